# Optimizing an MI355X kernel written in HIP

```python
import jax, jax.numpy as jnp
from jax import lax
import numpy as np

D_MODEL = 1024
BATCH = 4
SEQ = 8192
DEPTH = 1

D_MIX = D_MODEL
HEAD_DIM = 64
ATTN_WIDTH = D_MIX // 2
N_Q_HEADS = ATTN_WIDTH // HEAD_DIM
N_KV_HEADS = 2
Q_PER_KV = N_Q_HEADS // N_KV_HEADS
KV_WIDTH = N_KV_HEADS * HEAD_DIM
WINDOW = 128
ATTN_BLOCK = 128
GMLP_WIDTH = D_MIX - ATTN_WIDTH
N_GMLP_HEADS = GMLP_WIDTH // HEAD_DIM
GMLP_CHUNK = 128
IN_PROJ = ATTN_WIDTH + 2 * KV_WIDTH + 2 * GMLP_WIDTH
N_EXPERT_GROUPS = 4
EXPERTS_PER_GROUP = 8
N_EXPERTS = N_EXPERT_GROUPS * EXPERTS_PER_GROUP
TOP_K_IN_GROUP = 2
D_EXPERT = 256
RMS_EPS = 1e-6
LN_EPS = 1e-5
NEG_INF = -1e30

kernel_name = "hymba_swa_sink_gmlp_hiermoe_block"


def rmsnorm(x, g):
    xf = x.astype(jnp.float32)
    y = xf * lax.rsqrt(jnp.mean(xf * xf, axis=-1, keepdims=True) + RMS_EPS)
    return (y * g.astype(jnp.float32)).astype(x.dtype)


def layernorm(x, g, b):
    xf = x.astype(jnp.float32)
    mu = jnp.mean(xf, axis=-1, keepdims=True)
    var = jnp.mean(jnp.square(xf - mu), axis=-1, keepdims=True)
    y = (xf - mu) * lax.rsqrt(var + LN_EPS)
    return (y * g.astype(jnp.float32) + b.astype(jnp.float32)).astype(x.dtype)


def sliding_window_attention(q, k, v, sinks):
    B, S = q.shape[0], q.shape[1]
    nb = S // ATTN_BLOCK
    qb = q.reshape(B, nb, ATTN_BLOCK, N_KV_HEADS, Q_PER_KV, HEAD_DIM)
    kb = k.reshape(B, nb, ATTN_BLOCK, N_KV_HEADS, HEAD_DIM)
    vb = v.reshape(B, nb, ATTN_BLOCK, N_KV_HEADS, HEAD_DIM)
    pad = ((0, 0), (1, 0), (0, 0), (0, 0), (0, 0))
    k_band = jnp.concatenate([jnp.pad(kb[:, :-1], pad), kb], axis=2)
    v_band = jnp.concatenate([jnp.pad(vb[:, :-1], pad), vb], axis=2)
    scale = HEAD_DIM ** -0.5
    scores = jnp.einsum('bnqkgd,bnskd->bnkgqs', qb, k_band).astype(jnp.float32) * scale
    q_loc = jnp.arange(ATTN_BLOCK)[:, None]
    k_off = jnp.arange(2 * ATTN_BLOCK)[None, :] - ATTN_BLOCK
    diff = q_loc - k_off
    in_window = (diff >= 0) & (diff < WINDOW)
    k_abs = jnp.arange(nb)[:, None, None] * ATTN_BLOCK + k_off[None]
    mask = in_window[None] & (k_abs >= 0)
    scores = jnp.where(mask[None, :, None, None], scores, NEG_INF)
    sink = sinks.astype(jnp.float32).reshape(N_KV_HEADS, Q_PER_KV)[None, None, :, :, None, None]
    m = jnp.maximum(jnp.max(scores, axis=-1, keepdims=True), sink)
    p = jnp.exp(scores - m)
    denom = jnp.sum(p, axis=-1, keepdims=True) + jnp.exp(sink - m)
    probs = (p / denom).astype(v.dtype)
    out = jnp.einsum('bnkgqs,bnskd->bnqkgd', probs, v_band)
    return out.reshape(B, S, ATTN_WIDTH)


def chunked_spatial_gating(u, v, w_s, b_s, ln_g, ln_b):
    B, S = u.shape[0], u.shape[1]
    nc = S // GMLP_CHUNK
    u = jax.nn.gelu(u, approximate=False)
    v = layernorm(jax.nn.gelu(v, approximate=False), ln_g, ln_b)
    vc = v.reshape(B, nc, GMLP_CHUNK, N_GMLP_HEADS, HEAD_DIM)
    causal = jnp.tril(jnp.ones((GMLP_CHUNK, GMLP_CHUNK), dtype=bool))
    w = jnp.where(causal[None], w_s, 0).astype(v.dtype)
    s = jnp.einsum('htc,bnchd->bnthd', w, vc) + b_s.T.astype(v.dtype)[None, None, :, :, None]
    return u * s.reshape(B, S, GMLP_WIDTH)


def hierarchical_moe(x, w_gr, b_gr, w_er, b_er, w_gate, w_up, w_down):
    B, S, D = x.shape
    t = x.reshape(B * S, D)
    g_logits = (t @ w_gr).astype(jnp.float32) + b_gr.astype(jnp.float32)
    g_prob = jax.nn.softmax(g_logits, axis=-1)
    g_idx = jnp.argmax(g_logits, axis=-1)
    g_w = jnp.take_along_axis(g_prob, g_idx[:, None], axis=-1)
    e_all = jnp.einsum('td,gde->tge', t, w_er).astype(jnp.float32) + b_er.astype(jnp.float32)
    e_logits = jnp.take_along_axis(e_all, g_idx[:, None, None], axis=1)[:, 0]
    top_v, top_i = lax.top_k(e_logits, TOP_K_IN_GROUP)
    e_w = jax.nn.softmax(top_v, axis=-1)
    within = jnp.sum(jax.nn.one_hot(top_i, EXPERTS_PER_GROUP, dtype=jnp.float32) * e_w[..., None], axis=1)
    gates = jax.nn.one_hot(g_idx, N_EXPERT_GROUPS, dtype=jnp.float32)[:, :, None] * within[:, None, :] * g_w[:, :, None]
    gates = gates.reshape(B * S, N_EXPERTS).astype(t.dtype)
    out = jnp.zeros_like(t)
    for e in range(N_EXPERTS):
        hid = jax.nn.silu(t @ w_gate[e]) * (t @ w_up[e])
        out = out + gates[:, e:e + 1] * (hid @ w_down[e])
    return out.reshape(B, S, D)


def setup_inputs(seed: int = 0) -> dict:
    key = jax.random.key(seed)
    ks = jax.random.split(key, 20)
    f32 = jnp.float32
    nrm = lambda k, shape, s: (jax.random.normal(k, shape, f32) * s)
    L = DEPTH
    return {
        "x": nrm(ks[0], (BATCH, SEQ, D_MODEL), 1.0),
        "mix_norm_g": 1.0 + nrm(ks[1], (L, D_MODEL), 0.01),
        "w_in": nrm(ks[2], (L, D_MODEL, IN_PROJ), D_MODEL ** -0.5),
        "attn_sinks": nrm(ks[3], (L, N_Q_HEADS), 1.0),
        "w_spatial": nrm(ks[4], (L, N_GMLP_HEADS, GMLP_CHUNK, GMLP_CHUNK), GMLP_CHUNK ** -0.5),
        "b_spatial": 1.0 + nrm(ks[5], (L, N_GMLP_HEADS, GMLP_CHUNK), 0.1),
        "gmlp_ln_g": 1.0 + nrm(ks[6], (L, GMLP_WIDTH), 0.01),
        "gmlp_ln_b": nrm(ks[7], (L, GMLP_WIDTH), 0.01),
        "attn_out_g": 1.0 + nrm(ks[8], (L, ATTN_WIDTH), 0.01),
        "gmlp_out_g": 1.0 + nrm(ks[9], (L, GMLP_WIDTH), 0.01),
        "w_out": nrm(ks[10], (L, D_MIX, D_MODEL), D_MIX ** -0.5),
        "ffn_norm_g": 1.0 + nrm(ks[11], (L, D_MODEL), 0.01),
        "w_group_router": nrm(ks[12], (L, D_MODEL, N_EXPERT_GROUPS), D_MODEL ** -0.5),
        "b_group_router": nrm(ks[13], (L, N_EXPERT_GROUPS), 0.01),
        "w_expert_router": nrm(ks[14], (L, N_EXPERT_GROUPS, D_MODEL, EXPERTS_PER_GROUP), D_MODEL ** -0.5),
        "b_expert_router": nrm(ks[15], (L, N_EXPERT_GROUPS, EXPERTS_PER_GROUP), 0.01),
        "w_gate": nrm(ks[16], (L, N_EXPERTS, D_MODEL, D_EXPERT), D_MODEL ** -0.5),
        "w_up": nrm(ks[17], (L, N_EXPERTS, D_MODEL, D_EXPERT), D_MODEL ** -0.5),
        "w_down": nrm(ks[18], (L, N_EXPERTS, D_EXPERT, D_MODEL), D_EXPERT ** -0.5),
        "final_norm_g": 1.0 + nrm(ks[19], (D_MODEL,), 0.01),
    }


def reference(x, mix_norm_g, w_in, attn_sinks, w_spatial, b_spatial, gmlp_ln_g, gmlp_ln_b,
              attn_out_g, gmlp_out_g, w_out, ffn_norm_g, w_group_router, b_group_router,
              w_expert_router, b_expert_router, w_gate, w_up, w_down, final_norm_g):
    B, S = x.shape[0], x.shape[1]
    splits = [ATTN_WIDTH, ATTN_WIDTH + KV_WIDTH, ATTN_WIDTH + 2 * KV_WIDTH,
              ATTN_WIDTH + 2 * KV_WIDTH + GMLP_WIDTH]
    h = x
    for l in range(DEPTH):
        hn = rmsnorm(h, mix_norm_g[l])
        proj = hn @ w_in[l]
        q, k, v, gu, gv = jnp.split(proj, splits, axis=-1)
        q = q.reshape(B, S, N_Q_HEADS, HEAD_DIM)
        k = k.reshape(B, S, N_KV_HEADS, HEAD_DIM)
        v = v.reshape(B, S, N_KV_HEADS, HEAD_DIM)
        a = sliding_window_attention(q, k, v, attn_sinks[l])
        g = chunked_spatial_gating(gu, gv, w_spatial[l], b_spatial[l], gmlp_ln_g[l], gmlp_ln_b[l])
        mixed = jnp.concatenate([rmsnorm(a, attn_out_g[l]), rmsnorm(g, gmlp_out_g[l])], axis=-1)
        h = h + mixed @ w_out[l]
        hn = rmsnorm(h, ffn_norm_g[l])
        h = h + hierarchical_moe(hn, w_group_router[l], b_group_router[l], w_expert_router[l],
                                 b_expert_router[l], w_gate[l], w_up[l], w_down[l])
    return rmsnorm(h, final_norm_g)
```

```cpp
#include <hip/hip_runtime.h>
#include <cstdio>
#include <cstdint>
#include <cmath>

constexpr int BATCH = 4, SEQ = 8192, DM = 1024, NTOK = BATCH * SEQ;
constexpr int NPROJ = 1792;
constexpr int C_Q = 0, C_K = 512, C_V = 640, C_GU = 768, C_GV = 1280;
constexpr int NEXP = 32, DEXP = 256, NGRP = 4, EPG = 8;
constexpr int SLOT_CAP = 2 * NTOK + NEXP * 256;
constexpr float RMS_EPS = 1e-6f, LN_EPS = 1e-5f;

typedef unsigned short bf16_t;
__device__ __forceinline__ float bf2f(bf16_t v) { return __uint_as_float((unsigned)v << 16); }
__device__ __forceinline__ bf16_t f2bf(float f) { unsigned u = __float_as_uint(f); return (bf16_t)((u + 0x7fffu + ((u >> 16) & 1u)) >> 16); }

constexpr size_t MiB = 1u << 20;
constexpr size_t WS_CTL = 0, CTL_ZERO_BYTES = 1 * MiB;
constexpr size_t WS_TOKLIST = 58 * MiB;
constexpr size_t WS_RSLIST = 62 * MiB;
constexpr size_t WS_TOKREC = 66 * MiB;
constexpr size_t WS_TOKW = 67 * MiB;
constexpr size_t WS_SSQ = 68 * MiB;
constexpr size_t WS_XN = 72 * MiB;
constexpr size_t WS_PROJ = 136 * MiB;
constexpr size_t WS_MIXED = 248 * MiB;
constexpr size_t WS_HB = 312 * MiB;
constexpr size_t WS_HID = 376 * MiB;
constexpr size_t WS_Y = 72 * MiB;
constexpr size_t WS_AF = 412 * MiB;
constexpr size_t WS_VN = 72 * MiB;
constexpr size_t WS_HF = 376 * MiB;
constexpr size_t WS_END = 512 * MiB;
constexpr int CW_CNT = 64;

struct Params {
    const float* in[20];
    float* out;
    unsigned char* ws;
};

__device__ __forceinline__ float wave_sum(float v) {
#pragma unroll
    for (int o = 1; o < 64; o <<= 1) v += __shfl_xor(v, o);
    return v;
}
__device__ __forceinline__ float gelu_exact(float v) { return 0.5f * v * (1.0f + erff(v * 0.70710678118654752f)); }

__global__ void __launch_bounds__(256) k_xn(Params p) {
    const int lane = threadIdx.x & 63, row = blockIdx.x * 4 + (threadIdx.x >> 6);
    const float* x = p.in[0] + (size_t)row * DM; const float* g = p.in[1];
    bf16_t* xn = (bf16_t*)(p.ws + WS_XN) + (size_t)row * DM;
    float4 v[4]; float s = 0.f;
#pragma unroll
    for (int j = 0; j < 4; ++j) { v[j] = *(const float4*)(x + 256 * j + 4 * lane); s += v[j].x * v[j].x + v[j].y * v[j].y + v[j].z * v[j].z + v[j].w * v[j].w; }
    const float rstd = rsqrtf(wave_sum(s) * (1.f / DM) + RMS_EPS);
#pragma unroll
    for (int j = 0; j < 4; ++j) { const float4 gg = *(const float4*)(g + 256 * j + 4 * lane);
        ushort4 o; o.x = f2bf(v[j].x * rstd * gg.x); o.y = f2bf(v[j].y * rstd * gg.y); o.z = f2bf(v[j].z * rstd * gg.z); o.w = f2bf(v[j].w * rstd * gg.w);
        *(ushort4*)(xn + 256 * j + 4 * lane) = o; }
}

template <class AL, class BL, class EP>
__global__ void __launch_bounds__(256) k_gemm_naive(AL al, BL bl, EP ep, int K, int pad_) {
    __shared__ float As[16][64 + 4];
    __shared__ float Bs[16][64 + 4];
    const int tid = threadIdx.x, tx = tid & 15, ty = tid >> 4;
    const int m0 = blockIdx.y * 64, n0 = blockIdx.x * 64, z = blockIdx.z;
    if (!al.active(z, m0)) return;
    float acc[4][4];
#pragma unroll
    for (int i = 0; i < 4; ++i)
#pragma unroll
        for (int j = 0; j < 4; ++j) acc[i][j] = 0.f;
    for (int k0 = 0; k0 < K; k0 += 16) {
        { const int r = tid >> 2, kk = (tid & 3) * 4;
#pragma unroll
          for (int q = 0; q < 4; ++q) As[kk + q][r] = al.load(z, m0 + r, k0 + kk + q); }
        { const int kk = tid >> 4, c = (tid & 15) * 4;
#pragma unroll
          for (int q = 0; q < 4; ++q) Bs[kk][c + q] = bl.load(z, k0 + kk, n0 + c + q); }
        __syncthreads();
#pragma unroll
        for (int kk = 0; kk < 16; ++kk) {
            float a[4], b[4];
#pragma unroll
            for (int i = 0; i < 4; ++i) a[i] = As[kk][ty * 4 + i];
#pragma unroll
            for (int j = 0; j < 4; ++j) b[j] = Bs[kk][tx * 4 + j];
#pragma unroll
            for (int i = 0; i < 4; ++i)
#pragma unroll
                for (int j = 0; j < 4; ++j) acc[i][j] += a[i] * b[j];
        }
        __syncthreads();
    }
#pragma unroll
    for (int i = 0; i < 4; ++i)
#pragma unroll
        for (int j = 0; j < 4; ++j) ep.store(z, m0 + ty * 4 + i, n0 + tx * 4 + j, acc[i][j]);
}

struct AL_bf16 { const bf16_t* A; int lda; int pad;
    __device__ bool active(int, int) const { return true; }
    __device__ float load(int, int r, int k) const { return bf2f(A[(size_t)r * lda + k]); } };
struct BL_f32 { const float* B; int ldb; int pad;
    __device__ float load(int, int k, int n) const { return B[(size_t)k * ldb + n]; } };
struct EP_proj { bf16_t* O;
    __device__ void store(int, int r, int c, float v) const { if (c >= C_GU) v = gelu_exact(v); O[(size_t)r * NPROJ + c] = f2bf(v); } };
struct EP_h { const float* x; float* H;
    __device__ void store(int, int r, int c, float v) const { H[(size_t)r * DM + c] = x[(size_t)r * DM + c] + v; } };

__device__ __forceinline__ int tile_off(const int* cnt, int e) { int o = 0; for (int i = 0; i < e; ++i) o += (cnt[i] + 255) >> 8; return o; }

struct AL_moe_in { const bf16_t* HB; const float* g2; const int* cnt; const int* toklist;
    __device__ bool active(int z, int m0) const { return m0 < (((cnt[z] + 255) >> 8) << 8); }
    __device__ float load(int z, int r, int k) const { const int tok = r < cnt[z] ? toklist[(size_t)z * NTOK + r] : 0; return bf2f(HB[(size_t)tok * DM + k]) * g2[k]; } };
struct BL_gu { const float* wg; const float* wu;
    __device__ float load(int z, int k, int n) const { return n < DEXP ? wg[((size_t)z * DM + k) * DEXP + n] : wu[((size_t)z * DM + k) * DEXP + n - DEXP]; } };
struct EP_gu { float* GU; const int* cnt;
    __device__ void store(int z, int r, int c, float v) const { const int slot = tile_off(cnt, z) * 256 + r; GU[(size_t)slot * 512 + c] = v; } };
struct AL_hid { const bf16_t* HID; const int* cnt;
    __device__ bool active(int z, int m0) const { return m0 < (((cnt[z] + 255) >> 8) << 8); }
    __device__ float load(int z, int r, int k) const { const int slot = tile_off(cnt, z) * 256 + r; return bf2f(HID[(size_t)slot * DEXP + k]); } };
struct BL_down { const float* wd;
    __device__ float load(int z, int k, int n) const { return wd[((size_t)z * DEXP + k) * DM + n]; } };
struct EP_y { bf16_t* Y; const int* cnt;
    __device__ void store(int z, int r, int c, float v) const { const int slot = tile_off(cnt, z) * 256 + r; Y[(size_t)slot * DM + c] = f2bf(v); } };

__global__ void __launch_bounds__(128) k_attn_naive(Params p) {
    const bf16_t* proj = (const bf16_t*)(p.ws + WS_PROJ);
    float* AF = (float*)(p.ws + WS_AF);
    const int tok = blockIdx.x * 128 + threadIdx.x, head = blockIdx.y, kvh = head >> 2;
    const int tpos = tok % SEQ;
    float q[64], o[64];
#pragma unroll
    for (int d = 0; d < 64; ++d) { q[d] = bf2f(proj[(size_t)tok * NPROJ + C_Q + head * 64 + d]); o[d] = 0.f; }
    const float sink = p.in[3][head];
    float m = sink, l = 1.f;
    const int nk = tpos + 1 < 128 ? tpos + 1 : 128;
    for (int j = 0; j < nk; ++j) {
        const bf16_t* kr = proj + (size_t)(tok - j) * NPROJ + C_K + kvh * 64;
        const bf16_t* vr = proj + (size_t)(tok - j) * NPROJ + C_V + kvh * 64;
        float s = 0.f;
#pragma unroll
        for (int d = 0; d < 64; ++d) s += q[d] * bf2f(kr[d]);
        s *= 0.125f;
        const float mn = fmaxf(m, s), a = __expf(m - mn), pe = __expf(s - mn);
        l = l * a + pe; m = mn;
#pragma unroll
        for (int d = 0; d < 64; ++d) o[d] = o[d] * a + pe * bf2f(vr[d]);
    }
    const float il = 1.f / l;
#pragma unroll
    for (int d = 0; d < 64; ++d) AF[(size_t)tok * 512 + head * 64 + d] = o[d] * il;
}

__global__ void __launch_bounds__(256) k_rms512(const float* src, const float* g, bf16_t* mixed, int coloff, int pad_) {
    const int lane = threadIdx.x & 63, row = blockIdx.x * 4 + (threadIdx.x >> 6);
    const float* s = src + (size_t)row * 512;
    float4 v[2]; float ss = 0.f;
#pragma unroll
    for (int j = 0; j < 2; ++j) { v[j] = *(const float4*)(s + 256 * j + 4 * lane); ss += v[j].x * v[j].x + v[j].y * v[j].y + v[j].z * v[j].z + v[j].w * v[j].w; }
    const float rstd = rsqrtf(wave_sum(ss) * (1.f / 512) + RMS_EPS);
#pragma unroll
    for (int j = 0; j < 2; ++j) { const float4 gg = *(const float4*)(g + 256 * j + 4 * lane);
        ushort4 o; o.x = f2bf(v[j].x * rstd * gg.x); o.y = f2bf(v[j].y * rstd * gg.y); o.z = f2bf(v[j].z * rstd * gg.z); o.w = f2bf(v[j].w * rstd * gg.w);
        *(ushort4*)(mixed + (size_t)row * DM + coloff + 256 * j + 4 * lane) = o; }
}

__global__ void __launch_bounds__(256) k_ln_v(Params p) {
    const int lane = threadIdx.x & 63, row = blockIdx.x * 4 + (threadIdx.x >> 6);
    const bf16_t* s = (const bf16_t*)(p.ws + WS_PROJ) + (size_t)row * NPROJ + C_GV;
    float* vn = (float*)(p.ws + WS_VN) + (size_t)row * 512;
    float v[8]; float sm = 0.f;
#pragma unroll
    for (int j = 0; j < 8; ++j) { v[j] = bf2f(s[8 * lane + j]); sm += v[j]; }
    const float mu = wave_sum(sm) * (1.f / 512); float sq = 0.f;
#pragma unroll
    for (int j = 0; j < 8; ++j) { v[j] -= mu; sq += v[j] * v[j]; }
    const float rstd = rsqrtf(wave_sum(sq) * (1.f / 512) + LN_EPS);
#pragma unroll
    for (int j = 0; j < 8; ++j) vn[8 * lane + j] = v[j] * rstd * p.in[6][8 * lane + j] + p.in[7][8 * lane + j];
}

__global__ void __launch_bounds__(256) k_gmlp_naive(Params p) {
    const bf16_t* proj = (const bf16_t*)(p.ws + WS_PROJ);
    const float* vn = (const float*)(p.ws + WS_VN);
    float* GF = (float*)(p.ws + WS_AF);
    const int chunk = blockIdx.x, h = blockIdx.y, t = threadIdx.x >> 1, dh = (threadIdx.x & 1) * 32;
    const float* wrow = p.in[4] + ((size_t)h * 128 + t) * 128;
    float acc[32];
#pragma unroll
    for (int d = 0; d < 32; ++d) acc[d] = 0.f;
    for (int c = 0; c <= t; ++c) {
        const float w = wrow[c]; const float* vr = vn + (size_t)(chunk * 128 + c) * 512 + h * 64 + dh;
#pragma unroll
        for (int d = 0; d < 32; ++d) acc[d] += w * vr[d];
    }
    const float b = p.in[5][h * 128 + t]; const size_t tok = (size_t)chunk * 128 + t;
#pragma unroll
    for (int d = 0; d < 32; ++d) GF[tok * 512 + h * 64 + dh + d] = bf2f(proj[tok * NPROJ + C_GU + h * 64 + dh + d]) * (acc[d] + b);
}

__global__ void __launch_bounds__(256) k_h_finish(Params p) {
    const int lane = threadIdx.x & 63, row = blockIdx.x * 4 + (threadIdx.x >> 6);
    const float* h = (const float*)(p.ws + WS_HF) + (size_t)row * DM;
    bf16_t* hb = (bf16_t*)(p.ws + WS_HB) + (size_t)row * DM;
    float* ssq = (float*)(p.ws + WS_SSQ) + (size_t)row * 16;
    float s = 0.f;
#pragma unroll
    for (int j = 0; j < 4; ++j) { const float4 v = *(const float4*)(h + 256 * j + 4 * lane); s += v.x * v.x + v.y * v.y + v.z * v.z + v.w * v.w;
        ushort4 o; o.x = f2bf(v.x); o.y = f2bf(v.y); o.z = f2bf(v.z); o.w = f2bf(v.w); *(ushort4*)(hb + 256 * j + 4 * lane) = o; }
    s = wave_sum(s);
    if (lane < 16) ssq[lane] = lane == 0 ? s : 0.f;
}

__global__ void __launch_bounds__(64) k_router_naive(Params p) {
    __shared__ float lg[36];
    const int tok = blockIdx.x, c = threadIdx.x;
    const bf16_t* hb = (const bf16_t*)(p.ws + WS_HB) + (size_t)tok * DM;
    const float* ssq = (const float*)(p.ws + WS_SSQ) + (size_t)tok * 16;
    float s = 0.f; for (int i = 0; i < 16; ++i) s += ssq[i];
    const float rstd = rsqrtf(s * (1.f / DM) + RMS_EPS);
    const float* g2 = p.in[11];
    if (c < 36) {
        float acc = 0.f;
        if (c < 4) { for (int k = 0; k < DM; ++k) acc += bf2f(hb[k]) * g2[k] * p.in[12][k * 4 + c]; acc = acc * rstd + p.in[13][c]; }
        else { const int g = (c - 4) >> 3, e = (c - 4) & 7; const float* w = p.in[14] + (size_t)g * DM * 8 + e;
            for (int k = 0; k < DM; ++k) acc += bf2f(hb[k]) * g2[k] * w[k * 8]; acc = acc * rstd + p.in[15][g * 8 + e]; }
        lg[c] = acc;
    }
    __syncthreads();
    if (c == 0) {
        int gi = 0; float gm = lg[0];
        for (int j = 1; j < 4; ++j) if (lg[j] > gm) { gm = lg[j]; gi = j; }
        float den = 0.f; for (int j = 0; j < 4; ++j) den += __expf(lg[j] - gm);
        const float gw = 1.f / den;
        const float* el = lg + 4 + gi * 8;
        int i1 = 0; float v1 = el[0];
        for (int j = 1; j < 8; ++j) if (el[j] > v1) { v1 = el[j]; i1 = j; }
        int i2 = -1; float v2 = -INFINITY;
        for (int j = 0; j < 8; ++j) if (j != i1 && el[j] > v2) { v2 = el[j]; i2 = j; }
        const float w1 = 1.f / (1.f + __expf(v2 - v1)), w2 = 1.f - w1;
        const int e1 = gi * 8 + i1, e2 = gi * 8 + i2;
        int* cnt = (int*)(p.ws + WS_CTL) + CW_CNT;
        const int p1 = atomicAdd(cnt + e1, 1), p2 = atomicAdd(cnt + e2, 1);
        int* tl = (int*)(p.ws + WS_TOKLIST); float* rl = (float*)(p.ws + WS_RSLIST);
        tl[(size_t)e1 * NTOK + p1] = tok; rl[(size_t)e1 * NTOK + p1] = rstd;
        tl[(size_t)e2 * NTOK + p2] = tok; rl[(size_t)e2 * NTOK + p2] = rstd;
        ((int4*)(p.ws + WS_TOKREC))[tok] = make_int4(e1, p1, e2, p2);
        ((float2*)(p.ws + WS_TOKW))[tok] = make_float2(gw * w1, gw * w2);
    }
}

__global__ void __launch_bounds__(256) k_swiglu_naive(Params p, const float* GU) {
    const int* cnt = (const int*)(p.ws + WS_CTL) + CW_CNT; const int e = blockIdx.y, r = blockIdx.x;
    const int npad = ((cnt[e] + 255) >> 8) << 8; if (r >= npad) return;
    const int slot = tile_off(cnt, e) * 256 + r; const int j = threadIdx.x;
    const float rs = r < cnt[e] ? ((const float*)(p.ws + WS_RSLIST))[(size_t)e * NTOK + r] : 0.f;
    const float g = GU[(size_t)slot * 512 + j] * rs, u = GU[(size_t)slot * 512 + 256 + j] * rs;
    ((bf16_t*)(p.ws + WS_HID))[(size_t)slot * DEXP + j] = f2bf(g / (1.f + __expf(-g)) * u);
}

__global__ void __launch_bounds__(256) k_final(Params p) {
    const int lane = threadIdx.x & 63, tok = blockIdx.x * 4 + (threadIdx.x >> 6);
    const int* cnt = (const int*)(p.ws + WS_CTL) + CW_CNT;
    const int4 rec = ((const int4*)(p.ws + WS_TOKREC))[tok]; const float2 w = ((const float2*)(p.ws + WS_TOKW))[tok];
    const int s1 = tile_off(cnt, rec.x) * 256 + rec.y, s2 = tile_off(cnt, rec.z) * 256 + rec.w;
    const bf16_t* hb = (const bf16_t*)(p.ws + WS_HB) + (size_t)tok * DM;
    const bf16_t* y1 = (const bf16_t*)(p.ws + WS_Y) + (size_t)s1 * DM; const bf16_t* y2 = (const bf16_t*)(p.ws + WS_Y) + (size_t)s2 * DM;
    float z[16]; float ss = 0.f;
#pragma unroll
    for (int j = 0; j < 2; ++j) {
        const uint4 a = *(const uint4*)(hb + 512 * j + 8 * lane), b = *(const uint4*)(y1 + 512 * j + 8 * lane), c = *(const uint4*)(y2 + 512 * j + 8 * lane);
        const unsigned aa[4] = {a.x, a.y, a.z, a.w}, bb[4] = {b.x, b.y, b.z, b.w}, cc[4] = {c.x, c.y, c.z, c.w};
#pragma unroll
        for (int q = 0; q < 4; ++q) {
            const float lo = __uint_as_float(aa[q] << 16) + w.x * __uint_as_float(bb[q] << 16) + w.y * __uint_as_float(cc[q] << 16);
            const float hi = __uint_as_float(aa[q] & 0xffff0000u) + w.x * __uint_as_float(bb[q] & 0xffff0000u) + w.y * __uint_as_float(cc[q] & 0xffff0000u);
            z[8 * j + 2 * q] = lo; z[8 * j + 2 * q + 1] = hi; ss += lo * lo + hi * hi; }
    }
    const float rstd = rsqrtf(wave_sum(ss) * (1.f / DM) + RMS_EPS);
    const float* gf = p.in[19]; float* o = p.out + (size_t)tok * DM;
#pragma unroll
    for (int j = 0; j < 2; ++j) {
        const float4 g0 = *(const float4*)(gf + 512 * j + 8 * lane), g1 = *(const float4*)(gf + 512 * j + 8 * lane + 4);
        *(float4*)(o + 512 * j + 8 * lane) = make_float4(z[8 * j] * rstd * g0.x, z[8 * j + 1] * rstd * g0.y, z[8 * j + 2] * rstd * g0.z, z[8 * j + 3] * rstd * g0.w);
        *(float4*)(o + 512 * j + 8 * lane + 4) = make_float4(z[8 * j + 4] * rstd * g1.x, z[8 * j + 5] * rstd * g1.y, z[8 * j + 6] * rstd * g1.z, z[8 * j + 7] * rstd * g1.w);
    }
}

extern "C" void kernel_launch(void* const* d_in, const int* in_sizes, int n_in, void* d_out, int out_size, void* d_ws, size_t ws_size, hipStream_t stream) {
    if (n_in != 20 || in_sizes[0] != NTOK * DM || out_size != NTOK * DM || ws_size < WS_END) {
        fprintf(stderr, "kernel_launch: unexpected shapes (n_in %d, in0 %d, out %d, ws %zu)\n", n_in, n_in > 0 ? in_sizes[0] : -1, out_size, ws_size); return; }
    Params p{};
    for (int i = 0; i < 20; ++i) p.in[i] = (const float*)d_in[i];
    p.out = (float*)d_out; p.ws = (unsigned char*)d_ws;
    unsigned char* ws = p.ws;
    (void)hipMemsetAsync(ws + WS_CTL, 0, CTL_ZERO_BYTES, stream);
    const int* cnt = (const int*)(ws + WS_CTL) + CW_CNT;
    k_xn<<<NTOK / 4, 256, 0, stream>>>(p);
    k_gemm_naive<<<dim3(NPROJ / 64, NTOK / 64, 1), 256, 0, stream>>>(AL_bf16{(const bf16_t*)(ws + WS_XN), DM, 0}, BL_f32{p.in[2], NPROJ, 0}, EP_proj{(bf16_t*)(ws + WS_PROJ)}, DM, 0);
    k_attn_naive<<<dim3(NTOK / 128, 8), 128, 0, stream>>>(p);
    k_rms512<<<NTOK / 4, 256, 0, stream>>>((const float*)(ws + WS_AF), p.in[8], (bf16_t*)(ws + WS_MIXED), 0, 0);
    k_ln_v<<<NTOK / 4, 256, 0, stream>>>(p);
    k_gmlp_naive<<<dim3(NTOK / 128, 8), 256, 0, stream>>>(p);
    k_rms512<<<NTOK / 4, 256, 0, stream>>>((const float*)(ws + WS_AF), p.in[9], (bf16_t*)(ws + WS_MIXED), 512, 0);
    k_gemm_naive<<<dim3(DM / 64, NTOK / 64, 1), 256, 0, stream>>>(AL_bf16{(const bf16_t*)(ws + WS_MIXED), DM, 0}, BL_f32{p.in[10], DM, 0}, EP_h{p.in[0], (float*)(ws + WS_HF)}, DM, 0);
    k_h_finish<<<NTOK / 4, 256, 0, stream>>>(p);
    k_router_naive<<<NTOK, 64, 0, stream>>>(p);
    float* GU = (float*)(ws + WS_PROJ);
    k_gemm_naive<<<dim3(512 / 64, NTOK / 64, NEXP), 256, 0, stream>>>(AL_moe_in{(const bf16_t*)(ws + WS_HB), p.in[11], cnt, (const int*)(ws + WS_TOKLIST)}, BL_gu{p.in[16], p.in[17]}, EP_gu{GU, cnt}, DM, 0);
    k_swiglu_naive<<<dim3(NTOK, NEXP), 256, 0, stream>>>(p, GU);
    k_gemm_naive<<<dim3(DM / 64, NTOK / 64, NEXP), 256, 0, stream>>>(AL_hid{(const bf16_t*)(ws + WS_HID), cnt}, BL_down{p.in[18]}, EP_y{(bf16_t*)(ws + WS_Y), cnt}, DEXP, 0);
    k_final<<<NTOK / 4, 256, 0, stream>>>(p);
}
```

```cpp
#include <hip/hip_runtime.h>
#include <cstdio>
#include <cstdint>
#include <cmath>

constexpr int BATCH = 4, SEQ = 8192, DM = 1024, NTOK = BATCH * SEQ;
constexpr int NPROJ = 1792;
constexpr int C_Q = 0, C_K = 512, C_V = 640, C_GU = 768, C_GV = 1280;
constexpr int NEXP = 32, DEXP = 256, NGRP = 4, EPG = 8;
constexpr int SLOT_CAP = 2 * NTOK + NEXP * 256;
constexpr float RMS_EPS = 1e-6f, LN_EPS = 1e-5f;

typedef unsigned short bf16_t;
__device__ __forceinline__ float bf2f(bf16_t v) { return __uint_as_float((unsigned)v << 16); }
__device__ __forceinline__ bf16_t f2bf(float f) { unsigned u = __float_as_uint(f); return (bf16_t)((u + 0x7fffu + ((u >> 16) & 1u)) >> 16); }

constexpr size_t MiB = 1u << 20;
constexpr size_t WS_CTL = 0, CTL_ZERO_BYTES = 1 * MiB;
constexpr size_t WS_TOKLIST = 58 * MiB;
constexpr size_t WS_RSLIST = 62 * MiB;
constexpr size_t WS_TOKREC = 66 * MiB;
constexpr size_t WS_TOKW = 67 * MiB;
constexpr size_t WS_SSQ = 68 * MiB;
constexpr size_t WS_XN = 72 * MiB;
constexpr size_t WS_PROJ = 136 * MiB;
constexpr size_t WS_MIXED = 248 * MiB;
constexpr size_t WS_HB = 312 * MiB;
constexpr size_t WS_HID = 376 * MiB;
constexpr size_t WS_Y = 72 * MiB;
constexpr size_t WS_AF = 412 * MiB;
constexpr size_t WS_VN = 72 * MiB;
constexpr size_t WS_HF = 376 * MiB;
constexpr size_t WS_END = 512 * MiB;
constexpr int CW_CNT = 64;

struct Params {
    const float* in[20];
    float* out;
    unsigned char* ws;
};

__device__ __forceinline__ float wave_sum(float v) {
#pragma unroll
    for (int o = 1; o < 64; o <<= 1) v += __shfl_xor(v, o);
    return v;
}
__device__ __forceinline__ float gelu_exact(float v) { return 0.5f * v * (1.0f + erff(v * 0.70710678118654752f)); }

__global__ void __launch_bounds__(256) k_xn(Params p) {
    const int lane = threadIdx.x & 63, row = blockIdx.x * 4 + (threadIdx.x >> 6);
    const float* x = p.in[0] + (size_t)row * DM; const float* g = p.in[1];
    bf16_t* xn = (bf16_t*)(p.ws + WS_XN) + (size_t)row * DM;
    float4 v[4]; float s = 0.f;
#pragma unroll
    for (int j = 0; j < 4; ++j) { v[j] = *(const float4*)(x + 256 * j + 4 * lane); s += v[j].x * v[j].x + v[j].y * v[j].y + v[j].z * v[j].z + v[j].w * v[j].w; }
    const float rstd = rsqrtf(wave_sum(s) * (1.f / DM) + RMS_EPS);
#pragma unroll
    for (int j = 0; j < 4; ++j) { const float4 gg = *(const float4*)(g + 256 * j + 4 * lane);
        ushort4 o; o.x = f2bf(v[j].x * rstd * gg.x); o.y = f2bf(v[j].y * rstd * gg.y); o.z = f2bf(v[j].z * rstd * gg.z); o.w = f2bf(v[j].w * rstd * gg.w);
        *(ushort4*)(xn + 256 * j + 4 * lane) = o; }
}

template <class AL, class BL, class EP>
__global__ void __launch_bounds__(256) k_gemm_naive(AL al, BL bl, EP ep, int K, int pad_) {
    __shared__ float As[16][64 + 4];
    __shared__ float Bs[16][64 + 4];
    const int tid = threadIdx.x, tx = tid & 15, ty = tid >> 4;
    const int m0 = blockIdx.y * 64, n0 = blockIdx.x * 64, z = blockIdx.z;
    if (!al.active(z, m0)) return;
    float acc[4][4];
#pragma unroll
    for (int i = 0; i < 4; ++i)
#pragma unroll
        for (int j = 0; j < 4; ++j) acc[i][j] = 0.f;
    for (int k0 = 0; k0 < K; k0 += 16) {
        { const int r = tid >> 2, kk = (tid & 3) * 4;
#pragma unroll
          for (int q = 0; q < 4; ++q) As[kk + q][r] = al.load(z, m0 + r, k0 + kk + q); }
        { const int kk = tid >> 4, c = (tid & 15) * 4;
#pragma unroll
          for (int q = 0; q < 4; ++q) Bs[kk][c + q] = bl.load(z, k0 + kk, n0 + c + q); }
        __syncthreads();
#pragma unroll
        for (int kk = 0; kk < 16; ++kk) {
            float a[4], b[4];
#pragma unroll
            for (int i = 0; i < 4; ++i) a[i] = As[kk][ty * 4 + i];
#pragma unroll
            for (int j = 0; j < 4; ++j) b[j] = Bs[kk][tx * 4 + j];
#pragma unroll
            for (int i = 0; i < 4; ++i)
#pragma unroll
                for (int j = 0; j < 4; ++j) acc[i][j] += a[i] * b[j];
        }
        __syncthreads();
    }
#pragma unroll
    for (int i = 0; i < 4; ++i)
#pragma unroll
        for (int j = 0; j < 4; ++j) ep.store(z, m0 + ty * 4 + i, n0 + tx * 4 + j, acc[i][j]);
}

struct AL_bf16 { const bf16_t* A; int lda; int pad;
    __device__ bool active(int, int) const { return true; }
    __device__ float load(int, int r, int k) const { return bf2f(A[(size_t)r * lda + k]); } };
struct BL_f32 { const float* B; int ldb; int pad;
    __device__ float load(int, int k, int n) const { return B[(size_t)k * ldb + n]; } };
struct EP_proj { bf16_t* O;
    __device__ void store(int, int r, int c, float v) const { if (c >= C_GU) v = gelu_exact(v); O[(size_t)r * NPROJ + c] = f2bf(v); } };
struct EP_h { const float* x; float* H;
    __device__ void store(int, int r, int c, float v) const { H[(size_t)r * DM + c] = x[(size_t)r * DM + c] + v; } };

__device__ __forceinline__ int tile_off(const int* cnt, int e) { int o = 0; for (int i = 0; i < e; ++i) o += (cnt[i] + 255) >> 8; return o; }

struct AL_moe_in { const bf16_t* HB; const float* g2; const int* cnt; const int* toklist;
    __device__ bool active(int z, int m0) const { return m0 < (((cnt[z] + 255) >> 8) << 8); }
    __device__ float load(int z, int r, int k) const { const int tok = r < cnt[z] ? toklist[(size_t)z * NTOK + r] : 0; return bf2f(HB[(size_t)tok * DM + k]) * g2[k]; } };
struct BL_gu { const float* wg; const float* wu;
    __device__ float load(int z, int k, int n) const { return n < DEXP ? wg[((size_t)z * DM + k) * DEXP + n] : wu[((size_t)z * DM + k) * DEXP + n - DEXP]; } };
struct EP_gu { float* GU; const int* cnt;
    __device__ void store(int z, int r, int c, float v) const { const int slot = tile_off(cnt, z) * 256 + r; GU[(size_t)slot * 512 + c] = v; } };
struct AL_hid { const bf16_t* HID; const int* cnt;
    __device__ bool active(int z, int m0) const { return m0 < (((cnt[z] + 255) >> 8) << 8); }
    __device__ float load(int z, int r, int k) const { const int slot = tile_off(cnt, z) * 256 + r; return bf2f(HID[(size_t)slot * DEXP + k]); } };
struct BL_down { const float* wd;
    __device__ float load(int z, int k, int n) const { return wd[((size_t)z * DEXP + k) * DM + n]; } };
struct EP_y { bf16_t* Y; const int* cnt;
    __device__ void store(int z, int r, int c, float v) const { const int slot = tile_off(cnt, z) * 256 + r; Y[(size_t)slot * DM + c] = f2bf(v); } };

__global__ void __launch_bounds__(128) k_attn_naive(Params p) {
    const bf16_t* proj = (const bf16_t*)(p.ws + WS_PROJ);
    float* AF = (float*)(p.ws + WS_AF);
    const int tok = blockIdx.x * 128 + threadIdx.x, head = blockIdx.y, kvh = head >> 2;
    const int tpos = tok % SEQ;
    float q[64], o[64];
#pragma unroll
    for (int d = 0; d < 64; ++d) { q[d] = bf2f(proj[(size_t)tok * NPROJ + C_Q + head * 64 + d]); o[d] = 0.f; }
    const float sink = p.in[3][head];
    float m = sink, l = 1.f;
    const int nk = tpos + 1 < 128 ? tpos + 1 : 128;
    for (int j = 0; j < nk; ++j) {
        const bf16_t* kr = proj + (size_t)(tok - j) * NPROJ + C_K + kvh * 64;
        const bf16_t* vr = proj + (size_t)(tok - j) * NPROJ + C_V + kvh * 64;
        float s = 0.f;
#pragma unroll
        for (int d = 0; d < 64; ++d) s += q[d] * bf2f(kr[d]);
        s *= 0.125f;
        const float mn = fmaxf(m, s), a = __expf(m - mn), pe = __expf(s - mn);
        l = l * a + pe; m = mn;
#pragma unroll
        for (int d = 0; d < 64; ++d) o[d] = o[d] * a + pe * bf2f(vr[d]);
    }
    const float il = 1.f / l;
#pragma unroll
    for (int d = 0; d < 64; ++d) AF[(size_t)tok * 512 + head * 64 + d] = o[d] * il;
}

__global__ void __launch_bounds__(256) k_rms512(const float* src, const float* g, bf16_t* mixed, int coloff, int pad_) {
    const int lane = threadIdx.x & 63, row = blockIdx.x * 4 + (threadIdx.x >> 6);
    const float* s = src + (size_t)row * 512;
    float4 v[2]; float ss = 0.f;
#pragma unroll
    for (int j = 0; j < 2; ++j) { v[j] = *(const float4*)(s + 256 * j + 4 * lane); ss += v[j].x * v[j].x + v[j].y * v[j].y + v[j].z * v[j].z + v[j].w * v[j].w; }
    const float rstd = rsqrtf(wave_sum(ss) * (1.f / 512) + RMS_EPS);
#pragma unroll
    for (int j = 0; j < 2; ++j) { const float4 gg = *(const float4*)(g + 256 * j + 4 * lane);
        ushort4 o; o.x = f2bf(v[j].x * rstd * gg.x); o.y = f2bf(v[j].y * rstd * gg.y); o.z = f2bf(v[j].z * rstd * gg.z); o.w = f2bf(v[j].w * rstd * gg.w);
        *(ushort4*)(mixed + (size_t)row * DM + coloff + 256 * j + 4 * lane) = o; }
}

__global__ void __launch_bounds__(256) k_ln_v(Params p) {
    const int lane = threadIdx.x & 63, row = blockIdx.x * 4 + (threadIdx.x >> 6);
    const bf16_t* s = (const bf16_t*)(p.ws + WS_PROJ) + (size_t)row * NPROJ + C_GV;
    float* vn = (float*)(p.ws + WS_VN) + (size_t)row * 512;
    float v[8]; float sm = 0.f;
#pragma unroll
    for (int j = 0; j < 8; ++j) { v[j] = bf2f(s[8 * lane + j]); sm += v[j]; }
    const float mu = wave_sum(sm) * (1.f / 512); float sq = 0.f;
#pragma unroll
    for (int j = 0; j < 8; ++j) { v[j] -= mu; sq += v[j] * v[j]; }
    const float rstd = rsqrtf(wave_sum(sq) * (1.f / 512) + LN_EPS);
#pragma unroll
    for (int j = 0; j < 8; ++j) vn[8 * lane + j] = v[j] * rstd * p.in[6][8 * lane + j] + p.in[7][8 * lane + j];
}

__global__ void __launch_bounds__(256) k_gmlp_naive(Params p) {
    const bf16_t* proj = (const bf16_t*)(p.ws + WS_PROJ);
    const float* vn = (const float*)(p.ws + WS_VN);
    float* GF = (float*)(p.ws + WS_AF);
    const int chunk = blockIdx.x, h = blockIdx.y, t = threadIdx.x >> 1, dh = (threadIdx.x & 1) * 32;
    const float* wrow = p.in[4] + ((size_t)h * 128 + t) * 128;
    float acc[32];
#pragma unroll
    for (int d = 0; d < 32; ++d) acc[d] = 0.f;
    for (int c = 0; c <= t; ++c) {
        const float w = wrow[c]; const float* vr = vn + (size_t)(chunk * 128 + c) * 512 + h * 64 + dh;
#pragma unroll
        for (int d = 0; d < 32; ++d) acc[d] += w * vr[d];
    }
    const float b = p.in[5][h * 128 + t]; const size_t tok = (size_t)chunk * 128 + t;
#pragma unroll
    for (int d = 0; d < 32; ++d) GF[tok * 512 + h * 64 + dh + d] = bf2f(proj[tok * NPROJ + C_GU + h * 64 + dh + d]) * (acc[d] + b);
}

__global__ void __launch_bounds__(256) k_h_finish(Params p) {
    const int lane = threadIdx.x & 63, row = blockIdx.x * 4 + (threadIdx.x >> 6);
    const float* h = (const float*)(p.ws + WS_HF) + (size_t)row * DM;
    bf16_t* hb = (bf16_t*)(p.ws + WS_HB) + (size_t)row * DM;
    float* ssq = (float*)(p.ws + WS_SSQ) + (size_t)row * 16;
    float s = 0.f;
#pragma unroll
    for (int j = 0; j < 4; ++j) { const float4 v = *(const float4*)(h + 256 * j + 4 * lane); s += v.x * v.x + v.y * v.y + v.z * v.z + v.w * v.w;
        ushort4 o; o.x = f2bf(v.x); o.y = f2bf(v.y); o.z = f2bf(v.z); o.w = f2bf(v.w); *(ushort4*)(hb + 256 * j + 4 * lane) = o; }
    s = wave_sum(s);
    if (lane < 16) ssq[lane] = lane == 0 ? s : 0.f;
}

__global__ void __launch_bounds__(64) k_router_naive(Params p) {
    __shared__ float lg[36];
    const int tok = blockIdx.x, c = threadIdx.x;
    const bf16_t* hb = (const bf16_t*)(p.ws + WS_HB) + (size_t)tok * DM;
    const float* ssq = (const float*)(p.ws + WS_SSQ) + (size_t)tok * 16;
    float s = 0.f; for (int i = 0; i < 16; ++i) s += ssq[i];
    const float rstd = rsqrtf(s * (1.f / DM) + RMS_EPS);
    const float* g2 = p.in[11];
    if (c < 36) {
        float acc = 0.f;
        if (c < 4) { for (int k = 0; k < DM; ++k) acc += bf2f(hb[k]) * g2[k] * p.in[12][k * 4 + c]; acc = acc * rstd + p.in[13][c]; }
        else { const int g = (c - 4) >> 3, e = (c - 4) & 7; const float* w = p.in[14] + (size_t)g * DM * 8 + e;
            for (int k = 0; k < DM; ++k) acc += bf2f(hb[k]) * g2[k] * w[k * 8]; acc = acc * rstd + p.in[15][g * 8 + e]; }
        lg[c] = acc;
    }
    __syncthreads();
    if (c == 0) {
        int gi = 0; float gm = lg[0];
        for (int j = 1; j < 4; ++j) if (lg[j] > gm) { gm = lg[j]; gi = j; }
        float den = 0.f; for (int j = 0; j < 4; ++j) den += __expf(lg[j] - gm);
        const float gw = 1.f / den;
        const float* el = lg + 4 + gi * 8;
        int i1 = 0; float v1 = el[0];
        for (int j = 1; j < 8; ++j) if (el[j] > v1) { v1 = el[j]; i1 = j; }
        int i2 = -1; float v2 = -INFINITY;
        for (int j = 0; j < 8; ++j) if (j != i1 && el[j] > v2) { v2 = el[j]; i2 = j; }
        const float w1 = 1.f / (1.f + __expf(v2 - v1)), w2 = 1.f - w1;
        const int e1 = gi * 8 + i1, e2 = gi * 8 + i2;
        int* cnt = (int*)(p.ws + WS_CTL) + CW_CNT;
        const int p1 = atomicAdd(cnt + e1, 1), p2 = atomicAdd(cnt + e2, 1);
        int* tl = (int*)(p.ws + WS_TOKLIST); float* rl = (float*)(p.ws + WS_RSLIST);
        tl[(size_t)e1 * NTOK + p1] = tok; rl[(size_t)e1 * NTOK + p1] = rstd;
        tl[(size_t)e2 * NTOK + p2] = tok; rl[(size_t)e2 * NTOK + p2] = rstd;
        ((int4*)(p.ws + WS_TOKREC))[tok] = make_int4(e1, p1, e2, p2);
        ((float2*)(p.ws + WS_TOKW))[tok] = make_float2(gw * w1, gw * w2);
    }
}

__global__ void __launch_bounds__(256) k_swiglu_naive(Params p, const float* GU) {
    const int* cnt = (const int*)(p.ws + WS_CTL) + CW_CNT; const int e = blockIdx.y, r = blockIdx.x;
    const int npad = ((cnt[e] + 255) >> 8) << 8; if (r >= npad) return;
    const int slot = tile_off(cnt, e) * 256 + r; const int j = threadIdx.x;
    const float rs = r < cnt[e] ? ((const float*)(p.ws + WS_RSLIST))[(size_t)e * NTOK + r] : 0.f;
    const float g = GU[(size_t)slot * 512 + j] * rs, u = GU[(size_t)slot * 512 + 256 + j] * rs;
    ((bf16_t*)(p.ws + WS_HID))[(size_t)slot * DEXP + j] = f2bf(g / (1.f + __expf(-g)) * u);
}

__global__ void __launch_bounds__(256) k_final(Params p) {
    const int lane = threadIdx.x & 63, tok = blockIdx.x * 4 + (threadIdx.x >> 6);
    const int* cnt = (const int*)(p.ws + WS_CTL) + CW_CNT;
    const int4 rec = ((const int4*)(p.ws + WS_TOKREC))[tok]; const float2 w = ((const float2*)(p.ws + WS_TOKW))[tok];
    const int s1 = tile_off(cnt, rec.x) * 256 + rec.y, s2 = tile_off(cnt, rec.z) * 256 + rec.w;
    const bf16_t* hb = (const bf16_t*)(p.ws + WS_HB) + (size_t)tok * DM;
    const bf16_t* y1 = (const bf16_t*)(p.ws + WS_Y) + (size_t)s1 * DM; const bf16_t* y2 = (const bf16_t*)(p.ws + WS_Y) + (size_t)s2 * DM;
    float z[16]; float ss = 0.f;
#pragma unroll
    for (int j = 0; j < 2; ++j) {
        const uint4 a = *(const uint4*)(hb + 512 * j + 8 * lane), b = *(const uint4*)(y1 + 512 * j + 8 * lane), c = *(const uint4*)(y2 + 512 * j + 8 * lane);
        const unsigned aa[4] = {a.x, a.y, a.z, a.w}, bb[4] = {b.x, b.y, b.z, b.w}, cc[4] = {c.x, c.y, c.z, c.w};
#pragma unroll
        for (int q = 0; q < 4; ++q) {
            const float lo = __uint_as_float(aa[q] << 16) + w.x * __uint_as_float(bb[q] << 16) + w.y * __uint_as_float(cc[q] << 16);
            const float hi = __uint_as_float(aa[q] & 0xffff0000u) + w.x * __uint_as_float(bb[q] & 0xffff0000u) + w.y * __uint_as_float(cc[q] & 0xffff0000u);
            z[8 * j + 2 * q] = lo; z[8 * j + 2 * q + 1] = hi; ss += lo * lo + hi * hi; }
    }
    const float rstd = rsqrtf(wave_sum(ss) * (1.f / DM) + RMS_EPS);
    const float* gf = p.in[19]; float* o = p.out + (size_t)tok * DM;
#pragma unroll
    for (int j = 0; j < 2; ++j) {
        const float4 g0 = *(const float4*)(gf + 512 * j + 8 * lane), g1 = *(const float4*)(gf + 512 * j + 8 * lane + 4);
        *(float4*)(o + 512 * j + 8 * lane) = make_float4(z[8 * j] * rstd * g0.x, z[8 * j + 1] * rstd * g0.y, z[8 * j + 2] * rstd * g0.z, z[8 * j + 3] * rstd * g0.w);
        *(float4*)(o + 512 * j + 8 * lane + 4) = make_float4(z[8 * j + 4] * rstd * g1.x, z[8 * j + 5] * rstd * g1.y, z[8 * j + 6] * rstd * g1.z, z[8 * j + 7] * rstd * g1.w);
    }
}

#define LAS __attribute__((address_space(3)))
#define GAS __attribute__((address_space(1)))
typedef short bf16x8 __attribute__((ext_vector_type(8)));
typedef short s16x4 __attribute__((ext_vector_type(4)));
typedef float f32x4 __attribute__((ext_vector_type(4)));
typedef float f32x16 __attribute__((ext_vector_type(16)));
typedef float f32x2 __attribute__((ext_vector_type(2)));
typedef unsigned u32x4 __attribute__((ext_vector_type(4)));
typedef unsigned u32x2 __attribute__((ext_vector_type(2)));
typedef GAS unsigned gu32;

constexpr size_t WS_WIN_T = 2 * MiB;
constexpr size_t WS_WO_T = 6 * MiB;
constexpr size_t WS_WSP = 8 * MiB;
constexpr size_t WS_WR_T = 8 * MiB + 512 * 1024;
constexpr size_t WS_WGU_T = 10 * MiB;
constexpr size_t WS_WD_T = 42 * MiB;
constexpr int CW_TMO = 0;
constexpr int CW_BAR = 4096;

constexpr int NWAVES = 8;
constexpr int RING_BYTES = 131072;
constexpr int LDS_BYTES = 163840;
constexpr int MISC_OFF = 163840 - 1024;
constexpr float LOG2E = 1.4426950408889634f;

__device__ __forceinline__ unsigned cvt_pk_bf16(float lo, float hi) { unsigned r; asm volatile("v_cvt_pk_bf16_f32 %0, %1, %2" : "=v"(r) : "v"(lo), "v"(hi)); return r; }
#define MFMA32(a, b, c) __builtin_amdgcn_mfma_f32_32x32x16_bf16((a), (b), (c), 0, 0, 0)
#define MFMA16(a, b, c) __builtin_amdgcn_mfma_f32_16x16x32_bf16((a), (b), (c), 0, 0, 0)
typedef short v4i16_t __attribute__((ext_vector_type(4)));
__device__ __forceinline__ s16x4 vtr(const LAS unsigned char* p) { return __builtin_bit_cast(s16x4, __builtin_amdgcn_ds_read_tr16_b64_v4i16((LAS v4i16_t*)p)); }

namespace pg8 {
constexpr int BM = 256, BK = 64, HALF = 128, HTB = HALF * BK * 2, STAGE_BYTES = 8 * HTB, NXCD = 8, WGM = 8;
__host__ __device__ __forceinline__ int lds_byte(int r, int c) { const int st = (r >> 4) * 2 + (c >> 5), rr = r & 15, cc = c & 31, ob = rr * 64 + cc * 2; return st * 1024 + (ob ^ (((ob >> 9) & 1) << 5)); }
__host__ __device__ __forceinline__ void stage_rc(int b, int& R, int& C) { const int st = b / 1024, sb = b % 1024, swz = sb ^ (((sb >> 9) & 1) << 5); R = (st >> 1) * 16 + swz / 64; C = (st & 1) * 32 + (swz % 64) / 2; }
__host__ __device__ __forceinline__ int perm32(int rho) { const int n = rho >> 4, i = rho & 15; return 8 * (i >> 2) + 4 * n + (i & 3); }

struct Unit { int pm, pn, e; };
struct Gemm { const bf16_t* A; const bf16_t* Bt; int K; int pad; };

__device__ __forceinline__ int xcd_remap(int L, int nwg) { const int q = nwg / NXCD, r = nwg % NXCD, xcd = L % NXCD, off = L / NXCD; return (xcd < r ? xcd * (q + 1) : r * (q + 1) + (xcd - r) * q) + off; }

struct StaticOrder {
    int nM, nN, nwg, G, c, K;
    __device__ void init(int M, int N, int K_, int G_, int c_) { nM = M / BM; nN = N / BM; nwg = nM * nN; G = G_; c = c_; K = K_; }
    __device__ __forceinline__ bool next(int i, Unit& u) const {
        const long L = (long)i * G + c; if (L >= nwg) return false;
        const int wgid = xcd_remap((int)L, nwg);
        const int nig = WGM * nN, gid = wgid / nig, fm = gid * WGM, gsz = (nM - fm) < WGM ? (nM - fm) : WGM;
        u.pm = fm + ((wgid % nig) % gsz); u.pn = (wgid % nig) / gsz; u.e = 0; return true;
    }
    __device__ __forceinline__ size_t b_off(const Unit& u) const { return (size_t)u.pn * BM * K; }
    __device__ __forceinline__ int a_row(const Unit& u, int r) const { return u.pm * BM + r; }
};

template <class Epi, class Sched>
__device__ __forceinline__ void gemm_phase(LAS unsigned char* lds, const Gemm g, const Sched& S, const Epi& E) {
    const int tid = threadIdx.x, wid = __builtin_amdgcn_readfirstlane(tid >> 6), lane = tid & 63, wr = wid >> 2, wc = wid & 3, fr = lane & 15, fq = lane >> 4;
    const int K = g.K, nt = K / BK;
    int RA[2], CA[2]; unsigned voffB[2];
#pragma unroll
    for (int i = 0; i < 2; ++i) { int R, C; stage_rc(tid * 16 + i * 8192, R, C); const int Rb = Epi::PERM ? ((R & ~31) + perm32(R & 31)) : R;
        RA[i] = R; CA[i] = C; voffB[i] = (unsigned)(Rb * K + C) * 2u; }
    const size_t kstep = (size_t)(BK * 2);
    const size_t hstep = (size_t)HALF * K * 2;
    const unsigned ldsw = (unsigned)wid * 1024u;
    const int aoff = lds_byte(wr * 64 + fr, fq * 8), boff = lds_byte(wc * 32 + fr, fq * 8);
#define PG8_SA(b, h) (((b) * 2 + (h)) * HTB)
#define PG8_SB(b, h) ((4 + (b) * 2 + (h)) * HTB)
#define PG8_STAGE2(bufoff, gbase, v0, v1) do { \
        __builtin_amdgcn_global_load_lds((const unsigned*)((const char*)(gbase) + (v0)), (LAS unsigned*)(lds + (bufoff) + ldsw), 16, 0, 0); \
        __builtin_amdgcn_global_load_lds((const unsigned*)((const char*)(gbase) + (v1)), (LAS unsigned*)(lds + (bufoff) + ldsw + 8192), 16, 0, 0); } while (0)
#define PG8_STAGEB(bufoff, gbase) PG8_STAGE2(bufoff, gbase, voffB[0], voffB[1])
#define PG8_VOFFA(dst, U) do { _Pragma("unroll") for (int _h = 0; _h < 2; ++_h) _Pragma("unroll") for (int _i = 0; _i < 2; ++_i) \
        dst[_h][_i] = ((unsigned)S.a_row(U, _h * HALF + RA[_i]) * (unsigned)K + (unsigned)CA[_i]) * 2u; } while (0)
#define PG8_LDA(dst, b, h) do { _Pragma("unroll") for (int m = 0; m < 4; ++m) _Pragma("unroll") for (int k = 0; k < 2; ++k) dst[m][k] = *(const LAS bf16x8*)(lds + PG8_SA(b, h) + aoff + m * 2048 + k * 1024); } while (0)
#define PG8_LDB(dst, b, h) do { _Pragma("unroll") for (int n = 0; n < 2; ++n) _Pragma("unroll") for (int k = 0; k < 2; ++k) dst[n][k] = *(const LAS bf16x8*)(lds + PG8_SB(b, h) + boff + n * 2048 + k * 1024); } while (0)
#define PG8_MMA(ai, bj, At, Bt) do { __builtin_amdgcn_s_setprio(1); _Pragma("unroll") for (int m = 0; m < 4; ++m) _Pragma("unroll") for (int n = 0; n < 2; ++n) _Pragma("unroll") for (int k = 0; k < 2; ++k) \
        acc[ai][bj][m][n] = __builtin_amdgcn_mfma_f32_16x16x32_bf16(Bt[n][k], At[m][k], acc[ai][bj][m][n], 0, 0, 0); __builtin_amdgcn_s_setprio(0); } while (0)
#define PG8_WAIT_V(n) asm volatile("s_waitcnt vmcnt(" #n ")" ::: "memory")
#define PG8_WAIT_L(n) asm volatile("s_waitcnt lgkmcnt(" #n ")" ::: "memory")
#define PG8_BAR __builtin_amdgcn_s_barrier()
#define PG8_SCHED __builtin_amdgcn_sched_barrier(0)
    Unit cur, nxt; int ui = 0;
    if (!S.next(0, cur)) return;
    f32x4 acc[2][2][4][2];
#pragma unroll
    for (int a = 0; a < 2; ++a)
#pragma unroll
        for (int b = 0; b < 2; ++b)
#pragma unroll
            for (int m = 0; m < 4; ++m)
#pragma unroll
                for (int n = 0; n < 2; ++n) acc[a][b][m][n] = (f32x4){0.f, 0.f, 0.f, 0.f};
    bf16x8 At[4][2], B0[2][2], B1[2][2];
    const char* Ab = (const char*)g.A;
    const char* cB = (const char*)(g.Bt + S.b_off(cur));
    unsigned vA[2][2], nvA[2][2];
    PG8_VOFFA(vA, cur);
    PG8_STAGEB(PG8_SB(0, 0), cB); PG8_STAGEB(PG8_SB(0, 1), cB + hstep); PG8_STAGE2(PG8_SA(0, 0), Ab, vA[0][0], vA[0][1]); PG8_STAGE2(PG8_SA(0, 1), Ab, vA[1][0], vA[1][1]);
    if (wr == 1) PG8_BAR;
    PG8_WAIT_V(2); PG8_BAR;
    PG8_STAGEB(PG8_SB(1, 0), cB + kstep); PG8_STAGE2(PG8_SA(1, 0), Ab + kstep, vA[0][0], vA[0][1]); PG8_STAGEB(PG8_SB(1, 1), cB + hstep + kstep);
    PG8_WAIT_V(6); PG8_BAR;
    for (;;) {
        const bool has_next = S.next(ui + 1, nxt);
        const char* nB = cB;
#pragma unroll
        for (int h = 0; h < 2; ++h)
#pragma unroll
            for (int i = 0; i < 2; ++i) nvA[h][i] = vA[h][i];
        if (has_next) { nB = (const char*)(g.Bt + S.b_off(nxt)); PG8_VOFFA(nvA, nxt); }
        for (int t = 0; t < nt; t += 2) {
            const bool last = (t == nt - 2);
            const char* a1 = Ab + (size_t)(t + 1) * kstep;
            const char* a2 = last ? Ab : Ab + (size_t)(t + 2) * kstep; const char* b2 = last ? nB : cB + (size_t)(t + 2) * kstep;
            const char* a3 = a2 + kstep; const char* b3 = b2 + kstep;
            const unsigned o00 = last ? nvA[0][0] : vA[0][0], o01 = last ? nvA[0][1] : vA[0][1], o10 = last ? nvA[1][0] : vA[1][0], o11 = last ? nvA[1][1] : vA[1][1];
            PG8_LDB(B0, 0, 0); PG8_LDB(B1, 0, 1); PG8_SCHED; PG8_LDA(At, 0, 0); PG8_STAGE2(PG8_SA(1, 1), a1, vA[1][0], vA[1][1]);
            PG8_WAIT_V(8); PG8_WAIT_L(0); PG8_BAR; PG8_MMA(0, 0, At, B0); PG8_MMA(0, 1, At, B1); PG8_BAR; PG8_SCHED;
            PG8_LDA(At, 0, 1); PG8_STAGEB(PG8_SB(0, 0), b2); PG8_STAGEB(PG8_SB(0, 1), b2 + hstep); PG8_STAGE2(PG8_SA(0, 0), a2, o00, o01);
            PG8_WAIT_V(8); PG8_WAIT_L(0); PG8_BAR; PG8_MMA(1, 0, At, B0); PG8_MMA(1, 1, At, B1); PG8_BAR; PG8_SCHED;
            PG8_LDB(B0, 1, 0); PG8_LDB(B1, 1, 1); PG8_SCHED; PG8_LDA(At, 1, 0); PG8_STAGE2(PG8_SA(0, 1), a2, o10, o11);
            PG8_WAIT_V(8); PG8_WAIT_L(0); PG8_BAR; PG8_MMA(0, 0, At, B0); PG8_MMA(0, 1, At, B1); PG8_BAR; PG8_SCHED;
            PG8_LDA(At, 1, 1); PG8_STAGEB(PG8_SB(1, 0), b3); PG8_STAGEB(PG8_SB(1, 1), b3 + hstep); PG8_STAGE2(PG8_SA(1, 0), a3, o00, o01);
            PG8_WAIT_V(8); PG8_WAIT_L(0); PG8_BAR; PG8_MMA(1, 0, At, B0); PG8_MMA(1, 1, At, B1); PG8_BAR; PG8_SCHED;
        }
        if (wr == 0) PG8_BAR;
        E(acc, cur, wr, wc, fr, fq);
        if (!has_next) break;
#pragma unroll
        for (int a = 0; a < 2; ++a)
#pragma unroll
            for (int b = 0; b < 2; ++b)
#pragma unroll
                for (int m = 0; m < 4; ++m)
#pragma unroll
                    for (int n = 0; n < 2; ++n) acc[a][b][m][n] = (f32x4){0.f, 0.f, 0.f, 0.f};
        cur = nxt; cB = nB; ++ui;
#pragma unroll
        for (int h = 0; h < 2; ++h)
#pragma unroll
            for (int i = 0; i < 2; ++i) vA[h][i] = nvA[h][i];
        if (wr == 1) PG8_BAR;
    }
    PG8_WAIT_V(0);
    PG8_BAR;
#undef PG8_SA
#undef PG8_SB
#undef PG8_STAGE2
#undef PG8_STAGEB
#undef PG8_VOFFA
#undef PG8_LDA
#undef PG8_LDB
#undef PG8_MMA
#undef PG8_WAIT_V
#undef PG8_WAIT_L
#undef PG8_BAR
#undef PG8_SCHED
}

__device__ __forceinline__ f32x2 gelu_pk(f32x2 v) {
    const f32x2 av = __builtin_elementwise_abs(v), d = av * 0.2316418882f + 1.0f;
    f32x2 t; t.x = __builtin_amdgcn_rcpf(d.x); t.y = __builtin_amdgcn_rcpf(d.y);
    f32x2 q = t * 0.5307027145f + (-0.7265760135f); q = q * t + 0.7107068705f; q = q * t + (-0.142248368f); q = q * t + 0.127414796f; q = q * t;
    const f32x2 s = (v * v) * (-0.72134752044f);
    f32x2 e; e.x = __builtin_amdgcn_exp2f(s.x); e.y = __builtin_amdgcn_exp2f(s.y);
    const f32x2 m = v * (q * e), r = v - m;
    f32x2 o; o.x = v.x < 0.f ? m.x : r.x; o.y = v.y < 0.f ? m.y : r.y; return o;
}

struct EpiBf16G {
    static constexpr bool PERM = true;
    bf16_t* O; int ldc; int gelu_from;
    __device__ __forceinline__ void operator()(const f32x4 (&acc)[2][2][4][2], const Unit& u, int wr, int wc, int fr, int fq) const {
        const int row0 = u.pm * BM + wr * 64 + fr, col0 = u.pn * BM + wc * 32 + 8 * fq;
        const bool act = u.pn >= gelu_from;
#pragma unroll
        for (int ai = 0; ai < 2; ++ai)
#pragma unroll
            for (int m = 0; m < 4; ++m) { bf16_t* rowp = O + (size_t)(row0 + ai * HALF + m * 16) * ldc + col0;
#pragma unroll
                for (int bj = 0; bj < 2; ++bj) { f32x4 v0 = acc[ai][bj][m][0], v1 = acc[ai][bj][m][1];
                    if (act) { f32x2 a = gelu_pk((f32x2){v0[0], v0[1]}), b = gelu_pk((f32x2){v0[2], v0[3]}), c = gelu_pk((f32x2){v1[0], v1[1]}), d = gelu_pk((f32x2){v1[2], v1[3]});
                        v0 = (f32x4){a.x, a.y, b.x, b.y}; v1 = (f32x4){c.x, c.y, d.x, d.y}; }
                    u32x4 w; w.x = cvt_pk_bf16(v0[0], v0[1]); w.y = cvt_pk_bf16(v0[2], v0[3]); w.z = cvt_pk_bf16(v1[0], v1[1]); w.w = cvt_pk_bf16(v1[2], v1[3]);
                    *(u32x4*)(rowp + bj * HALF) = w; } }
    }
};
struct EpiH {
    static constexpr bool PERM = true;
    const float* x; bf16_t* HB; float* SSQ;
    __device__ __forceinline__ void operator()(const f32x4 (&acc)[2][2][4][2], const Unit& u, int wr, int wc, int fr, int fq) const {
        const int row0 = u.pm * BM + wr * 64 + fr, col0 = u.pn * BM + wc * 32 + 8 * fq;
#pragma unroll
        for (int ai = 0; ai < 2; ++ai)
#pragma unroll
            for (int m = 0; m < 4; ++m) { const int row = row0 + ai * HALF + m * 16; const float* xr = x + (size_t)row * DM + col0; bf16_t* hr = HB + (size_t)row * DM + col0; float s = 0.f;
#pragma unroll
                for (int bj = 0; bj < 2; ++bj) { const f32x4 x0 = *(const f32x4*)(xr + bj * HALF), x1 = *(const f32x4*)(xr + bj * HALF + 4);
                    const f32x4 v0 = acc[ai][bj][m][0] + x0, v1 = acc[ai][bj][m][1] + x1;
                    s += (v0[0] * v0[0] + v0[1] * v0[1]) + (v0[2] * v0[2] + v0[3] * v0[3]) + (v1[0] * v1[0] + v1[1] * v1[1]) + (v1[2] * v1[2] + v1[3] * v1[3]);
                    u32x4 w; w.x = cvt_pk_bf16(v0[0], v0[1]); w.y = cvt_pk_bf16(v0[2], v0[3]); w.z = cvt_pk_bf16(v1[0], v1[1]); w.w = cvt_pk_bf16(v1[2], v1[3]);
                    *(u32x4*)(hr + bj * HALF) = w; }
                s += __shfl_xor(s, 16); s += __shfl_xor(s, 32);
                if (fq == 0) SSQ[(size_t)row * 16 + u.pn * 4 + wc] = s; }
    }
};
}

struct MoeOrder {
    const volatile LAS int* toff;
    const int* cnt; const int* toklist;
    int nN, nwg, G, c, K, rows_per_e; bool gather;
    __device__ __forceinline__ bool next(int i, pg8::Unit& u) const {
        const long L = (long)i * G + c; if (L >= nwg) return false;
        const int wgid = pg8::xcd_remap((int)L, nwg);
        const int T = wgid / nN; u.pn = wgid % nN; u.pm = T;
        int e = 0;
        for (int j = 1; j < NEXP; ++j) e += (toff[j] <= T) ? 1 : 0;
        u.e = e; return true;
    }
    __device__ __forceinline__ size_t b_off(const pg8::Unit& u) const { return ((size_t)u.e * rows_per_e + (size_t)u.pn * 256) * K; }
    __device__ __forceinline__ int a_row(const pg8::Unit& u, int r) const {
        if (!gather) return u.pm * 256 + r;
        const int pos = (u.pm - toff[u.e]) * 256 + r;
        return pos < cnt[u.e] ? toklist[(size_t)u.e * NTOK + pos] : 0;
    }
};
struct EpiSwiglu {
    static constexpr bool PERM = true;
    bf16_t* HID; const float* rslist; const int* cnt; const volatile LAS int* toff;
    __device__ __forceinline__ void operator()(const f32x4 (&acc)[2][2][4][2], const pg8::Unit& u, int wr, int wc, int fr, int fq) const {
        const int r0 = wr * 64 + fr, col0 = u.pn * 128 + wc * 32 + 8 * fq; const int pos0 = (u.pm - toff[u.e]) * 256, n_e = cnt[u.e];
#pragma unroll
        for (int ai = 0; ai < 2; ++ai)
#pragma unroll
            for (int m = 0; m < 4; ++m) { const int r = r0 + ai * 128 + m * 16, pos = pos0 + r;
                const float rs = pos < n_e ? rslist[(size_t)u.e * NTOK + pos] : 0.f;
                float o[8];
#pragma unroll
                for (int n = 0; n < 2; ++n)
#pragma unroll
                    for (int j = 0; j < 4; ++j) { const float gt = acc[ai][0][m][n][j] * rs, up = acc[ai][1][m][n][j] * rs;
                        o[4 * n + j] = gt * __builtin_amdgcn_rcpf(1.f + __builtin_amdgcn_exp2f(-gt * LOG2E)) * up; }
                u32x4 w; w.x = cvt_pk_bf16(o[0], o[1]); w.y = cvt_pk_bf16(o[2], o[3]); w.z = cvt_pk_bf16(o[4], o[5]); w.w = cvt_pk_bf16(o[6], o[7]);
                *(u32x4*)(HID + (size_t)(u.pm * 256 + r) * DEXP + col0) = w; }
    }
};

#define XB_TMO      128
#define XB_XCNT(j)  (256  + 64 * (j))
#define XB_XSUB(j)  (1280 + 64 * (j))
#define XB_XGEN(j)  (2304 + 64 * (j))
#define XB_TOP      3328
#define XB_TOPGEN   3392
#define XCD_BAR_WORDS 3456
#define XB_SPIN_CAP (1u << 18)
__device__ __forceinline__ unsigned xb_ld(unsigned* p)              { return __hip_atomic_load(p, __ATOMIC_RELAXED, __HIP_MEMORY_SCOPE_AGENT); }
__device__ __forceinline__ unsigned xb_add(unsigned* p, unsigned v) { return __hip_atomic_fetch_add(p, v, __ATOMIC_RELAXED, __HIP_MEMORY_SCOPE_AGENT); }
__device__ __forceinline__ unsigned xb_xcc_id() { return (unsigned)__builtin_amdgcn_s_getreg((3 << 11) | 20) & 0xFu; }
#define XB_SPIN(cond, bar) do { unsigned _sp = 0; while (cond) { __builtin_amdgcn_s_sleep(1); \
    if ((++_sp & 255u) == 0u) { if (xb_ld(&(bar)[XB_TMO])) break; if (_sp > XB_SPIN_CAP) { atomicAdd(&(bar)[XB_TMO], 1u); break; } } } } while (0)
struct XcdBarrier { unsigned* bar; unsigned x; volatile LAS unsigned* st; };
__device__ __forceinline__ XcdBarrier xcd_barrier_post(unsigned* bar, volatile LAS unsigned* st) {
    XcdBarrier b; b.bar = bar; b.x = xb_xcc_id(); b.st = st;
    if (threadIdx.x == 0) (void)xb_add(&bar[XB_XCNT(b.x)], 1u);
    return b;
}
__device__ __forceinline__ void xcd_barrier_complete(unsigned* bar, unsigned x, unsigned& nloc, unsigned& nx) {
    const unsigned G = gridDim.x * gridDim.y * gridDim.z;
    unsigned sum, cnt, mine, sp = 0u;
    for (;;) {
        sum = 0u; cnt = 0u; mine = 0u;
#pragma unroll
        for (unsigned j = 0; j < 16; ++j) { const unsigned c = xb_ld(&bar[XB_XCNT(j)]); sum += c; cnt += (c > 0u) ? 1u : 0u; mine = (j == x) ? c : mine; }
        if (sum == G) break;
        __builtin_amdgcn_s_sleep(1);
        if ((++sp & 255u) == 0u) { if (xb_ld(&bar[XB_TMO])) break; if (sp > XB_SPIN_CAP) { atomicAdd(&bar[XB_TMO], 1u); break; } }
    }
    nloc = mine > 0u ? mine : 1u; nx = cnt > 0u ? cnt : 1u;
}
__device__ __forceinline__ void xcd_barrier(const XcdBarrier& b) {
    asm volatile("s_waitcnt vmcnt(0)" ::: "memory");
    __syncthreads();
    if (threadIdx.x == 0) {
        unsigned* bar = b.bar;
        __builtin_amdgcn_s_waitcnt(0);
        unsigned nloc = b.st[0], nx = b.st[1];
        if (nloc == 0u) { xcd_barrier_complete(bar, b.x, nloc, nx); b.st[0] = nloc; b.st[1] = nx; }
        const unsigned old = xb_add(&bar[XB_XSUB(b.x)], 1u);
        const unsigned gen = old / nloc;
        if (old + 1u == (gen + 1u) * nloc) {
            __builtin_amdgcn_fence(__ATOMIC_RELEASE, "agent");
            asm volatile("s_waitcnt vmcnt(0)" ::: "memory");
            const unsigned og = xb_add(&bar[XB_TOP], 1u);
            const unsigned tg = og / nx;
            if (og + 1u == (tg + 1u) * nx) xb_add(&bar[XB_TOPGEN], 1u);
            else XB_SPIN(xb_ld(&bar[XB_TOPGEN]) == tg, bar);
            __builtin_amdgcn_fence(__ATOMIC_ACQUIRE, "agent");
            xb_add(&bar[XB_XGEN(b.x)], 1u);
            asm volatile("s_waitcnt vmcnt(0)" ::: "memory");
        } else {
            XB_SPIN(xb_ld(&bar[XB_XGEN(b.x)]) == gen, bar);
            __builtin_amdgcn_fence(__ATOMIC_ACQUIRE, "agent");
            asm volatile("s_waitcnt vmcnt(0)" ::: "memory");
        }
    }
    __syncthreads();
}

struct Frame {
    LAS unsigned char* lds;
    volatile LAS unsigned* MISC;
    int tid, lane, wave, vcu, G;
    const float* const* in; float* out; unsigned char* ws;
};
#define LDS_WAIT() asm volatile("s_waitcnt lgkmcnt(0)" ::: "memory")

__device__ __forceinline__ void p0_transpose_item(const float* W, int ldw, int k0, int n0, bf16_t* WT, int ldt, int rowbase, const float* kscale, LAS float* scr, int lane) {
#pragma unroll 8
    for (int i = 0; i < 32; ++i) { const int kk = 2 * i + (lane >> 5); float v = W[(size_t)(k0 + kk) * ldw + n0 + (lane & 31)]; if (kscale) v *= kscale[k0 + kk]; scr[kk * 33 + (lane & 31)] = v; }
    LDS_WAIT(); asm volatile("" ::: "memory");
    const int c = lane & 7;
#pragma unroll
    for (int j = 0; j < 4; ++j) { const int n = (lane >> 3) + 8 * j; const LAS float* s = scr + (8 * c) * 33 + n;
        u32x4 o; o.x = cvt_pk_bf16(s[0 * 33], s[1 * 33]); o.y = cvt_pk_bf16(s[2 * 33], s[3 * 33]); o.z = cvt_pk_bf16(s[4 * 33], s[5 * 33]); o.w = cvt_pk_bf16(s[6 * 33], s[7 * 33]);
        *(u32x4*)(WT + (size_t)(rowbase + n) * ldt + k0 + 8 * c) = o; }
    LDS_WAIT(); asm volatile("" ::: "memory");
}
__device__ __forceinline__ void p0_prologue(Frame& F) {
    LAS float* scr = (LAS float*)(F.lds + F.wave * 16384);
    const int gw = F.vcu * NWAVES + F.wave, NGW = F.G * NWAVES, lane = F.lane;
    unsigned char* ws = F.ws;
    constexpr int I_IN = 16 * 56, I_OUT = 16 * 32, I_G = NEXP * 128, I_U = NEXP * 128, I_D = NEXP * 128;
    constexpr int NITEMS = I_IN + I_OUT + I_G + I_U + I_D;
    for (int it = gw; it < NITEMS; it += NGW) {
        int r = it;
        if (r < I_IN) { const int kb = r / 56, nb = r % 56; p0_transpose_item(F.in[2], NPROJ, 64 * kb, 32 * nb, (bf16_t*)(ws + WS_WIN_T), DM, 32 * nb, nullptr, scr, lane); continue; } r -= I_IN;
        if (r < I_OUT) { const int kb = r / 32, nb = r % 32; p0_transpose_item(F.in[10], DM, 64 * kb, 32 * nb, (bf16_t*)(ws + WS_WO_T), DM, 32 * nb, nullptr, scr, lane); continue; } r -= I_OUT;
        if (r < I_G + I_U) { const int up = r >= I_G; if (up) r -= I_G; const int e = r / 128, q = r % 128, kb = q / 8, nb = q % 8, n0 = 32 * nb;
            const int rowbase = e * 512 + 256 * (n0 >> 7) + (up ? 128 : 0) + (n0 & 127);
            p0_transpose_item(F.in[up ? 17 : 16] + (size_t)e * DM * DEXP, DEXP, 64 * kb, n0, (bf16_t*)(ws + WS_WGU_T), DM, rowbase, F.in[11], scr, lane); continue; } r -= I_G + I_U;
        { const int e = r / 128, q = r % 128, kb = q / 32, nb = q % 32;
            p0_transpose_item(F.in[18] + (size_t)e * DEXP * DM, DM, 64 * kb, 32 * nb, (bf16_t*)(ws + WS_WD_T), DEXP, e * DM + 32 * nb, nullptr, scr, lane); }
    }
    const int gt = F.vcu * (NWAVES * 64) + F.tid, NGT = F.G * NWAVES * 64;
    for (int i = gt; i < 8 * 128 * 128; i += NGT) { const int c = i & 127, t = (i >> 7) & 127; ((bf16_t*)(ws + WS_WSP))[i] = c <= t ? f2bf(F.in[4][i]) : (bf16_t)0; }
    for (int i = gt; i < 64 * DM; i += NGT) { const int k = i & (DM - 1), c = i >> 10; float v = 0.f;
        if (c < 4) v = F.in[12][k * 4 + c] * F.in[11][k];
        else if (c < 36) { const int g = (c - 4) >> 3, e = (c - 4) & 7; v = F.in[14][((size_t)g * DM + k) * 8 + e] * F.in[11][k]; }
        ((bf16_t*)(ws + WS_WR_T))[i] = f2bf(v); }
    for (int row = gw; row < NTOK; row += NGW) {
        const float* x = F.in[0] + (size_t)row * DM; const float* g = F.in[1]; bf16_t* xn = (bf16_t*)(ws + WS_XN) + (size_t)row * DM;
        f32x4 v[4]; float s = 0.f;
#pragma unroll
        for (int j = 0; j < 4; ++j) { v[j] = *(const f32x4*)(x + 256 * j + 4 * lane); s += (v[j][0] * v[j][0] + v[j][1] * v[j][1]) + (v[j][2] * v[j][2] + v[j][3] * v[j][3]); }
        const float rstd = rsqrtf(wave_sum(s) * (1.f / DM) + RMS_EPS);
#pragma unroll
        for (int j = 0; j < 4; ++j) { const f32x4 gg = *(const f32x4*)(g + 256 * j + 4 * lane);
            u32x2 o; o.x = cvt_pk_bf16(v[j][0] * rstd * gg[0], v[j][1] * rstd * gg[1]); o.y = cvt_pk_bf16(v[j][2] * rstd * gg[2], v[j][3] * rstd * gg[3]);
            *(u32x2*)(xn + 256 * j + 4 * lane) = o; }
    }
}

constexpr int P2_K_OFF = 0, P2_KROW = 144, P2_KHEAD = 256 * P2_KROW;
constexpr int P2_V_OFF = 2 * P2_KHEAD, P2_VHEAD = 256 * 128;
constexpr int P2_VN_OFF = 0, P2_VNROW = 1088;
constexpr int P2_EXA_OFF = 139264, P2_EXG_OFF = P2_EXA_OFF + 4096;
static_assert(P2_V_OFF + 2 * P2_VHEAD <= P2_EXA_OFF && 128 * P2_VNROW <= P2_EXA_OFF && P2_EXG_OFF + 4096 <= MISC_OFF, "P2 LDS map");

__device__ __forceinline__ void p2_mix(Frame& F) {
    const int tid = F.tid, lane = F.lane, w = F.wave;
    const int r = lane & 31, hh = lane >> 5, g4 = lane >> 4, q4 = (lane & 15) >> 2, p4 = lane & 3;
    const bf16_t* proj = (const bf16_t*)(F.ws + WS_PROJ);
    bf16_t* mixed = (bf16_t*)(F.ws + WS_MIXED);
    const bf16_t* wsp = (const bf16_t*)(F.ws + WS_WSP);
    LAS unsigned char* lds = F.lds;
    LAS float* exA = (LAS float*)(lds + P2_EXA_OFF); LAS float* exG = (LAS float*)(lds + P2_EXG_OFF);
    const float sink2 = F.in[3][w] * LOG2E;
    const float SC2 = 0.125f * LOG2E;
    for (int unit = F.vcu; unit < NTOK / 128; unit += F.G) {
        const int t0 = unit * 128; const bool first = (unit & 63) == 0;
#pragma unroll
        for (int i = 0; i < 8; ++i) { const int pc = tid + 512 * i, key = pc >> 4, sub = pc & 15, kvh = sub >> 3, piece = sub & 7;
            u32x4 kv = (u32x4){0u, 0u, 0u, 0u}, vv = (u32x4){0u, 0u, 0u, 0u};
            if (!(first && key < 128)) { const bf16_t* rowp = proj + (size_t)(t0 - 128 + key) * NPROJ; kv = *(const u32x4*)(rowp + C_K + sub * 8); vv = *(const u32x4*)(rowp + C_V + sub * 8); }
            *(LAS u32x4*)(lds + P2_K_OFF + kvh * P2_KHEAD + key * P2_KROW + piece * 16) = kv;
            *(LAS u32x4*)(lds + P2_V_OFF + kvh * P2_VHEAD + key * 128 + ((piece ^ (((key >> 1) & 1) << 2)) * 16)) = vv; }
        __syncthreads();
        {
            const int kvh = w >> 2;
            const LAS unsigned char* Kl = lds + P2_K_OFF + kvh * P2_KHEAD;
            const LAS unsigned char* Vl = lds + P2_V_OFF + kvh * P2_VHEAD;
            const int vflip = (q4 >> 1) & 1;
            const int vlane = (4 * hh + q4) * 128 + (g4 & 1) * 32 + p4 * 8;
            const int vh0 = vflip * 64, vh1 = (vflip ^ 1) * 64;
            for (int qb = 0; qb < 4; ++qb) {
                bf16x8 qf[4];
                const bf16_t* qrow = proj + (size_t)(t0 + 32 * qb + r) * NPROJ + C_Q + 64 * w + 8 * hh;
#pragma unroll
                for (int s = 0; s < 4; ++s) qf[s] = *(const bf16x8*)(qrow + 16 * s);
                f32x16 sa[5];
#pragma unroll
                for (int cc = 0; cc < 5; ++cc) {
#pragma unroll
                    for (int i = 0; i < 16; ++i) sa[cc][i] = 0.f;
                    const LAS unsigned char* kp = Kl + (32 * (qb + cc) + r) * P2_KROW + 16 * hh;
#pragma unroll
                    for (int s = 0; s < 4; ++s) { const bf16x8 kf = *(const LAS bf16x8*)(kp + 32 * s); sa[cc] = MFMA32(kf, qf[s], sa[cc]); }
                }
                const int q = 32 * qb + r; float mx = sink2;
#pragma unroll
                for (int cc = 0; cc < 5; ++cc)
#pragma unroll
                    for (int i = 0; i < 16; ++i) { const int kb = 32 * (qb + cc) + (i & 3) + 8 * (i >> 2) + 4 * hh;
                        bool ok = true; if (cc == 0) ok = kb >= q + 1; if (cc == 4) ok = kb <= q + 128; if (first) ok = ok && kb >= 128;
                        const float t = ok ? sa[cc][i] * SC2 : -1e30f; sa[cc][i] = t; mx = fmaxf(mx, t); }
                mx = fmaxf(mx, __shfl_xor(mx, 32));
                float sum = 0.f;
#pragma unroll
                for (int cc = 0; cc < 5; ++cc)
#pragma unroll
                    for (int i = 0; i < 16; ++i) { const float pe = __builtin_amdgcn_exp2f(sa[cc][i] - mx); sa[cc][i] = pe; sum += pe; }
                sum += __shfl_xor(sum, 32);
                const float inv = 1.f / (sum + __builtin_amdgcn_exp2f(sink2 - mx));
                f32x16 o[2];
#pragma unroll
                for (int i = 0; i < 16; ++i) { o[0][i] = 0.f; o[1][i] = 0.f; }
#pragma unroll
                for (int cc = 0; cc < 5; ++cc)
#pragma unroll
                    for (int s2 = 0; s2 < 2; ++s2) {
                        u32x4 pw; pw.x = cvt_pk_bf16(sa[cc][8 * s2 + 0], sa[cc][8 * s2 + 1]); pw.y = cvt_pk_bf16(sa[cc][8 * s2 + 2], sa[cc][8 * s2 + 3]);
                        pw.z = cvt_pk_bf16(sa[cc][8 * s2 + 4], sa[cc][8 * s2 + 5]); pw.w = cvt_pk_bf16(sa[cc][8 * s2 + 6], sa[cc][8 * s2 + 7]);
                        const bf16x8 pf = __builtin_bit_cast(bf16x8, pw);
                        const LAS unsigned char* vp = Vl + (32 * (qb + cc) + 16 * s2) * 128 + vlane;
#pragma unroll
                        for (int db = 0; db < 2; ++db) { const int vh = db ? vh1 : vh0; const s16x4 a0 = vtr(vp + vh), a1 = vtr(vp + 8 * 128 + vh);
                            const bf16x8 vf = (bf16x8){a0[0], a0[1], a0[2], a0[3], a1[0], a1[1], a1[2], a1[3]};
                            o[db] = MFMA32(vf, pf, o[db]); }
                    }
                float ss = 0.f;
#pragma unroll
                for (int db = 0; db < 2; ++db)
#pragma unroll
                    for (int i = 0; i < 16; ++i) { o[db][i] *= inv; ss += o[db][i] * o[db][i]; }
                ss += __shfl_xor(ss, 32);
                if (hh == 0) exA[(qb * 8 + w) * 32 + r] = ss;
                __syncthreads();
                float tot = 0.f;
#pragma unroll
                for (int j = 0; j < 8; ++j) tot += exA[(qb * 8 + j) * 32 + r];
                const float rstd = rsqrtf(tot * (1.f / 512) + RMS_EPS);
                bf16_t* orow = mixed + (size_t)(t0 + q) * DM + 64 * w + 4 * hh;
                const float* ga = F.in[8] + 64 * w + 4 * hh;
#pragma unroll
                for (int db = 0; db < 2; ++db)
#pragma unroll
                    for (int rg = 0; rg < 4; ++rg) { const f32x4 gg = *(const f32x4*)(ga + 32 * db + 8 * rg);
                        u32x2 ow; ow.x = cvt_pk_bf16(o[db][4 * rg] * rstd * gg[0], o[db][4 * rg + 1] * rstd * gg[1]); ow.y = cvt_pk_bf16(o[db][4 * rg + 2] * rstd * gg[2], o[db][4 * rg + 3] * rstd * gg[3]);
                        *(u32x2*)(orow + 32 * db + 8 * rg) = ow; }
            }
        }
        __syncthreads();
        {
            f32x4 lg0 = *(const f32x4*)(F.in[6] + 8 * lane), lg1 = *(const f32x4*)(F.in[6] + 8 * lane + 4), lb0 = *(const f32x4*)(F.in[7] + 8 * lane), lb1 = *(const f32x4*)(F.in[7] + 8 * lane + 4);
#pragma unroll 4
            for (int i = 0; i < 16; ++i) { const int tok = 16 * w + i;
                const u32x4 raw = *(const u32x4*)(proj + (size_t)(t0 + tok) * NPROJ + C_GV + 8 * lane);
                float v[8];
                v[0] = __uint_as_float(raw.x << 16); v[1] = __uint_as_float(raw.x & 0xffff0000u); v[2] = __uint_as_float(raw.y << 16); v[3] = __uint_as_float(raw.y & 0xffff0000u);
                v[4] = __uint_as_float(raw.z << 16); v[5] = __uint_as_float(raw.z & 0xffff0000u); v[6] = __uint_as_float(raw.w << 16); v[7] = __uint_as_float(raw.w & 0xffff0000u);
                float sm = 0.f;
#pragma unroll
                for (int j = 0; j < 8; ++j) sm += v[j];
                const float mu = wave_sum(sm) * (1.f / 512); float sq = 0.f;
#pragma unroll
                for (int j = 0; j < 8; ++j) { v[j] -= mu; sq += v[j] * v[j]; }
                const float rstd = rsqrtf(wave_sum(sq) * (1.f / 512) + LN_EPS);
                u32x4 ow; ow.x = cvt_pk_bf16(v[0] * rstd * lg0[0] + lb0[0], v[1] * rstd * lg0[1] + lb0[1]); ow.y = cvt_pk_bf16(v[2] * rstd * lg0[2] + lb0[2], v[3] * rstd * lg0[3] + lb0[3]);
                ow.z = cvt_pk_bf16(v[4] * rstd * lg1[0] + lb1[0], v[5] * rstd * lg1[1] + lb1[1]); ow.w = cvt_pk_bf16(v[6] * rstd * lg1[2] + lb1[2], v[7] * rstd * lg1[3] + lb1[3]);
                *(LAS u32x4*)(lds + P2_VN_OFF + tok * P2_VNROW + lane * 16) = ow; }
        }
        __syncthreads();
        {
            const LAS unsigned char* vnl = lds + P2_VN_OFF + (8 * hh + q4) * P2_VNROW + (64 * w + 16 * (g4 & 1) + 4 * p4) * 2;
            const bf16_t* wh = wsp + (size_t)w * 128 * 128;
            for (int tb = 0; tb < 4; ++tb) {
                f32x16 acc[2];
#pragma unroll
                for (int i = 0; i < 16; ++i) { acc[0][i] = 0.f; acc[1][i] = 0.f; }
                const bf16_t* wrow = wh + (size_t)(32 * tb + r) * 128 + 8 * hh;
                const int nks = 2 * tb + 2;
                for (int s = 0; s < nks; ++s) {
                    const bf16x8 wf = *(const bf16x8*)(wrow + 16 * s);
#pragma unroll
                    for (int db = 0; db < 2; ++db) { const LAS unsigned char* vp = vnl + (16 * s) * P2_VNROW + db * 64;
                        const s16x4 a0 = vtr(vp), a1 = vtr(vp + 4 * P2_VNROW);
                        const bf16x8 af = (bf16x8){a0[0], a0[1], a0[2], a0[3], a1[0], a1[1], a1[2], a1[3]};
                        acc[db] = MFMA32(af, wf, acc[db]); }
                }
                const int t = 32 * tb + r; const float bs = F.in[5][w * 128 + t];
                const bf16_t* urow = proj + (size_t)(t0 + t) * NPROJ + C_GU + 64 * w + 4 * hh;
                float ss = 0.f;
#pragma unroll
                for (int db = 0; db < 2; ++db)
#pragma unroll
                    for (int rg = 0; rg < 4; ++rg) { const u32x2 uu = *(const u32x2*)(urow + 32 * db + 8 * rg);
                        const float u0 = __uint_as_float(uu.x << 16), u1 = __uint_as_float(uu.x & 0xffff0000u), u2 = __uint_as_float(uu.y << 16), u3 = __uint_as_float(uu.y & 0xffff0000u);
                        float a = u0 * (acc[db][4 * rg] + bs), b = u1 * (acc[db][4 * rg + 1] + bs), c = u2 * (acc[db][4 * rg + 2] + bs), d = u3 * (acc[db][4 * rg + 3] + bs);
                        acc[db][4 * rg] = a; acc[db][4 * rg + 1] = b; acc[db][4 * rg + 2] = c; acc[db][4 * rg + 3] = d; ss += (a * a + b * b) + (c * c + d * d); }
                ss += __shfl_xor(ss, 32);
                if (hh == 0) exG[(tb * 8 + w) * 32 + r] = ss;
                __syncthreads();
                float tot = 0.f;
#pragma unroll
                for (int j = 0; j < 8; ++j) tot += exG[(tb * 8 + j) * 32 + r];
                const float rstd = rsqrtf(tot * (1.f / 512) + RMS_EPS);
                bf16_t* orow = mixed + (size_t)(t0 + t) * DM + 512 + 64 * w + 4 * hh;
                const float* gg_ = F.in[9] + 64 * w + 4 * hh;
#pragma unroll
                for (int db = 0; db < 2; ++db)
#pragma unroll
                    for (int rg = 0; rg < 4; ++rg) { const f32x4 gg = *(const f32x4*)(gg_ + 32 * db + 8 * rg);
                        u32x2 ow; ow.x = cvt_pk_bf16(acc[db][4 * rg] * rstd * gg[0], acc[db][4 * rg + 1] * rstd * gg[1]); ow.y = cvt_pk_bf16(acc[db][4 * rg + 2] * rstd * gg[2], acc[db][4 * rg + 3] * rstd * gg[3]);
                        *(u32x2*)(orow + 32 * db + 8 * rg) = ow; }
            }
        }
        __syncthreads();
    }
}

constexpr int P4_LG_OFF = 0, P4_CNT_OFF = 32768, P4_BASE_OFF = 32768 + 128, P4_POS_OFF = 32768 + 256;
__device__ __forceinline__ void p4_router(Frame& F) {
    const int lane = F.lane, w = F.wave, tid = F.tid;
    const bf16_t* hb = (const bf16_t*)(F.ws + WS_HB);
    const bf16_t* wr_t = (const bf16_t*)(F.ws + WS_WR_T);
    const float* ssq = (const float*)(F.ws + WS_SSQ);
    int* cntg = (int*)(F.ws + WS_CTL) + CW_CNT;
    int* tl = (int*)(F.ws + WS_TOKLIST); float* rl = (float*)(F.ws + WS_RSLIST);
    LAS float* lg = (LAS float*)(F.lds + P4_LG_OFF) + w * 16 * 48;
    LAS int* cl = (LAS int*)(F.lds + P4_CNT_OFF); LAS int* bl = (LAS int*)(F.lds + P4_BASE_OFF); LAS int* pl = (LAS int*)(F.lds + P4_POS_OFF) + w * 32;
    for (int blk = F.vcu; blk < NTOK / 128; blk += F.G) {
        const int tok0 = blk * 128 + 16 * w;
        if (tid < 32) cl[tid] = 0;
        f32x4 acc[3];
#pragma unroll
        for (int c = 0; c < 3; ++c) acc[c] = (f32x4){0.f, 0.f, 0.f, 0.f};
        const bf16_t* ap = hb + (size_t)(tok0 + (lane & 15)) * DM + 8 * (lane >> 4);
        const bf16_t* bp = wr_t + (size_t)(lane & 15) * DM + 8 * (lane >> 4);
#pragma unroll 4
        for (int s = 0; s < 32; ++s) {
            const bf16x8 a = *(const bf16x8*)(ap + 32 * s);
#pragma unroll
            for (int c = 0; c < 3; ++c) { const bf16x8 b = *(const bf16x8*)(bp + (size_t)c * 16 * DM + 32 * s); acc[c] = MFMA16(a, b, acc[c]); }
        }
#pragma unroll
        for (int c = 0; c < 3; ++c)
#pragma unroll
            for (int i = 0; i < 4; ++i) lg[(4 * (lane >> 4) + i) * 48 + 16 * c + (lane & 15)] = acc[c][i];
        __syncthreads();
        int e1 = 0, e2 = 0, l1 = 0, l2 = 0; float w1 = 0.f, w2 = 0.f, rstd = 0.f;
        if (lane < 16) {
            const int tok = tok0 + lane; const float* sp = ssq + (size_t)tok * 16; float s = 0.f;
#pragma unroll
            for (int i = 0; i < 16; ++i) s += sp[i];
            rstd = rsqrtf(s * (1.f / DM) + RMS_EPS);
            const LAS float* L = lg + lane * 48;
            float gl[4]; int gi = 0;
#pragma unroll
            for (int j = 0; j < 4; ++j) gl[j] = L[j] * rstd + F.in[13][j];
            float gm = gl[0];
#pragma unroll
            for (int j = 1; j < 4; ++j) if (gl[j] > gm) { gm = gl[j]; gi = j; }
            float den = 0.f;
#pragma unroll
            for (int j = 0; j < 4; ++j) den += __expf(gl[j] - gm);
            const float gw = 1.f / den;
            float el[8];
#pragma unroll
            for (int j = 0; j < 8; ++j) el[j] = L[4 + gi * 8 + j] * rstd + F.in[15][gi * 8 + j];
            int i1 = 0; float v1 = el[0];
#pragma unroll
            for (int j = 1; j < 8; ++j) if (el[j] > v1) { v1 = el[j]; i1 = j; }
            int i2 = 0; float v2 = -INFINITY;
#pragma unroll
            for (int j = 0; j < 8; ++j) if (j != i1 && el[j] > v2) { v2 = el[j]; i2 = j; }
            const float a1 = 1.f / (1.f + __expf(v2 - v1));
            w1 = gw * a1; w2 = gw * (1.f - a1); e1 = gi * 8 + i1; e2 = gi * 8 + i2;
            l1 = atomicAdd((int*)(cl + e1), 1); l2 = atomicAdd((int*)(cl + e2), 1);
        }
        __syncthreads();
        if (tid < 32) bl[tid] = atomicAdd(cntg + tid, (int)cl[tid]);
        __syncthreads();
        if (lane < 16) {
            const int tok = tok0 + lane; const int p1 = bl[e1] + l1, p2 = bl[e2] + l2;
            tl[(size_t)e1 * NTOK + p1] = tok; rl[(size_t)e1 * NTOK + p1] = rstd;
            tl[(size_t)e2 * NTOK + p2] = tok; rl[(size_t)e2 * NTOK + p2] = rstd;
            ((int4*)(F.ws + WS_TOKREC))[tok] = make_int4(e1, p1, e2, p2);
            ((float2*)(F.ws + WS_TOKW))[tok] = make_float2(w1, w2);
        }
        __syncthreads();
        (void)pl;
    }
}

__device__ __forceinline__ int moe_offsets(Frame& F) {
    const int* cnt = (const int*)(F.ws + WS_CTL) + CW_CNT;
    if (F.tid == 0) { int o = 0; for (int e = 0; e < NEXP; ++e) { F.MISC[16 + e] = (unsigned)o; o += (__hip_atomic_load(cnt + e, __ATOMIC_RELAXED, __HIP_MEMORY_SCOPE_AGENT) + 255) >> 8; } F.MISC[16 + NEXP] = (unsigned)o; }
    __syncthreads();
    return (int)F.MISC[16 + NEXP];
}

__device__ __forceinline__ void p7_final(Frame& F) {
    const int lane = F.lane; const int gw = F.vcu * NWAVES + F.wave, NGW = F.G * NWAVES;
    const volatile LAS int* toff = (const volatile LAS int*)(F.MISC + 16);
    const float* gf = F.in[19];
    const f32x4 g0a = *(const f32x4*)(gf + 8 * lane), g0b = *(const f32x4*)(gf + 8 * lane + 4), g1a = *(const f32x4*)(gf + 512 + 8 * lane), g1b = *(const f32x4*)(gf + 512 + 8 * lane + 4);
    for (int tok = gw; tok < NTOK; tok += NGW) {
        const int4 rec = ((const int4*)(F.ws + WS_TOKREC))[tok]; const float2 wt = ((const float2*)(F.ws + WS_TOKW))[tok];
        const int s1 = toff[rec.x] * 256 + rec.y, s2 = toff[rec.z] * 256 + rec.w;
        const bf16_t* hb = (const bf16_t*)(F.ws + WS_HB) + (size_t)tok * DM;
        const bf16_t* y1 = (const bf16_t*)(F.ws + WS_Y) + (size_t)s1 * DM; const bf16_t* y2 = (const bf16_t*)(F.ws + WS_Y) + (size_t)s2 * DM;
        float z[16]; float ss = 0.f;
#pragma unroll
        for (int j = 0; j < 2; ++j) {
            const u32x4 a = *(const u32x4*)(hb + 512 * j + 8 * lane), b = *(const u32x4*)(y1 + 512 * j + 8 * lane), c = *(const u32x4*)(y2 + 512 * j + 8 * lane);
#pragma unroll
            for (int q = 0; q < 4; ++q) {
                const float lo = __uint_as_float(a[q] << 16) + wt.x * __uint_as_float(b[q] << 16) + wt.y * __uint_as_float(c[q] << 16);
                const float hi = __uint_as_float(a[q] & 0xffff0000u) + wt.x * __uint_as_float(b[q] & 0xffff0000u) + wt.y * __uint_as_float(c[q] & 0xffff0000u);
                z[8 * j + 2 * q] = lo; z[8 * j + 2 * q + 1] = hi; ss += lo * lo + hi * hi; }
        }
        const float rstd = rsqrtf(wave_sum(ss) * (1.f / DM) + RMS_EPS);
        float* o = F.out + (size_t)tok * DM;
        *(f32x4*)(o + 8 * lane) = (f32x4){z[0] * rstd * g0a[0], z[1] * rstd * g0a[1], z[2] * rstd * g0a[2], z[3] * rstd * g0a[3]};
        *(f32x4*)(o + 8 * lane + 4) = (f32x4){z[4] * rstd * g0b[0], z[5] * rstd * g0b[1], z[6] * rstd * g0b[2], z[7] * rstd * g0b[3]};
        *(f32x4*)(o + 512 + 8 * lane) = (f32x4){z[8] * rstd * g1a[0], z[9] * rstd * g1a[1], z[10] * rstd * g1a[2], z[11] * rstd * g1a[3]};
        *(f32x4*)(o + 512 + 8 * lane + 4) = (f32x4){z[12] * rstd * g1b[0], z[13] * rstd * g1b[1], z[14] * rstd * g1b[2], z[15] * rstd * g1b[3]};
    }
}

struct Args { const float* in[20]; float* out; unsigned char* ws; int ph_lo, ph_hi, li, pad; };
constexpr int N_PHASES = 8;
__global__ void __launch_bounds__(NWAVES * 64, 2) mk_fwd(Args args) {
    extern __shared__ __attribute__((aligned(16))) unsigned char lds_raw[];
    Frame F;
    F.lds = (LAS unsigned char*)lds_raw;
    F.MISC = (volatile LAS unsigned*)(F.lds + MISC_OFF);
    F.tid = threadIdx.x; F.lane = F.tid & 63; F.wave = __builtin_amdgcn_readfirstlane(F.tid >> 6);
    F.G = gridDim.x; { const int bx = blockIdx.x; F.vcu = (F.G % 8 == 0) ? (bx % 8) * (F.G / 8) + bx / 8 : bx; }
    F.in = args.in; F.out = args.out; F.ws = args.ws;
    unsigned char* ws = args.ws;
    for (int u = F.tid; u < 256; u += NWAVES * 64) F.MISC[u] = 0u;
    __syncthreads();
    const int lo = args.ph_lo, hi = args.ph_hi;
    XcdBarrier bar; bar.bar = (unsigned*)(ws + WS_CTL) + CW_BAR + args.li * XCD_BAR_WORDS; bar.x = 0; bar.st = nullptr;
    if (hi - lo > 1) bar = xcd_barrier_post((unsigned*)(ws + WS_CTL) + CW_BAR + args.li * XCD_BAR_WORDS, F.MISC + 8);
#define IN(k) (lo <= (k) && (k) < hi)
#define SEAM(k) do { if (IN(k) && IN((k) + 1)) xcd_barrier(bar); } while (0)
    if (IN(0)) { p0_prologue(F); SEAM(0); }
    if (IN(1)) {
        pg8::Gemm g{(const bf16_t*)(ws + WS_XN), (const bf16_t*)(ws + WS_WIN_T), DM, 0}; pg8::StaticOrder S; S.init(NTOK, NPROJ, DM, F.G, (int)blockIdx.x);
        pg8::EpiBf16G E{(bf16_t*)(ws + WS_PROJ), NPROJ, 3};
        pg8::gemm_phase<pg8::EpiBf16G, pg8::StaticOrder>(F.lds, g, S, E);
        SEAM(1);
    }
    if (IN(2)) { p2_mix(F); SEAM(2); }
    if (IN(3)) {
        pg8::Gemm g{(const bf16_t*)(ws + WS_MIXED), (const bf16_t*)(ws + WS_WO_T), DM, 0}; pg8::StaticOrder S; S.init(NTOK, DM, DM, F.G, (int)blockIdx.x);
        pg8::EpiH E{args.in[0], (bf16_t*)(ws + WS_HB), (float*)(ws + WS_SSQ)};
        pg8::gemm_phase<pg8::EpiH, pg8::StaticOrder>(F.lds, g, S, E);
        SEAM(3);
    }
    if (IN(4)) { p4_router(F); SEAM(4); }
    if (IN(5) || IN(6) || IN(7)) {
        const int ntiles = moe_offsets(F);
        const volatile LAS int* toff = (const volatile LAS int*)(F.MISC + 16);
        const int* cnt = (const int*)(ws + WS_CTL) + CW_CNT;
        if (IN(5)) {
            pg8::Gemm g{(const bf16_t*)(ws + WS_HB), (const bf16_t*)(ws + WS_WGU_T), DM, 0};
            MoeOrder S{toff, cnt, (const int*)(ws + WS_TOKLIST), 2, ntiles * 2, F.G, (int)blockIdx.x, DM, 512, true};
            EpiSwiglu E{(bf16_t*)(ws + WS_HID), (const float*)(ws + WS_RSLIST), cnt, toff};
            pg8::gemm_phase<EpiSwiglu, MoeOrder>(F.lds, g, S, E);
            SEAM(5);
        }
        if (IN(6)) {
            pg8::Gemm g{(const bf16_t*)(ws + WS_HID), (const bf16_t*)(ws + WS_WD_T), DEXP, 0};
            MoeOrder S{toff, cnt, (const int*)(ws + WS_TOKLIST), 4, ntiles * 4, F.G, (int)blockIdx.x, DEXP, DM, false};
            pg8::EpiBf16G E{(bf16_t*)(ws + WS_Y), DM, 1000};
            pg8::gemm_phase<pg8::EpiBf16G, MoeOrder>(F.lds, g, S, E);
            SEAM(6);
        }
        if (IN(7)) p7_final(F);
    }
#undef IN
#undef SEAM
}
#ifndef MK_MASK
#define MK_MASK 0xFF
#endif
extern "C" void kernel_launch(void* const* d_in, const int* in_sizes, int n_in, void* d_out, int out_size, void* d_ws, size_t ws_size, hipStream_t stream) {
    static int grid = 0;
    if (grid == 0) {
        if (n_in != 20 || in_sizes[0] != NTOK * DM || out_size != NTOK * DM || ws_size < WS_END) {
            fprintf(stderr, "kernel_launch: unexpected shapes (n_in %d, in0 %d, out %d, ws %zu)\n", n_in, n_in > 0 ? in_sizes[0] : -1, out_size, ws_size); grid = -1; return; }
        int dev = 0, cus = 0, per_cu = 0;
        if (hipGetDevice(&dev) != hipSuccess || hipDeviceGetAttribute(&cus, hipDeviceAttributeMultiprocessorCount, dev) != hipSuccess) { fprintf(stderr, "kernel_launch: device query failed\n"); grid = -1; return; }
        if (hipFuncSetAttribute((const void*)mk_fwd, hipFuncAttributeMaxDynamicSharedMemorySize, LDS_BYTES) != hipSuccess) { fprintf(stderr, "kernel_launch: hipFuncSetAttribute(%d B LDS) failed\n", LDS_BYTES); grid = -1; return; }
        if (hipOccupancyMaxActiveBlocksPerMultiprocessor(&per_cu, (const void*)mk_fwd, NWAVES * 64, LDS_BYTES) != hipSuccess || per_cu < 1)
            fprintf(stderr, "kernel_launch: note: occupancy query reports %d workgroups per CU\n", per_cu);
        (void)hipGetLastError();
        grid = cus;
    }
    if (grid < 0) return;
    Params p{};
    for (int i = 0; i < 20; ++i) p.in[i] = (const float*)d_in[i];
    p.out = (float*)d_out; p.ws = (unsigned char*)d_ws;
    unsigned char* ws = p.ws;
    (void)hipMemsetAsync(ws + WS_CTL, 0, CTL_ZERO_BYTES, stream);
    const int* cnt = (const int*)(ws + WS_CTL) + CW_CNT;
    Args a{};
    for (int i = 0; i < 20; ++i) a.in[i] = (const float*)d_in[i];
    a.out = (float*)d_out; a.ws = ws;
    int li = 0;
    for (int ph = 0; ph < N_PHASES;) {
        if ((MK_MASK >> ph) & 1) {
            int hi = ph; while (hi < N_PHASES && ((MK_MASK >> hi) & 1)) ++hi;
            a.ph_lo = ph; a.ph_hi = hi; a.li = li++;
            hipLaunchKernelGGL(mk_fwd, dim3(grid), dim3(NWAVES * 64), LDS_BYTES, stream, a);
            ph = hi; continue;
        }
        switch (ph) {
        case 0: k_xn<<<NTOK / 4, 256, 0, stream>>>(p); break;
        case 1: k_gemm_naive<<<dim3(NPROJ / 64, NTOK / 64, 1), 256, 0, stream>>>(AL_bf16{(const bf16_t*)(ws + WS_XN), DM, 0}, BL_f32{p.in[2], NPROJ, 0}, EP_proj{(bf16_t*)(ws + WS_PROJ)}, DM, 0); break;
        case 2:
            k_attn_naive<<<dim3(NTOK / 128, 8), 128, 0, stream>>>(p);
            k_rms512<<<NTOK / 4, 256, 0, stream>>>((const float*)(ws + WS_AF), p.in[8], (bf16_t*)(ws + WS_MIXED), 0, 0);
            k_ln_v<<<NTOK / 4, 256, 0, stream>>>(p);
            k_gmlp_naive<<<dim3(NTOK / 128, 8), 256, 0, stream>>>(p);
            k_rms512<<<NTOK / 4, 256, 0, stream>>>((const float*)(ws + WS_AF), p.in[9], (bf16_t*)(ws + WS_MIXED), 512, 0);
            break;
        case 3:
            k_gemm_naive<<<dim3(DM / 64, NTOK / 64, 1), 256, 0, stream>>>(AL_bf16{(const bf16_t*)(ws + WS_MIXED), DM, 0}, BL_f32{p.in[10], DM, 0}, EP_h{p.in[0], (float*)(ws + WS_HF)}, DM, 0);
            k_h_finish<<<NTOK / 4, 256, 0, stream>>>(p);
            break;
        case 4: k_router_naive<<<NTOK, 64, 0, stream>>>(p); break;
        case 5: {
            float* GU = (float*)(ws + WS_PROJ);
            k_gemm_naive<<<dim3(512 / 64, NTOK / 64, NEXP), 256, 0, stream>>>(AL_moe_in{(const bf16_t*)(ws + WS_HB), p.in[11], cnt, (const int*)(ws + WS_TOKLIST)}, BL_gu{p.in[16], p.in[17]}, EP_gu{GU, cnt}, DM, 0);
            k_swiglu_naive<<<dim3(NTOK, NEXP), 256, 0, stream>>>(p, GU);
            break; }
        case 6: k_gemm_naive<<<dim3(DM / 64, NTOK / 64, NEXP), 256, 0, stream>>>(AL_hid{(const bf16_t*)(ws + WS_HID), cnt}, BL_down{p.in[18]}, EP_y{(bf16_t*)(ws + WS_Y), cnt}, DEXP, 0); break;
        case 7: k_final<<<NTOK / 4, 256, 0, stream>>>(p); break;
        }
        ++ph;
    }
}
```

```cpp
#include <hip/hip_runtime.h>
#include <cstdio>
#include <cstdint>
#include <cmath>

constexpr int BATCH = 4, SEQ = 8192, DM = 1024, NTOK = BATCH * SEQ;
constexpr int NPROJ = 1792;
constexpr int C_Q = 0, C_K = 512, C_V = 640, C_GU = 768, C_GV = 1280;
constexpr int NEXP = 32, DEXP = 256, NGRP = 4, EPG = 8;
constexpr int SLOT_CAP = 2 * NTOK + NEXP * 256;
constexpr float RMS_EPS = 1e-6f, LN_EPS = 1e-5f;

typedef unsigned short bf16_t;
__device__ __forceinline__ float bf2f(bf16_t v) { return __uint_as_float((unsigned)v << 16); }
__device__ __forceinline__ bf16_t f2bf(float f) { unsigned u = __float_as_uint(f); return (bf16_t)((u + 0x7fffu + ((u >> 16) & 1u)) >> 16); }

constexpr size_t MiB = 1u << 20;
constexpr size_t WS_CTL = 0, CTL_ZERO_BYTES = 1 * MiB;
constexpr size_t WS_TOKLIST = 58 * MiB;
constexpr size_t WS_RSLIST = 62 * MiB;
constexpr size_t WS_TOKREC = 66 * MiB;
constexpr size_t WS_TOKW = 67 * MiB;
constexpr size_t WS_SSQ = 68 * MiB;
constexpr size_t WS_XN = 72 * MiB;
constexpr size_t WS_PROJ = 136 * MiB;
constexpr size_t WS_MIXED = 248 * MiB;
constexpr size_t WS_HB = 312 * MiB;
constexpr size_t WS_HID = 376 * MiB;
constexpr size_t WS_Y = 72 * MiB;
constexpr size_t WS_AF = 412 * MiB;
constexpr size_t WS_VN = 72 * MiB;
constexpr size_t WS_HF = 376 * MiB;
constexpr size_t WS_END = 512 * MiB;
constexpr int CW_CNT = 64;

struct Params {
    const float* in[20];
    float* out;
    unsigned char* ws;
};

__device__ __forceinline__ float wave_sum(float v) {
#pragma unroll
    for (int o = 1; o < 64; o <<= 1) v += __shfl_xor(v, o);
    return v;
}
__device__ __forceinline__ float gelu_exact(float v) { return 0.5f * v * (1.0f + erff(v * 0.70710678118654752f)); }

#define LAS __attribute__((address_space(3)))
#define GAS __attribute__((address_space(1)))
typedef short bf16x8 __attribute__((ext_vector_type(8)));
typedef short s16x4 __attribute__((ext_vector_type(4)));
typedef float f32x4 __attribute__((ext_vector_type(4)));
typedef float f32x16 __attribute__((ext_vector_type(16)));
typedef float f32x2 __attribute__((ext_vector_type(2)));
typedef unsigned u32x4 __attribute__((ext_vector_type(4)));
typedef unsigned u32x2 __attribute__((ext_vector_type(2)));
typedef GAS unsigned gu32;

constexpr size_t WS_WIN_T = 2 * MiB;
constexpr size_t WS_WO_T = 6 * MiB;
constexpr size_t WS_WSP = 8 * MiB;
constexpr size_t WS_WR_T = 8 * MiB + 512 * 1024;
constexpr size_t WS_WGU_T = 10 * MiB;
constexpr size_t WS_WD_T = 42 * MiB;
constexpr int CW_TMO = 0;
constexpr int CW_BAR = 4096;

constexpr int NWAVES = 8;
constexpr int RING_BYTES = 131072;
constexpr int LDS_BYTES = 163840;
constexpr int MISC_OFF = 163840 - 1024;
constexpr float LOG2E = 1.4426950408889634f;

__device__ __forceinline__ unsigned cvt_pk_bf16(float lo, float hi) { unsigned r; asm volatile("v_cvt_pk_bf16_f32 %0, %1, %2" : "=v"(r) : "v"(lo), "v"(hi)); return r; }
#define MFMA32(a, b, c) __builtin_amdgcn_mfma_f32_32x32x16_bf16((a), (b), (c), 0, 0, 0)
#define MFMA16(a, b, c) __builtin_amdgcn_mfma_f32_16x16x32_bf16((a), (b), (c), 0, 0, 0)
typedef short v4i16_t __attribute__((ext_vector_type(4)));
__device__ __forceinline__ s16x4 vtr(const LAS unsigned char* p) { return __builtin_bit_cast(s16x4, __builtin_amdgcn_ds_read_tr16_b64_v4i16((LAS v4i16_t*)p)); }

namespace pg8 {
constexpr int BM = 256, BK = 64, HALF = 128, HTB = HALF * BK * 2, STAGE_BYTES = 8 * HTB, NXCD = 8, WGM = 8;
__host__ __device__ __forceinline__ int lds_byte(int r, int c) { const int st = (r >> 4) * 2 + (c >> 5), rr = r & 15, cc = c & 31, ob = rr * 64 + cc * 2; return st * 1024 + (ob ^ (((ob >> 9) & 1) << 5)); }
__host__ __device__ __forceinline__ void stage_rc(int b, int& R, int& C) { const int st = b / 1024, sb = b % 1024, swz = sb ^ (((sb >> 9) & 1) << 5); R = (st >> 1) * 16 + swz / 64; C = (st & 1) * 32 + (swz % 64) / 2; }
__host__ __device__ __forceinline__ int perm32(int rho) { const int n = rho >> 4, i = rho & 15; return 8 * (i >> 2) + 4 * n + (i & 3); }

struct Unit { int pm, pn, e, pos0, ne, nv; };
struct Gemm { const bf16_t* A; const bf16_t* Bt; int K; int pad; };

__device__ __forceinline__ int xcd_remap(int L, int nwg) { const int q = nwg / NXCD, r = nwg % NXCD, xcd = L % NXCD, off = L / NXCD; return (xcd < r ? xcd * (q + 1) : r * (q + 1) + (xcd - r) * q) + off; }

struct StaticOrder {
    int nM, nN, nwg, G, c, K;
    __device__ void init(int M, int N, int K_, int G_, int c_) { nM = M / BM; nN = N / BM; nwg = nM * nN; G = G_; c = c_; K = K_; }
    __device__ __forceinline__ bool next(int i, Unit& u) const {
        const long L = (long)i * G + c; if (L >= nwg) return false;
        const int wgid = xcd_remap((int)L, nwg);
        const int nig = WGM * nN, gid = wgid / nig, fm = gid * WGM, gsz = (nM - fm) < WGM ? (nM - fm) : WGM;
        u.pm = fm + ((wgid % nig) % gsz); u.pn = (wgid % nig) / gsz; u.e = 0; u.pos0 = 0; u.ne = 0; u.nv = BM; return true;
    }
    __device__ __forceinline__ size_t b_off(const Unit& u) const { return (size_t)u.pn * BM * K; }
    __device__ __forceinline__ int a_row(const Unit& u, int r) const { return u.pm * BM + r; }
};

template <class Epi, class Sched>
__device__ __forceinline__ void gemm_phase(LAS unsigned char* lds, const Gemm g, const Sched& S, const Epi& E) {
    const int tid = threadIdx.x, wid = __builtin_amdgcn_readfirstlane(tid >> 6), lane = tid & 63, wr = wid >> 2, wc = wid & 3, fr = lane & 15, fq = lane >> 4;
    const int K = g.K, nt = K / BK;
    unsigned voffB[2];
#pragma unroll
    for (int i = 0; i < 2; ++i) { int R, C; stage_rc(tid * 16 + i * 8192, R, C); const int Rb = Epi::PERM ? ((R & ~31) + perm32(R & 31)) : R;
        voffB[i] = (unsigned)(Rb * K + C) * 2u; }
    const size_t kstep = (size_t)(BK * 2);
    const size_t hstep = (size_t)HALF * K * 2;
    const unsigned ldsw = (unsigned)wid * 1024u;
    const int aoff = lds_byte(wr * 64 + fr, fq * 8), boff = lds_byte(wc * 32 + fr, fq * 8);
#define PG8_SA(b, h) (((b) * 2 + (h)) * HTB)
#define PG8_SB(b, h) ((4 + (b) * 2 + (h)) * HTB)
#define PG8_STAGE2(bufoff, gbase, v0, v1) do { \
        __builtin_amdgcn_global_load_lds((const unsigned*)((const char*)(gbase) + (v0)), (LAS unsigned*)(lds + (bufoff) + ldsw), 16, 0, 0); \
        __builtin_amdgcn_global_load_lds((const unsigned*)((const char*)(gbase) + (v1)), (LAS unsigned*)(lds + (bufoff) + ldsw + 8192), 16, 0, 0); } while (0)
#define PG8_STAGEB(bufoff, gbase) PG8_STAGE2(bufoff, gbase, voffB[0], voffB[1])
#define PG8_VOFFA(dst, U) do { _Pragma("unroll") for (int _i = 0; _i < 2; ++_i) { int _R, _C; stage_rc(threadIdx.x * 16 + _i * 8192, _R, _C); _Pragma("unroll") for (int _h = 0; _h < 2; ++_h) \
        dst[_h][_i] = ((unsigned)S.a_row(U, _h * HALF + _R) * (unsigned)K + (unsigned)_C) * 2u; } } while (0)
#define PG8_LDA(dst, b, h) do { _Pragma("unroll") for (int m = 0; m < 4; ++m) _Pragma("unroll") for (int k = 0; k < 2; ++k) dst[m][k] = *(const LAS bf16x8*)(lds + PG8_SA(b, h) + aoff + m * 2048 + k * 1024); } while (0)
#define PG8_LDB(dst, b, h) do { _Pragma("unroll") for (int n = 0; n < 2; ++n) _Pragma("unroll") for (int k = 0; k < 2; ++k) dst[n][k] = *(const LAS bf16x8*)(lds + PG8_SB(b, h) + boff + n * 2048 + k * 1024); } while (0)
#define PG8_MMA(ai, bj, At, Bt) do { if ((ai) * HALF + wr * 64 < cur.nv) { __builtin_amdgcn_s_setprio(1); _Pragma("unroll") for (int m = 0; m < 4; ++m) _Pragma("unroll") for (int n = 0; n < 2; ++n) _Pragma("unroll") for (int k = 0; k < 2; ++k) \
        acc[ai][bj][m][n] = __builtin_amdgcn_mfma_f32_16x16x32_bf16(Bt[n][k], At[m][k], acc[ai][bj][m][n], 0, 0, 0); __builtin_amdgcn_s_setprio(0); } } while (0)
#define PG8_WAIT_V(n) asm volatile("s_waitcnt vmcnt(" #n ")" ::: "memory")
#define PG8_WAIT_L(n) asm volatile("s_waitcnt lgkmcnt(" #n ")" ::: "memory")
#define PG8_BAR __builtin_amdgcn_s_barrier()
#define PG8_SCHED __builtin_amdgcn_sched_barrier(0)
    Unit cur, nxt; int ui = 0;
    if (!S.next(0, cur)) return;
    f32x4 acc[2][2][4][2];
#pragma unroll
    for (int a = 0; a < 2; ++a)
#pragma unroll
        for (int b = 0; b < 2; ++b)
#pragma unroll
            for (int m = 0; m < 4; ++m)
#pragma unroll
                for (int n = 0; n < 2; ++n) acc[a][b][m][n] = (f32x4){0.f, 0.f, 0.f, 0.f};
    bf16x8 At[4][2], B0[2][2], B1[2][2];
    const char* Ab = (const char*)g.A;
    const char* cB = (const char*)(g.Bt + S.b_off(cur));
    unsigned vA[2][2], nvA[2][2];
    PG8_VOFFA(vA, cur);
    PG8_STAGEB(PG8_SB(0, 0), cB); PG8_STAGEB(PG8_SB(0, 1), cB + hstep); PG8_STAGE2(PG8_SA(0, 0), Ab, vA[0][0], vA[0][1]); PG8_STAGE2(PG8_SA(0, 1), Ab, vA[1][0], vA[1][1]);
    if (wr == 1) PG8_BAR;
    PG8_WAIT_V(2); PG8_BAR;
    PG8_STAGEB(PG8_SB(1, 0), cB + kstep); PG8_STAGE2(PG8_SA(1, 0), Ab + kstep, vA[0][0], vA[0][1]); PG8_STAGEB(PG8_SB(1, 1), cB + hstep + kstep);
    PG8_WAIT_V(6); PG8_BAR;
    for (;;) {
        const bool has_next = S.next(ui + 1, nxt);
        const char* nB = cB;
#pragma unroll
        for (int h = 0; h < 2; ++h)
#pragma unroll
            for (int i = 0; i < 2; ++i) nvA[h][i] = vA[h][i];
        if (has_next) { nB = (const char*)(g.Bt + S.b_off(nxt)); PG8_VOFFA(nvA, nxt); }
        for (int t = 0; t < nt; t += 2) {
            const bool last = (t == nt - 2);
            const char* a1 = Ab + (size_t)(t + 1) * kstep;
            const char* a2 = last ? Ab : Ab + (size_t)(t + 2) * kstep; const char* b2 = last ? nB : cB + (size_t)(t + 2) * kstep;
            const char* a3 = a2 + kstep; const char* b3 = b2 + kstep;
            unsigned o00 = vA[0][0], o01 = vA[0][1], o10 = vA[1][0], o11 = vA[1][1];
            if (last) { asm volatile("" : "+v"(nvA[0][0]), "+v"(nvA[0][1]), "+v"(nvA[1][0]), "+v"(nvA[1][1])); o00 = nvA[0][0]; o01 = nvA[0][1]; o10 = nvA[1][0]; o11 = nvA[1][1]; }
            PG8_LDB(B0, 0, 0); PG8_LDB(B1, 0, 1); PG8_SCHED; PG8_LDA(At, 0, 0); PG8_STAGE2(PG8_SA(1, 1), a1, vA[1][0], vA[1][1]);
            PG8_WAIT_V(8); PG8_WAIT_L(0); PG8_BAR; PG8_MMA(0, 0, At, B0); PG8_MMA(0, 1, At, B1); PG8_BAR; PG8_SCHED;
            PG8_LDA(At, 0, 1); PG8_STAGEB(PG8_SB(0, 0), b2); PG8_STAGEB(PG8_SB(0, 1), b2 + hstep); PG8_STAGE2(PG8_SA(0, 0), a2, o00, o01);
            PG8_WAIT_V(8); PG8_WAIT_L(0); PG8_BAR; PG8_MMA(1, 0, At, B0); PG8_MMA(1, 1, At, B1); PG8_BAR; PG8_SCHED;
            PG8_LDB(B0, 1, 0); PG8_LDB(B1, 1, 1); PG8_SCHED; PG8_LDA(At, 1, 0); PG8_STAGE2(PG8_SA(0, 1), a2, o10, o11);
            PG8_WAIT_V(8); PG8_WAIT_L(0); PG8_BAR; PG8_MMA(0, 0, At, B0); PG8_MMA(0, 1, At, B1); PG8_BAR; PG8_SCHED;
            PG8_LDA(At, 1, 1); PG8_STAGEB(PG8_SB(1, 0), b3); PG8_STAGEB(PG8_SB(1, 1), b3 + hstep); PG8_STAGE2(PG8_SA(1, 0), a3, o00, o01);
            PG8_WAIT_V(8); PG8_WAIT_L(0); PG8_BAR; PG8_MMA(1, 0, At, B0); PG8_MMA(1, 1, At, B1); PG8_BAR; PG8_SCHED;
        }
        if (wr == 0) PG8_BAR;
        E(acc, cur, wr, wc, fr, fq);
        if (!has_next) break;
#pragma unroll
        for (int a = 0; a < 2; ++a)
#pragma unroll
            for (int b = 0; b < 2; ++b)
#pragma unroll
                for (int m = 0; m < 4; ++m)
#pragma unroll
                    for (int n = 0; n < 2; ++n) acc[a][b][m][n] = (f32x4){0.f, 0.f, 0.f, 0.f};
        cur = nxt; cB = nB; ++ui;
#pragma unroll
        for (int h = 0; h < 2; ++h)
#pragma unroll
            for (int i = 0; i < 2; ++i) vA[h][i] = nvA[h][i];
        if (wr == 1) PG8_BAR;
    }
    PG8_WAIT_V(0);
    PG8_BAR;
#undef PG8_SA
#undef PG8_SB
#undef PG8_STAGE2
#undef PG8_STAGEB
#undef PG8_VOFFA
#undef PG8_LDA
#undef PG8_LDB
#undef PG8_MMA
#undef PG8_WAIT_V
#undef PG8_WAIT_L
#undef PG8_BAR
#undef PG8_SCHED
}

__device__ __forceinline__ f32x2 gelu_pk(f32x2 v) {
    const f32x2 av = __builtin_elementwise_abs(v), d = av * 0.2316418882f + 1.0f;
    f32x2 t; t.x = __builtin_amdgcn_rcpf(d.x); t.y = __builtin_amdgcn_rcpf(d.y);
    f32x2 q = t * 0.5307027145f + (-0.7265760135f); q = q * t + 0.7107068705f; q = q * t + (-0.142248368f); q = q * t + 0.127414796f; q = q * t;
    const f32x2 s = (v * v) * (-0.72134752044f);
    f32x2 e; e.x = __builtin_amdgcn_exp2f(s.x); e.y = __builtin_amdgcn_exp2f(s.y);
    const f32x2 m = v * (q * e), r = v - m;
    f32x2 o; o.x = v.x < 0.f ? m.x : r.x; o.y = v.y < 0.f ? m.y : r.y; return o;
}

struct EpiBf16G {
    static constexpr bool PERM = true;
    bf16_t* O; int ldc; int gelu_from; f32x2* STAT; int stat_from; int pad;
    __device__ __forceinline__ void operator()(const f32x4 (&acc)[2][2][4][2], const Unit& u, int wr, int wc, int fr, int fq) const {
        const int row0 = u.pm * BM + wr * 64 + fr, col0 = u.pn * BM + wc * 32 + 8 * fq, rl0 = wr * 64 + fr;
        const bool act = u.pn >= gelu_from, st = u.pn >= stat_from;
#pragma unroll
        for (int ai = 0; ai < 2; ++ai)
#pragma unroll
            for (int m = 0; m < 4; ++m) { bf16_t* rowp = O + (size_t)(row0 + ai * HALF + m * 16) * ldc + col0; float s1 = 0.f, s2 = 0.f;
                const bool live = rl0 + ai * HALF + m * 16 < u.nv;
#pragma unroll
                for (int bj = 0; bj < 2; ++bj) { f32x4 v0 = acc[ai][bj][m][0], v1 = acc[ai][bj][m][1];
                    if (act) { f32x2 a = gelu_pk((f32x2){v0[0], v0[1]}), b = gelu_pk((f32x2){v0[2], v0[3]}), c = gelu_pk((f32x2){v1[0], v1[1]}), d = gelu_pk((f32x2){v1[2], v1[3]});
                        v0 = (f32x4){a.x, a.y, b.x, b.y}; v1 = (f32x4){c.x, c.y, d.x, d.y}; }
                    if (st) { s1 += (v0[0] + v0[1]) + (v0[2] + v0[3]) + (v1[0] + v1[1]) + (v1[2] + v1[3]);
                        s2 += (v0[0] * v0[0] + v0[1] * v0[1]) + (v0[2] * v0[2] + v0[3] * v0[3]) + (v1[0] * v1[0] + v1[1] * v1[1]) + (v1[2] * v1[2] + v1[3] * v1[3]); }
                    u32x4 w; w.x = cvt_pk_bf16(v0[0], v0[1]); w.y = cvt_pk_bf16(v0[2], v0[3]); w.z = cvt_pk_bf16(v1[0], v1[1]); w.w = cvt_pk_bf16(v1[2], v1[3]);
                    if (live) *(u32x4*)(rowp + bj * HALF) = w; }
                if (st) { s1 += __shfl_xor(s1, 16); s1 += __shfl_xor(s1, 32); s2 += __shfl_xor(s2, 16); s2 += __shfl_xor(s2, 32);
                    if (fq == 0) STAT[(size_t)(row0 + ai * HALF + m * 16) * 8 + (u.pn - stat_from) * 4 + wc] = (f32x2){s1, s2}; } }
    }
};
struct EpiH {
    static constexpr bool PERM = true;
    const float* x; bf16_t* HB; float* SSQ;
    __device__ __forceinline__ void operator()(const f32x4 (&acc)[2][2][4][2], const Unit& u, int wr, int wc, int fr, int fq) const {
        const int row0 = u.pm * BM + wr * 64 + fr, col0 = u.pn * BM + wc * 32 + 8 * fq;
#pragma unroll
        for (int ai = 0; ai < 2; ++ai)
#pragma unroll
            for (int m = 0; m < 4; ++m) { const int row = row0 + ai * HALF + m * 16; const float* xr = x + (size_t)row * DM + col0; bf16_t* hr = HB + (size_t)row * DM + col0; float s = 0.f;
#pragma unroll
                for (int bj = 0; bj < 2; ++bj) { const f32x4 x0 = __builtin_nontemporal_load((const f32x4*)(xr + bj * HALF)), x1 = __builtin_nontemporal_load((const f32x4*)(xr + bj * HALF + 4));
                    const f32x4 v0 = acc[ai][bj][m][0] + x0, v1 = acc[ai][bj][m][1] + x1;
                    s += (v0[0] * v0[0] + v0[1] * v0[1]) + (v0[2] * v0[2] + v0[3] * v0[3]) + (v1[0] * v1[0] + v1[1] * v1[1]) + (v1[2] * v1[2] + v1[3] * v1[3]);
                    u32x4 w; w.x = cvt_pk_bf16(v0[0], v0[1]); w.y = cvt_pk_bf16(v0[2], v0[3]); w.z = cvt_pk_bf16(v1[0], v1[1]); w.w = cvt_pk_bf16(v1[2], v1[3]);
                    *(u32x4*)(hr + bj * HALF) = w; }
                s += __shfl_xor(s, 16); s += __shfl_xor(s, 32);
                if (fq == 0) SSQ[(size_t)row * 16 + u.pn * 4 + wc] = s; }
    }
};
}

template <bool GATHER>
struct MoeOrder {
    const volatile LAS int* toff;
    const int* cnt; const int* toklist;
    int nN, nwg, G, c, K, rows_per_e;
    __device__ __forceinline__ bool next(int i, pg8::Unit& u) const {
        const long L = (long)i * G + c; if (L >= nwg) return false;
        const int wgid = pg8::xcd_remap((int)L, nwg);
        const int T = wgid / nN; u.pn = wgid % nN; u.pm = T;
        int e = 0;
        for (int j = 1; j < NEXP; ++j) e += (toff[j] <= T) ? 1 : 0;
        e = __builtin_amdgcn_readfirstlane(e);
        u.e = e; u.pos0 = __builtin_amdgcn_readfirstlane((T - toff[e]) * 256); u.ne = __builtin_amdgcn_readfirstlane(toff[64 + e]); { const int left = u.ne - u.pos0; u.nv = left < 256 ? left : 256; } return true;
    }
    __device__ __forceinline__ size_t b_off(const pg8::Unit& u) const { return ((size_t)u.e * rows_per_e + (size_t)u.pn * 256) * K; }
    __device__ __forceinline__ int a_row(const pg8::Unit& u, int r) const {
        if (!GATHER) return u.pm * 256 + r;
        const int pos = u.pos0 + r;
        return pos < u.ne ? toklist[(size_t)u.e * NTOK + pos] : 0;
    }
};
struct EpiSwiglu {
    static constexpr bool PERM = true;
    bf16_t* HID; const float* rslist;
    __device__ __forceinline__ void operator()(const f32x4 (&acc)[2][2][4][2], const pg8::Unit& u, int wr, int wc, int fr, int fq) const {
        const int r0 = wr * 64 + fr, col0 = u.pn * 128 + wc * 32 + 8 * fq; const int pos0 = u.pos0, n_e = u.ne;
#pragma unroll
        for (int ai = 0; ai < 2; ++ai)
#pragma unroll
            for (int m = 0; m < 4; ++m) { const int r = r0 + ai * 128 + m * 16, pos = pos0 + r;
                const float rs = pos < n_e ? rslist[(size_t)u.e * NTOK + pos] : 0.f;
                float o[8];
#pragma unroll
                for (int n = 0; n < 2; ++n)
#pragma unroll
                    for (int j = 0; j < 4; ++j) { const float gt = acc[ai][0][m][n][j] * rs, up = acc[ai][1][m][n][j] * rs;
                        o[4 * n + j] = gt * __builtin_amdgcn_rcpf(1.f + __builtin_amdgcn_exp2f(-gt * LOG2E)) * up; }
                u32x4 w; w.x = cvt_pk_bf16(o[0], o[1]); w.y = cvt_pk_bf16(o[2], o[3]); w.z = cvt_pk_bf16(o[4], o[5]); w.w = cvt_pk_bf16(o[6], o[7]);
                if (r < u.nv || true) *(u32x4*)(HID + (size_t)(u.pm * 256 + r) * DEXP + col0) = w; }
    }
};

#define XB_TMO      128
#define XB_XCNT(j)  (256  + 64 * (j))
#define XB_XSUB(j)  (1280 + 64 * (j))
#define XB_XGEN(j)  (2304 + 64 * (j))
#define XB_TOP      3328
#define XB_TOPGEN   3392
#define XCD_BAR_WORDS 3456
#define XB_SPIN_CAP (1u << 18)
__device__ __forceinline__ unsigned xb_ld(unsigned* p)              { return __hip_atomic_load(p, __ATOMIC_RELAXED, __HIP_MEMORY_SCOPE_AGENT); }
__device__ __forceinline__ unsigned xb_add(unsigned* p, unsigned v) { return __hip_atomic_fetch_add(p, v, __ATOMIC_RELAXED, __HIP_MEMORY_SCOPE_AGENT); }
__device__ __forceinline__ unsigned xb_xcc_id() { return (unsigned)__builtin_amdgcn_s_getreg((3 << 11) | 20) & 0xFu; }
#define XB_SPIN(cond, bar) do { unsigned _sp = 0; while (cond) { __builtin_amdgcn_s_sleep(1); \
    if ((++_sp & 255u) == 0u) { if (xb_ld(&(bar)[XB_TMO])) break; if (_sp > XB_SPIN_CAP) { atomicAdd(&(bar)[XB_TMO], 1u); break; } } } } while (0)
struct XcdBarrier { unsigned* bar; unsigned x; volatile LAS unsigned* st; };
__device__ __forceinline__ XcdBarrier xcd_barrier_post(unsigned* bar, volatile LAS unsigned* st) {
    XcdBarrier b; b.bar = bar; b.x = xb_xcc_id(); b.st = st;
    if (threadIdx.x == 0) (void)xb_add(&bar[XB_XCNT(b.x)], 1u);
    return b;
}
__device__ __forceinline__ void xcd_barrier_complete(unsigned* bar, unsigned x, unsigned& nloc, unsigned& nx) {
    const unsigned G = gridDim.x * gridDim.y * gridDim.z;
    unsigned sum, cnt, mine, sp = 0u;
    for (;;) {
        sum = 0u; cnt = 0u; mine = 0u;
#pragma unroll
        for (unsigned j = 0; j < 16; ++j) { const unsigned c = xb_ld(&bar[XB_XCNT(j)]); sum += c; cnt += (c > 0u) ? 1u : 0u; mine = (j == x) ? c : mine; }
        if (sum == G) break;
        __builtin_amdgcn_s_sleep(1);
        if ((++sp & 255u) == 0u) { if (xb_ld(&bar[XB_TMO])) break; if (sp > XB_SPIN_CAP) { atomicAdd(&bar[XB_TMO], 1u); break; } }
    }
    nloc = mine > 0u ? mine : 1u; nx = cnt > 0u ? cnt : 1u;
}
__device__ __forceinline__ void xcd_barrier(const XcdBarrier& b) {
    asm volatile("s_waitcnt vmcnt(0)" ::: "memory");
    __syncthreads();
    if (threadIdx.x == 0) {
        unsigned* bar = b.bar;
        __builtin_amdgcn_s_waitcnt(0);
        unsigned nloc = b.st[0], nx = b.st[1];
        if (nloc == 0u) { xcd_barrier_complete(bar, b.x, nloc, nx); b.st[0] = nloc; b.st[1] = nx; }
        const unsigned old = xb_add(&bar[XB_XSUB(b.x)], 1u);
        const unsigned gen = old / nloc;
        if (old + 1u == (gen + 1u) * nloc) {
            __builtin_amdgcn_fence(__ATOMIC_RELEASE, "agent");
            asm volatile("s_waitcnt vmcnt(0)" ::: "memory");
            const unsigned og = xb_add(&bar[XB_TOP], 1u);
            const unsigned tg = og / nx;
            if (og + 1u == (tg + 1u) * nx) xb_add(&bar[XB_TOPGEN], 1u);
            else XB_SPIN(xb_ld(&bar[XB_TOPGEN]) == tg, bar);
            __builtin_amdgcn_fence(__ATOMIC_ACQUIRE, "agent");
            xb_add(&bar[XB_XGEN(b.x)], 1u);
            asm volatile("s_waitcnt vmcnt(0)" ::: "memory");
        } else {
            XB_SPIN(xb_ld(&bar[XB_XGEN(b.x)]) == gen, bar);
            __builtin_amdgcn_fence(__ATOMIC_ACQUIRE, "agent");
            asm volatile("s_waitcnt vmcnt(0)" ::: "memory");
        }
    }
    __syncthreads();
}

struct Frame {
    LAS unsigned char* lds;
    volatile LAS unsigned* MISC;
    int tid, lane, wave, vcu, G;
    const float* const* in; float* out; unsigned char* ws;
};
#define LDS_WAIT() asm volatile("s_waitcnt lgkmcnt(0)" ::: "memory")

__device__ __forceinline__ void transpose_tile64(const float* W, int ldw, int k0, int n0, bf16_t* WT, int ldt, int rowbase, const float* kscale, int lane) {
    const float* src = W + (size_t)k0 * ldw + n0 + lane;
    float v[64];
#pragma unroll
    for (int k = 0; k < 64; ++k) v[k] = __builtin_nontemporal_load(src + (size_t)k * ldw);
    if (kscale) {
#pragma unroll
        for (int k = 0; k < 64; ++k) v[k] *= kscale[k0 + k];
    }
    bf16_t* dst = WT + (size_t)(rowbase + lane) * ldt + k0;
#pragma unroll
    for (int c = 0; c < 8; ++c) { u32x4 o; o.x = cvt_pk_bf16(v[8 * c], v[8 * c + 1]); o.y = cvt_pk_bf16(v[8 * c + 2], v[8 * c + 3]); o.z = cvt_pk_bf16(v[8 * c + 4], v[8 * c + 5]); o.w = cvt_pk_bf16(v[8 * c + 6], v[8 * c + 7]);
        *(u32x4*)(dst + 8 * c) = o; }
}
template <int WHICH> __device__ __forceinline__ void convert_rest(Frame& F, int part, int nparts);
__device__ __forceinline__ void p0_prologue(Frame& F) {
    const int gw = F.vcu * NWAVES + F.wave, NGW = F.G * NWAVES, lane = F.lane;
    unsigned char* ws = F.ws;
    for (int it = gw; it < 16 * 28; it += NGW) { const int kb = it / 28, nb = it % 28; transpose_tile64(F.in[2], NPROJ, 64 * kb, 64 * nb, (bf16_t*)(ws + WS_WIN_T), DM, 64 * nb, nullptr, lane); }
    const int gt = F.vcu * (NWAVES * 64) + F.tid, NGT = F.G * NWAVES * 64;
    for (int i = gt; i < 8 * 128 * 128; i += NGT) { const int c = i & 127, t = (i >> 7) & 127; ((bf16_t*)(ws + WS_WSP))[i] = c <= t ? f2bf(F.in[4][i]) : (bf16_t)0; }
    for (int i = gt; i < 64 * DM; i += NGT) { const int k = i & (DM - 1), c = i >> 10; float v = 0.f;
        if (c < 4) v = F.in[12][k * 4 + c] * F.in[11][k];
        else if (c < 36) { const int g = (c - 4) >> 3, e = (c - 4) & 7; v = F.in[14][((size_t)g * DM + k) * 8 + e] * F.in[11][k]; }
        ((bf16_t*)(ws + WS_WR_T))[i] = f2bf(v); }
    const float* g = F.in[1];
    f32x4 gg[4];
#pragma unroll
    for (int j = 0; j < 4; ++j) gg[j] = *(const f32x4*)(g + 256 * j + 4 * lane);
    for (int row0 = gw * 4; row0 < NTOK; row0 += NGW * 4) {
        f32x4 v[4][4];
#pragma unroll
        for (int rr = 0; rr < 4; ++rr)
#pragma unroll
            for (int j = 0; j < 4; ++j) v[rr][j] = __builtin_nontemporal_load((const f32x4*)(F.in[0] + (size_t)(row0 + rr) * DM + 256 * j + 4 * lane));
#pragma unroll
        for (int rr = 0; rr < 4; ++rr) {
            float s = 0.f;
#pragma unroll
            for (int j = 0; j < 4; ++j) s += (v[rr][j][0] * v[rr][j][0] + v[rr][j][1] * v[rr][j][1]) + (v[rr][j][2] * v[rr][j][2] + v[rr][j][3] * v[rr][j][3]);
            const float rstd = rsqrtf(wave_sum(s) * (1.f / DM) + RMS_EPS);
            bf16_t* xn = (bf16_t*)(ws + WS_XN) + (size_t)(row0 + rr) * DM;
#pragma unroll
            for (int j = 0; j < 4; ++j) { u32x2 o; o.x = cvt_pk_bf16(v[rr][j][0] * rstd * gg[j][0], v[rr][j][1] * rstd * gg[j][1]); o.y = cvt_pk_bf16(v[rr][j][2] * rstd * gg[j][2], v[rr][j][3] * rstd * gg[j][3]);
                *(u32x2*)(xn + 256 * j + 4 * lane) = o; }
        }
    }
    convert_rest<0>(F, gw, NGW);
}
template <int WHICH>
__device__ __forceinline__ void convert_rest(Frame& F, int part, int nparts) {
    unsigned char* ws = F.ws; const int lane = F.lane;
    constexpr int T_OUT = 16 * 16, T_GU = NEXP * 64, T_D = NEXP * 64;
    if (WHICH == 0) {
        for (int it = part; it < 2 * T_GU; it += nparts) {
            int r = it; const int up = r >= T_GU; if (up) r -= T_GU; const int e = r / 64, q = r % 64, kb = q / 4, nb = q % 4, n0 = 64 * nb;
            const int rowbase = e * 512 + 256 * (n0 >> 7) + (up ? 128 : 0) + (n0 & 127);
            transpose_tile64(F.in[up ? 17 : 16] + (size_t)e * DM * DEXP, DEXP, 64 * kb, n0, (bf16_t*)(ws + WS_WGU_T), DM, rowbase, F.in[11], lane); }
    } else if (WHICH == 1) {
        for (int it = part; it < T_OUT; it += nparts) { const int kb = it / 16, nb = it % 16; transpose_tile64(F.in[10], DM, 64 * kb, 64 * nb, (bf16_t*)(ws + WS_WO_T), DM, 64 * nb, nullptr, lane); }
    } else {
        for (int it = part; it < T_D; it += nparts) { const int e = it / 64, q = it % 64, kb = q / 16, nb = q % 16;
            transpose_tile64(F.in[18] + (size_t)e * DEXP * DM, DM, 64 * kb, 64 * nb, (bf16_t*)(ws + WS_WD_T), DEXP, e * DM + 64 * nb, nullptr, lane); }
    }
}

constexpr int P2_K_OFF = 0, P2_KROW = 144, P2_KHEAD = 256 * P2_KROW;
constexpr int P2_V_OFF = 2 * P2_KHEAD, P2_VHEAD = 256 * 128;
constexpr int P2_VN_OFF = 0, P2_VNROW = 1088;
constexpr int P2_EXA_OFF = 139264, P2_EXG_OFF = P2_EXA_OFF + 4096;
static_assert(P2_V_OFF + 2 * P2_VHEAD <= P2_EXA_OFF && 128 * P2_VNROW <= P2_EXA_OFF && P2_EXG_OFF + 4096 <= MISC_OFF, "P2 LDS map");

__device__ __forceinline__ void p2_mix(Frame& F, const int skip) {
    const int tid = F.tid, lane = F.lane, w = F.wave;
    const int r = lane & 31, hh = lane >> 5, g4 = lane >> 4, q4 = (lane & 15) >> 2, p4 = lane & 3;
    const bf16_t* proj = (const bf16_t*)(F.ws + WS_PROJ);
    bf16_t* mixed = (bf16_t*)(F.ws + WS_MIXED);
    const bf16_t* wsp = (const bf16_t*)(F.ws + WS_WSP);
    LAS unsigned char* lds = F.lds;
    LAS float* exA = (LAS float*)(lds + P2_EXA_OFF); LAS float* exG = (LAS float*)(lds + P2_EXG_OFF);
    const float sink2 = F.in[3][w] * LOG2E;
    const float SC2 = 0.125f * LOG2E;
    for (int unit = F.vcu; unit < NTOK / 128; unit += F.G) {
        const int t0 = unit * 128; const bool first = (unit & 63) == 0;
        {
            u32x4 kv[8], vv[8];
#pragma unroll
            for (int i = 0; i < 8; ++i) { const int pc = tid + 512 * i, key = pc >> 4, sub = pc & 15;
                kv[i] = (u32x4){0u, 0u, 0u, 0u}; vv[i] = (u32x4){0u, 0u, 0u, 0u};
                if (!(first && key < 128)) { const bf16_t* rowp = proj + (size_t)(t0 - 128 + key) * NPROJ; kv[i] = *(const u32x4*)(rowp + C_K + sub * 8); vv[i] = *(const u32x4*)(rowp + C_V + sub * 8); } }
            { unsigned dummy = 0u;
#pragma unroll
              for (int i = 0; i < 4; ++i) { const int ln = tid + 512 * i, row = ln >> 4, seg = ln & 15; dummy += *(const unsigned*)(proj + (size_t)(t0 + row) * NPROJ + C_GU + seg * 64); }
              asm volatile("" :: "v"(dummy)); }
#pragma unroll
            for (int i = 0; i < 8; ++i) { const int pc = tid + 512 * i, key = pc >> 4, sub = pc & 15, kvh = sub >> 3, piece = sub & 7;
                *(LAS u32x4*)(lds + P2_K_OFF + kvh * P2_KHEAD + key * P2_KROW + piece * 16) = kv[i];
                *(LAS u32x4*)(lds + P2_V_OFF + kvh * P2_VHEAD + key * 128 + ((piece ^ (((key >> 1) & 1) << 2)) * 16)) = vv[i]; }
        }
        if (!(skip & 1)) {
            const int kvh = w >> 2;
            const LAS unsigned char* Kl = lds + P2_K_OFF + kvh * P2_KHEAD;
            const LAS unsigned char* Vl = lds + P2_V_OFF + kvh * P2_VHEAD;
            const int vflip = (q4 >> 1) & 1;
            const int vlane = (4 * hh + q4) * 128 + (g4 & 1) * 32 + p4 * 8;
            const int vh0 = vflip * 64, vh1 = (vflip ^ 1) * 64;
            const bf16_t* qbase = proj + (size_t)(t0 + r) * NPROJ + C_Q + 64 * w + 8 * hh;
            bf16x8 qn[4];
#pragma unroll
            for (int s = 0; s < 4; ++s) qn[s] = __builtin_nontemporal_load((const bf16x8*)(qbase + 16 * s));
            __syncthreads();
            for (int qb = 0; qb < 4; ++qb) {
                bf16x8 qf[4];
#pragma unroll
                for (int s = 0; s < 4; ++s) qf[s] = qn[s];
                if (qb < 3) {
#pragma unroll
                    for (int s = 0; s < 4; ++s) qn[s] = __builtin_nontemporal_load((const bf16x8*)(qbase + (size_t)(32 * (qb + 1)) * NPROJ + 16 * s));
                }
                f32x16 sa[5];
#pragma unroll
                for (int cc = 0; cc < 5; ++cc) {
#pragma unroll
                    for (int i = 0; i < 16; ++i) sa[cc][i] = 0.f;
                    const LAS unsigned char* kp = Kl + (32 * (qb + cc) + r) * P2_KROW + 16 * hh;
#pragma unroll
                    for (int s = 0; s < 4; ++s) { const bf16x8 kf = *(const LAS bf16x8*)(kp + 32 * s); sa[cc] = MFMA32(kf, qf[s], sa[cc]); }
                }
                const int q = 32 * qb + r; float mr = -1e30f;
#pragma unroll
                for (int cc = 0; cc < 5; ++cc)
#pragma unroll
                    for (int i = 0; i < 16; ++i) { const int kb = 32 * (qb + cc) + (i & 3) + 8 * (i >> 2) + 4 * hh;
                        if (cc == 0 || cc == 4 || first) { bool ok = true; if (cc == 0) ok = kb >= q + 1; if (cc == 4) ok = kb <= q + 128; if (first) ok = ok && kb >= 128; sa[cc][i] = ok ? sa[cc][i] : -1e30f; }
                        mr = fmaxf(mr, sa[cc][i]); }
                mr = fmaxf(mr, __shfl_xor(mr, 32));
                const float mx = fmaxf(mr * SC2, sink2);
                float sum = 0.f;
#pragma unroll
                for (int cc = 0; cc < 5; ++cc)
#pragma unroll
                    for (int i = 0; i < 16; ++i) { const float pe = __builtin_amdgcn_exp2f(fmaf(sa[cc][i], SC2, -mx)); sa[cc][i] = pe; sum += pe; }
                sum += __shfl_xor(sum, 32);
                const float inv = 1.f / (sum + __builtin_amdgcn_exp2f(sink2 - mx));
                f32x16 o[2];
#pragma unroll
                for (int i = 0; i < 16; ++i) { o[0][i] = 0.f; o[1][i] = 0.f; }
#pragma unroll
                for (int cc = 0; cc < 5; ++cc)
#pragma unroll
                    for (int s2 = 0; s2 < 2; ++s2) {
                        u32x4 pw; pw.x = cvt_pk_bf16(sa[cc][8 * s2 + 0], sa[cc][8 * s2 + 1]); pw.y = cvt_pk_bf16(sa[cc][8 * s2 + 2], sa[cc][8 * s2 + 3]);
                        pw.z = cvt_pk_bf16(sa[cc][8 * s2 + 4], sa[cc][8 * s2 + 5]); pw.w = cvt_pk_bf16(sa[cc][8 * s2 + 6], sa[cc][8 * s2 + 7]);
                        const bf16x8 pf = __builtin_bit_cast(bf16x8, pw);
                        const LAS unsigned char* vp = Vl + (32 * (qb + cc) + 16 * s2) * 128 + vlane;
#pragma unroll
                        for (int db = 0; db < 2; ++db) { const int vh = db ? vh1 : vh0; const s16x4 a0 = vtr(vp + vh), a1 = vtr(vp + 8 * 128 + vh);
                            const bf16x8 vf = (bf16x8){a0[0], a0[1], a0[2], a0[3], a1[0], a1[1], a1[2], a1[3]};
                            o[db] = MFMA32(vf, pf, o[db]); }
                    }
                float ss = 0.f;
#pragma unroll
                for (int db = 0; db < 2; ++db)
#pragma unroll
                    for (int i = 0; i < 16; ++i) { o[db][i] *= inv; ss += o[db][i] * o[db][i]; }
                ss += __shfl_xor(ss, 32);
                if (hh == 0) exA[(qb * 8 + w) * 32 + r] = ss;
                __syncthreads();
                float tot = 0.f;
#pragma unroll
                for (int j = 0; j < 8; ++j) tot += exA[(qb * 8 + j) * 32 + r];
                const float rstd = rsqrtf(tot * (1.f / 512) + RMS_EPS);
                bf16_t* orow = mixed + (size_t)(t0 + q) * DM + 64 * w + 4 * hh;
                const float* ga = F.in[8] + 64 * w + 4 * hh;
#pragma unroll
                for (int db = 0; db < 2; ++db)
#pragma unroll
                    for (int rg = 0; rg < 4; ++rg) { const f32x4 gg = *(const f32x4*)(ga + 32 * db + 8 * rg);
                        u32x2 ow; ow.x = cvt_pk_bf16(o[db][4 * rg] * rstd * gg[0], o[db][4 * rg + 1] * rstd * gg[1]); ow.y = cvt_pk_bf16(o[db][4 * rg + 2] * rstd * gg[2], o[db][4 * rg + 3] * rstd * gg[3]);
                        *(u32x2*)(orow + 32 * db + 8 * rg) = ow; }
            }
        }
        if (!(skip & 2)) {
            u32x4 raw[16];
#pragma unroll
            for (int i = 0; i < 16; ++i) raw[i] = __builtin_nontemporal_load((const u32x4*)(proj + (size_t)(t0 + 16 * w + i) * NPROJ + C_GV + 8 * lane));
            const f32x4 lg0 = *(const f32x4*)(F.in[6] + 8 * lane), lg1 = *(const f32x4*)(F.in[6] + 8 * lane + 4), lb0 = *(const f32x4*)(F.in[7] + 8 * lane), lb1 = *(const f32x4*)(F.in[7] + 8 * lane + 4);
            LAS f32x2* stat = (LAS f32x2*)(lds + P2_EXG_OFF);
            if (tid < 128) { const f32x4* sp = (const f32x4*)((const float*)(F.ws + WS_SSQ) + (size_t)(t0 + tid) * 16); const f32x4 a = sp[0], b = sp[1], c = sp[2], d = sp[3];
                const float s1 = (a[0] + a[2]) + (b[0] + b[2]) + (c[0] + c[2]) + (d[0] + d[2]), s2 = (a[1] + a[3]) + (b[1] + b[3]) + (c[1] + c[3]) + (d[1] + d[3]);
                const float mu = s1 * (1.f / 512), var = fmaxf(s2 * (1.f / 512) - mu * mu, 0.f); stat[tid] = (f32x2){mu, rsqrtf(var + LN_EPS)}; }
            __syncthreads();
#pragma unroll
            for (int i = 0; i < 16; ++i) { const int tok = 16 * w + i; const f32x2 st = stat[tok]; const float mu = st.x, rstd = st.y;
                float v[8];
                v[0] = __uint_as_float(raw[i].x << 16); v[1] = __uint_as_float(raw[i].x & 0xffff0000u); v[2] = __uint_as_float(raw[i].y << 16); v[3] = __uint_as_float(raw[i].y & 0xffff0000u);
                v[4] = __uint_as_float(raw[i].z << 16); v[5] = __uint_as_float(raw[i].z & 0xffff0000u); v[6] = __uint_as_float(raw[i].w << 16); v[7] = __uint_as_float(raw[i].w & 0xffff0000u);
#pragma unroll
                for (int j = 0; j < 8; ++j) v[j] = (v[j] - mu) * rstd;
                u32x4 ow; ow.x = cvt_pk_bf16(v[0] * lg0[0] + lb0[0], v[1] * lg0[1] + lb0[1]); ow.y = cvt_pk_bf16(v[2] * lg0[2] + lb0[2], v[3] * lg0[3] + lb0[3]);
                ow.z = cvt_pk_bf16(v[4] * lg1[0] + lb1[0], v[5] * lg1[1] + lb1[1]); ow.w = cvt_pk_bf16(v[6] * lg1[2] + lb1[2], v[7] * lg1[3] + lb1[3]);
                *(LAS u32x4*)(lds + P2_VN_OFF + tok * P2_VNROW + lane * 16) = ow; }
        }
        if (!(skip & 4)) {
            const LAS unsigned char* vnl = lds + P2_VN_OFF + (8 * hh + q4) * P2_VNROW + (64 * w + 16 * (g4 & 1) + 4 * p4) * 2;
            const bf16_t* wh = wsp + (size_t)w * 128 * 128 + (size_t)r * 128 + 8 * hh;
            const bf16_t* ub = proj + (size_t)(t0 + r) * NPROJ + C_GU + 64 * w + 4 * hh;
            bf16x8 wf[8]; u32x2 uu[8];
#pragma unroll
            for (int s = 0; s < 2; ++s) wf[s] = *(const bf16x8*)(wh + 16 * s);
#pragma unroll
            for (int j = 0; j < 8; ++j) uu[j] = *(const u32x2*)(ub + 32 * (j >> 2) + 8 * (j & 3));
            __syncthreads();
#pragma unroll
            for (int tb = 0; tb < 4; ++tb) {
                f32x16 acc[2];
#pragma unroll
                for (int i = 0; i < 16; ++i) { acc[0][i] = 0.f; acc[1][i] = 0.f; }
#pragma unroll
                for (int s = 0; s < 2 * tb + 2; ++s) {
#pragma unroll
                    for (int db = 0; db < 2; ++db) { const LAS unsigned char* vp = vnl + (16 * s) * P2_VNROW + db * 64;
                        const s16x4 a0 = vtr(vp), a1 = vtr(vp + 4 * P2_VNROW);
                        const bf16x8 af = (bf16x8){a0[0], a0[1], a0[2], a0[3], a1[0], a1[1], a1[2], a1[3]};
                        acc[db] = MFMA32(af, wf[s], acc[db]); }
                }
                const int t = 32 * tb + r; const float bs = F.in[5][w * 128 + t];
                float ss = 0.f;
#pragma unroll
                for (int db = 0; db < 2; ++db)
#pragma unroll
                    for (int rg = 0; rg < 4; ++rg) { const u32x2 u2 = uu[4 * db + rg];
                        const float u0 = __uint_as_float(u2.x << 16), u1 = __uint_as_float(u2.x & 0xffff0000u), u2f = __uint_as_float(u2.y << 16), u3 = __uint_as_float(u2.y & 0xffff0000u);
                        float a = u0 * (acc[db][4 * rg] + bs), b = u1 * (acc[db][4 * rg + 1] + bs), c = u2f * (acc[db][4 * rg + 2] + bs), d = u3 * (acc[db][4 * rg + 3] + bs);
                        acc[db][4 * rg] = a; acc[db][4 * rg + 1] = b; acc[db][4 * rg + 2] = c; acc[db][4 * rg + 3] = d; ss += (a * a + b * b) + (c * c + d * d); }
                if (tb < 3) {
#pragma unroll
                    for (int s = 0; s < 2 * tb + 4; ++s) wf[s] = *(const bf16x8*)(wh + (size_t)(32 * (tb + 1)) * 128 + 16 * s);
#pragma unroll
                    for (int j = 0; j < 8; ++j) uu[j] = *(const u32x2*)(ub + (size_t)(32 * (tb + 1)) * NPROJ + 32 * (j >> 2) + 8 * (j & 3));
                }
                ss += __shfl_xor(ss, 32);
                if (hh == 0) exG[(tb * 8 + w) * 32 + r] = ss;
                __syncthreads();
                float tot = 0.f;
#pragma unroll
                for (int j = 0; j < 8; ++j) tot += exG[(tb * 8 + j) * 32 + r];
                const float rstd = rsqrtf(tot * (1.f / 512) + RMS_EPS);
                bf16_t* orow = mixed + (size_t)(t0 + t) * DM + 512 + 64 * w + 4 * hh;
                const float* gg_ = F.in[9] + 64 * w + 4 * hh;
#pragma unroll
                for (int db = 0; db < 2; ++db)
#pragma unroll
                    for (int rg = 0; rg < 4; ++rg) { const f32x4 gg = *(const f32x4*)(gg_ + 32 * db + 8 * rg);
                        u32x2 ow; ow.x = cvt_pk_bf16(acc[db][4 * rg] * rstd * gg[0], acc[db][4 * rg + 1] * rstd * gg[1]); ow.y = cvt_pk_bf16(acc[db][4 * rg + 2] * rstd * gg[2], acc[db][4 * rg + 3] * rstd * gg[3]);
                        *(u32x2*)(orow + 32 * db + 8 * rg) = ow; }
            }
        }
        __syncthreads();
    }
}

constexpr int P4_WROW = 2064;
constexpr int P4_W_OFF = 0, P4_LG_OFF = 48 * P4_WROW, P4_CNT_OFF = P4_LG_OFF + 8 * 16 * 48 * 4, P4_BASE_OFF = P4_CNT_OFF + 128;
static_assert(P4_BASE_OFF + 128 <= MISC_OFF, "P4 LDS map");
__device__ __forceinline__ void p4_router(Frame& F) {
    const int lane = F.lane, w = F.wave, tid = F.tid;
    const bf16_t* hb = (const bf16_t*)(F.ws + WS_HB);
    const bf16_t* wr_t = (const bf16_t*)(F.ws + WS_WR_T);
    const float* ssq = (const float*)(F.ws + WS_SSQ);
    int* cntg = (int*)(F.ws + WS_CTL) + CW_CNT;
    int* tl = (int*)(F.ws + WS_TOKLIST); float* rl = (float*)(F.ws + WS_RSLIST);
    LAS unsigned char* lds = F.lds;
    LAS float* lg = (LAS float*)(lds + P4_LG_OFF) + w * 16 * 48;
    LAS int* cl = (LAS int*)(lds + P4_CNT_OFF); LAS int* bl = (LAS int*)(lds + P4_BASE_OFF);
#pragma unroll
    for (int i = 0; i < 12; ++i) { const int pc = tid + 512 * i, row = pc >> 7, ch = pc & 127; *(LAS u32x4*)(lds + P4_W_OFF + row * P4_WROW + ch * 16) = *(const u32x4*)(wr_t + (size_t)row * DM + ch * 8); }
    for (int blk = F.vcu; blk < NTOK / 128; blk += F.G) {
        const int tok0 = blk * 128 + 16 * w;
        if (tid < 32) cl[tid] = 0;
        const bf16_t* ap = hb + (size_t)(tok0 + (lane & 15)) * DM + 8 * (lane >> 4);
        bf16x8 af[32];
#pragma unroll
        for (int s = 0; s < 32; ++s) af[s] = *(const bf16x8*)(ap + 32 * s);
        const f32x4 sq0 = *(const f32x4*)(ssq + (size_t)(tok0 + (lane & 15)) * 16), sq1 = *(const f32x4*)(ssq + (size_t)(tok0 + (lane & 15)) * 16 + 4),
                    sq2 = *(const f32x4*)(ssq + (size_t)(tok0 + (lane & 15)) * 16 + 8), sq3 = *(const f32x4*)(ssq + (size_t)(tok0 + (lane & 15)) * 16 + 12);
        __syncthreads();
        f32x4 acc[3];
#pragma unroll
        for (int c = 0; c < 3; ++c) acc[c] = (f32x4){0.f, 0.f, 0.f, 0.f};
        const LAS unsigned char* bp = lds + P4_W_OFF + (lane & 15) * P4_WROW + 16 * (lane >> 4);
#pragma unroll
        for (int s = 0; s < 32; ++s) {
#pragma unroll
            for (int c = 0; c < 3; ++c) { const bf16x8 b = *(const LAS bf16x8*)(bp + c * 16 * P4_WROW + 64 * s); acc[c] = MFMA16(af[s], b, acc[c]); }
        }
#pragma unroll
        for (int c = 0; c < 3; ++c)
#pragma unroll
            for (int i = 0; i < 4; ++i) lg[(4 * (lane >> 4) + i) * 48 + 16 * c + (lane & 15)] = acc[c][i];
        LDS_WAIT();
        int e1 = 0, e2 = 0, l1 = 0, l2 = 0; float w1 = 0.f, w2 = 0.f, rstd = 0.f;
        if (lane < 16) {
            float s = 0.f;
#pragma unroll
            for (int i = 0; i < 4; ++i) s += sq0[i];
#pragma unroll
            for (int i = 0; i < 4; ++i) s += sq1[i];
#pragma unroll
            for (int i = 0; i < 4; ++i) s += sq2[i];
#pragma unroll
            for (int i = 0; i < 4; ++i) s += sq3[i];
            rstd = rsqrtf(s * (1.f / DM) + RMS_EPS);
            const LAS float* L = lg + lane * 48;
            float gl[4]; int gi = 0;
#pragma unroll
            for (int j = 0; j < 4; ++j) gl[j] = L[j] * rstd + F.in[13][j];
            float gm = gl[0];
#pragma unroll
            for (int j = 1; j < 4; ++j) if (gl[j] > gm) { gm = gl[j]; gi = j; }
            float den = 0.f;
#pragma unroll
            for (int j = 0; j < 4; ++j) den += __expf(gl[j] - gm);
            const float gw = 1.f / den;
            float el[8];
#pragma unroll
            for (int j = 0; j < 8; ++j) el[j] = L[4 + gi * 8 + j] * rstd + F.in[15][gi * 8 + j];
            int i1 = 0; float v1 = el[0];
#pragma unroll
            for (int j = 1; j < 8; ++j) if (el[j] > v1) { v1 = el[j]; i1 = j; }
            int i2 = 0; float v2 = -INFINITY;
#pragma unroll
            for (int j = 0; j < 8; ++j) if (j != i1 && el[j] > v2) { v2 = el[j]; i2 = j; }
            const float a1 = 1.f / (1.f + __expf(v2 - v1));
            w1 = gw * a1; w2 = gw * (1.f - a1); e1 = gi * 8 + i1; e2 = gi * 8 + i2;
            l1 = atomicAdd((int*)(cl + e1), 1); l2 = atomicAdd((int*)(cl + e2), 1);
        }
        __syncthreads();
        if (tid < 32) bl[tid] = atomicAdd(cntg + tid, (int)cl[tid]);
        __syncthreads();
        if (lane < 16) {
            const int tok = tok0 + lane; const int p1 = bl[e1] + l1, p2 = bl[e2] + l2;
            tl[(size_t)e1 * NTOK + p1] = tok; rl[(size_t)e1 * NTOK + p1] = rstd;
            tl[(size_t)e2 * NTOK + p2] = tok; rl[(size_t)e2 * NTOK + p2] = rstd;
            ((int4*)(F.ws + WS_TOKREC))[tok] = make_int4(e1, p1, e2, p2);
            ((float2*)(F.ws + WS_TOKW))[tok] = make_float2(w1, w2);
        }
        __syncthreads();
    }
}

__device__ __forceinline__ int moe_offsets(Frame& F) {
    const int* cnt = (const int*)(F.ws + WS_CTL) + CW_CNT;
    if (F.tid == 0) { int o = 0; for (int e = 0; e < NEXP; ++e) { const int n = __hip_atomic_load(cnt + e, __ATOMIC_RELAXED, __HIP_MEMORY_SCOPE_AGENT); F.MISC[16 + e] = (unsigned)o; F.MISC[16 + 64 + e] = (unsigned)n; o += (n + 255) >> 8; } F.MISC[16 + NEXP] = (unsigned)o; }
    __syncthreads();
    return __builtin_amdgcn_readfirstlane((int)F.MISC[16 + NEXP]);
}

__device__ __forceinline__ void p7_final(Frame& F) {
    const int lane = F.lane; const int gw = F.vcu * NWAVES + F.wave, NGW = F.G * NWAVES;
    const volatile LAS int* toff = (const volatile LAS int*)(F.MISC + 16);
    const float* gf = F.in[19];
    const f32x4 g0a = *(const f32x4*)(gf + 8 * lane), g0b = *(const f32x4*)(gf + 8 * lane + 4), g1a = *(const f32x4*)(gf + 512 + 8 * lane), g1b = *(const f32x4*)(gf + 512 + 8 * lane + 4);
    const bf16_t* HBp = (const bf16_t*)(F.ws + WS_HB); const bf16_t* Yp = (const bf16_t*)(F.ws + WS_Y);
    for (int tok0 = gw * 4; tok0 < NTOK; tok0 += NGW * 4) {
        int4 rec[4]; float2 wt[4];
#pragma unroll
        for (int t = 0; t < 4; ++t) { rec[t] = ((const int4*)(F.ws + WS_TOKREC))[tok0 + t]; wt[t] = ((const float2*)(F.ws + WS_TOKW))[tok0 + t]; }
        u32x4 ra[4][2], rb[4][2], rc[4][2];
#pragma unroll
        for (int t = 0; t < 4; ++t) {
            const int s1 = toff[rec[t].x] * 256 + rec[t].y, s2 = toff[rec[t].z] * 256 + rec[t].w;
            const bf16_t* hb = HBp + (size_t)(tok0 + t) * DM + 8 * lane; const bf16_t* y1 = Yp + (size_t)s1 * DM + 8 * lane; const bf16_t* y2 = Yp + (size_t)s2 * DM + 8 * lane;
#pragma unroll
            for (int j = 0; j < 2; ++j) { ra[t][j] = __builtin_nontemporal_load((const u32x4*)(hb + 512 * j)); rb[t][j] = __builtin_nontemporal_load((const u32x4*)(y1 + 512 * j)); rc[t][j] = __builtin_nontemporal_load((const u32x4*)(y2 + 512 * j)); }
        }
#pragma unroll
        for (int t = 0; t < 4; ++t) {
            float z[16]; float ss = 0.f;
#pragma unroll
            for (int j = 0; j < 2; ++j)
#pragma unroll
                for (int q = 0; q < 4; ++q) {
                    const float lo = __uint_as_float(ra[t][j][q] << 16) + wt[t].x * __uint_as_float(rb[t][j][q] << 16) + wt[t].y * __uint_as_float(rc[t][j][q] << 16);
                    const float hi = __uint_as_float(ra[t][j][q] & 0xffff0000u) + wt[t].x * __uint_as_float(rb[t][j][q] & 0xffff0000u) + wt[t].y * __uint_as_float(rc[t][j][q] & 0xffff0000u);
                    z[8 * j + 2 * q] = lo; z[8 * j + 2 * q + 1] = hi; ss += lo * lo + hi * hi; }
            const float rstd = rsqrtf(wave_sum(ss) * (1.f / DM) + RMS_EPS);
            float* o = F.out + (size_t)(tok0 + t) * DM;
            __builtin_nontemporal_store((f32x4){z[0] * rstd * g0a[0], z[1] * rstd * g0a[1], z[2] * rstd * g0a[2], z[3] * rstd * g0a[3]}, (f32x4*)(o + 8 * lane));
            __builtin_nontemporal_store((f32x4){z[4] * rstd * g0b[0], z[5] * rstd * g0b[1], z[6] * rstd * g0b[2], z[7] * rstd * g0b[3]}, (f32x4*)(o + 8 * lane + 4));
            __builtin_nontemporal_store((f32x4){z[8] * rstd * g1a[0], z[9] * rstd * g1a[1], z[10] * rstd * g1a[2], z[11] * rstd * g1a[3]}, (f32x4*)(o + 512 + 8 * lane));
            __builtin_nontemporal_store((f32x4){z[12] * rstd * g1b[0], z[13] * rstd * g1b[1], z[14] * rstd * g1b[2], z[15] * rstd * g1b[3]}, (f32x4*)(o + 512 + 8 * lane + 4));
        }
    }
}

struct Args { const float* in[20]; float* out; unsigned char* ws; int ph_lo, ph_hi, li, pad; };
constexpr int N_PHASES = 8;
__global__ void __launch_bounds__(NWAVES * 64, 2) mk_fwd(Args args) {
    extern __shared__ __attribute__((aligned(16))) unsigned char lds_raw[];
    Frame F;
    F.lds = (LAS unsigned char*)lds_raw;
    F.MISC = (volatile LAS unsigned*)(F.lds + MISC_OFF);
    F.tid = threadIdx.x; F.lane = F.tid & 63; F.wave = __builtin_amdgcn_readfirstlane(F.tid >> 6);
    F.G = gridDim.x; { const int bx = blockIdx.x; F.vcu = (F.G % 8 == 0) ? (bx % 8) * (F.G / 8) + bx / 8 : bx; }
    F.in = args.in; F.out = args.out; F.ws = args.ws;
    unsigned char* ws = args.ws;
    for (int u = F.tid; u < 256; u += NWAVES * 64) F.MISC[u] = 0u;
    __syncthreads();
    const int lo = args.ph_lo, hi = args.ph_hi;
    XcdBarrier bar; bar.bar = (unsigned*)(ws + WS_CTL) + CW_BAR + args.li * XCD_BAR_WORDS; bar.x = 0; bar.st = nullptr;
    if (hi - lo > 1) bar = xcd_barrier_post((unsigned*)(ws + WS_CTL) + CW_BAR + args.li * XCD_BAR_WORDS, F.MISC + 8);
#define IN(k) (lo <= (k) && (k) < hi)
#define SEAM(k) do { if (IN(k) && IN((k) + 1)) xcd_barrier(bar); } while (0)
    if (IN(0)) { p0_prologue(F); SEAM(0); }
    if (IN(1)) {
        pg8::Gemm g{(const bf16_t*)(ws + WS_XN), (const bf16_t*)(ws + WS_WIN_T), DM, 0}; pg8::StaticOrder S; S.init(NTOK, NPROJ, DM, F.G, (int)blockIdx.x);
        pg8::EpiBf16G E{(bf16_t*)(ws + WS_PROJ), NPROJ, 3, (f32x2*)(ws + WS_SSQ), 5, 0};
        pg8::gemm_phase<pg8::EpiBf16G, pg8::StaticOrder>(F.lds, g, S, E);
        {
            const int nu = (NTOK / 256) * (NPROJ / 256), full = nu % F.G;
            if (full == 0) convert_rest<1>(F, (int)blockIdx.x * NWAVES + F.wave, F.G * NWAVES);
            else if ((int)blockIdx.x >= full) convert_rest<1>(F, ((int)blockIdx.x - full) * NWAVES + F.wave, (F.G - full) * NWAVES);
        }
        SEAM(1);
    }
    if (IN(2)) { p2_mix(F, args.pad); SEAM(2); }
    if (IN(3)) {
        pg8::Gemm g{(const bf16_t*)(ws + WS_MIXED), (const bf16_t*)(ws + WS_WO_T), DM, 0}; pg8::StaticOrder S; S.init(NTOK, DM, DM, F.G, (int)blockIdx.x);
        pg8::EpiH E{args.in[0], (bf16_t*)(ws + WS_HB), (float*)(ws + WS_SSQ)};
        pg8::gemm_phase<pg8::EpiH, pg8::StaticOrder>(F.lds, g, S, E);
        SEAM(3);
    }
    if (IN(4)) { p4_router(F); SEAM(4); }
    if (IN(5) || IN(6) || IN(7)) {
        const int ntiles = moe_offsets(F);
        const volatile LAS int* toff = (const volatile LAS int*)(F.MISC + 16);
        const int* cnt = (const int*)(ws + WS_CTL) + CW_CNT;
        if (IN(5)) {
            pg8::Gemm g{(const bf16_t*)(ws + WS_HB), (const bf16_t*)(ws + WS_WGU_T), DM, 0};
            MoeOrder<true> S{toff, cnt, (const int*)(ws + WS_TOKLIST), 2, ntiles * 2, F.G, (int)blockIdx.x, DM, 512};
            EpiSwiglu E{(bf16_t*)(ws + WS_HID), (const float*)(ws + WS_RSLIST)};
            pg8::gemm_phase<EpiSwiglu, MoeOrder<true>>(F.lds, g, S, E);
            {
                const int nu = ntiles * 2, full = nu % F.G;
                if (full == 0) convert_rest<2>(F, (int)blockIdx.x * NWAVES + F.wave, F.G * NWAVES);
                else if ((int)blockIdx.x >= full) convert_rest<2>(F, ((int)blockIdx.x - full) * NWAVES + F.wave, (F.G - full) * NWAVES);
            }
            SEAM(5);
        }
        if (IN(6)) {
            pg8::Gemm g{(const bf16_t*)(ws + WS_HID), (const bf16_t*)(ws + WS_WD_T), DEXP, 0};
            MoeOrder<false> S{toff, cnt, (const int*)(ws + WS_TOKLIST), 4, ntiles * 4, F.G, (int)blockIdx.x, DEXP, DM};
            pg8::EpiBf16G E{(bf16_t*)(ws + WS_Y), DM, 1000, nullptr, 1000, 0};
            pg8::gemm_phase<pg8::EpiBf16G, MoeOrder<false>>(F.lds, g, S, E);
            SEAM(6);
        }
        if (IN(7)) p7_final(F);
    }
#undef IN
#undef SEAM
}
extern "C" void kernel_launch(void* const* d_in, const int* in_sizes, int n_in, void* d_out, int out_size, void* d_ws, size_t ws_size, hipStream_t stream) {
    static int grid = 0;
    if (grid == 0) {
        if (n_in != 20 || in_sizes[0] != NTOK * DM || out_size != NTOK * DM || ws_size < WS_END) {
            fprintf(stderr, "kernel_launch: unexpected shapes (n_in %d, in0 %d, out %d, ws %zu)\n", n_in, n_in > 0 ? in_sizes[0] : -1, out_size, ws_size); grid = -1; return; }
        int dev = 0, cus = 0, per_cu = 0;
        if (hipGetDevice(&dev) != hipSuccess || hipDeviceGetAttribute(&cus, hipDeviceAttributeMultiprocessorCount, dev) != hipSuccess) { fprintf(stderr, "kernel_launch: device query failed\n"); grid = -1; return; }
        if (hipFuncSetAttribute((const void*)mk_fwd, hipFuncAttributeMaxDynamicSharedMemorySize, LDS_BYTES) != hipSuccess) { fprintf(stderr, "kernel_launch: hipFuncSetAttribute(%d B LDS) failed\n", LDS_BYTES); grid = -1; return; }
        if (hipOccupancyMaxActiveBlocksPerMultiprocessor(&per_cu, (const void*)mk_fwd, NWAVES * 64, LDS_BYTES) != hipSuccess || per_cu < 1)
            fprintf(stderr, "kernel_launch: note: occupancy query reports %d workgroups per CU\n", per_cu);
        (void)hipGetLastError();
        grid = cus;
    }
    if (grid < 0) return;
    Params p{};
    for (int i = 0; i < 20; ++i) p.in[i] = (const float*)d_in[i];
    p.out = (float*)d_out; p.ws = (unsigned char*)d_ws;
    unsigned char* ws = p.ws;
    (void)hipMemsetAsync(ws + WS_CTL, 0, CTL_ZERO_BYTES, stream);
    const int* cnt = (const int*)(ws + WS_CTL) + CW_CNT;
    Args a{};
    for (int i = 0; i < 20; ++i) a.in[i] = (const float*)d_in[i];
    a.out = (float*)d_out; a.ws = ws;
#ifndef REP_PH
#define REP_PH -1
#endif
    constexpr int rp = REP_PH;
    int li = 0;
#ifdef CUM_PH
    { a.ph_lo = 0; a.ph_hi = CUM_PH; a.li = li++; hipLaunchKernelGGL(mk_fwd, dim3(grid), dim3(NWAVES * 64), LDS_BYTES, stream, a);
      (void)hipMemsetAsync(ws + WS_CTL + CW_CNT * 4, 0, NEXP * 4, stream); }
#endif
    if (rp < 0) { a.ph_lo = 0; a.ph_hi = N_PHASES; a.li = li++; hipLaunchKernelGGL(mk_fwd, dim3(grid), dim3(NWAVES * 64), LDS_BYTES, stream, a); }
    else {
        a.ph_lo = 0; a.ph_hi = rp + 1; a.li = li++; hipLaunchKernelGGL(mk_fwd, dim3(grid), dim3(NWAVES * 64), LDS_BYTES, stream, a);
        if (rp == 4) (void)hipMemsetAsync(ws + WS_CTL + CW_CNT * 4, 0, NEXP * 4, stream);
#ifdef REP_P2
        a.pad = REP_P2;
#endif
#ifdef REP_GRID
        a.ph_lo = rp; a.ph_hi = rp + 1; a.li = li++; hipLaunchKernelGGL(mk_fwd, dim3(REP_GRID), dim3(NWAVES * 64), LDS_BYTES, stream, a);
#else
        a.ph_lo = rp; a.ph_hi = rp + 1; a.li = li++; hipLaunchKernelGGL(mk_fwd, dim3(grid), dim3(NWAVES * 64), LDS_BYTES, stream, a);
#endif
        a.pad = 0;
        if (rp + 1 < N_PHASES) { a.ph_lo = rp + 1; a.ph_hi = N_PHASES; a.li = li++; hipLaunchKernelGGL(mk_fwd, dim3(grid), dim3(NWAVES * 64), LDS_BYTES, stream, a); }
    }
    (void)p; (void)cnt;
}
```

```cpp
#include <hip/hip_runtime.h>
#include <cstdio>
#include <cstdint>
#include <cmath>

constexpr int BATCH = 4, SEQ = 8192, DM = 1024, NTOK = BATCH * SEQ;
constexpr int NPROJ = 1792;
constexpr int C_Q = 0, C_K = 512, C_V = 640, C_GU = 768, C_GV = 1280;
constexpr int NEXP = 32, DEXP = 256, NGRP = 4, EPG = 8;
constexpr int SLOT_CAP = 2 * NTOK + NEXP * 256;
constexpr float RMS_EPS = 1e-6f, LN_EPS = 1e-5f;

typedef unsigned short bf16_t;
__device__ __forceinline__ float bf2f(bf16_t v) { return __uint_as_float((unsigned)v << 16); }
__device__ __forceinline__ bf16_t f2bf(float f) { unsigned u = __float_as_uint(f); return (bf16_t)((u + 0x7fffu + ((u >> 16) & 1u)) >> 16); }

constexpr size_t MiB = 1u << 20;
constexpr size_t WS_CTL = 0, CTL_ZERO_BYTES = 1 * MiB;
constexpr size_t WS_TOKLIST = 58 * MiB;
constexpr size_t WS_RSLIST = 62 * MiB;
constexpr size_t WS_TOKREC = 66 * MiB;
constexpr size_t WS_TOKW = 67 * MiB;
constexpr size_t WS_SSQ = 68 * MiB;
constexpr size_t WS_XN = 72 * MiB;
constexpr size_t WS_PROJ = 136 * MiB;
constexpr size_t WS_MIXED = 248 * MiB;
constexpr size_t WS_HB = 312 * MiB;
constexpr size_t WS_HID = 376 * MiB;
constexpr size_t WS_Y = 72 * MiB;
constexpr size_t WS_AF = 412 * MiB;
constexpr size_t WS_VN = 72 * MiB;
constexpr size_t WS_HF = 376 * MiB;
constexpr size_t WS_END = 512 * MiB;
constexpr int CW_CNT = 64;

struct Params {
    const float* in[20];
    float* out;
    unsigned char* ws;
};

__device__ __forceinline__ float wave_sum(float v) {
#pragma unroll
    for (int o = 1; o < 64; o <<= 1) v += __shfl_xor(v, o);
    return v;
}
__device__ __forceinline__ float gelu_exact(float v) { return 0.5f * v * (1.0f + erff(v * 0.70710678118654752f)); }

#define LAS __attribute__((address_space(3)))
#define GAS __attribute__((address_space(1)))
typedef short bf16x8 __attribute__((ext_vector_type(8)));
typedef short s16x4 __attribute__((ext_vector_type(4)));
typedef float f32x4 __attribute__((ext_vector_type(4)));
typedef float f32x16 __attribute__((ext_vector_type(16)));
typedef float f32x2 __attribute__((ext_vector_type(2)));
typedef unsigned u32x4 __attribute__((ext_vector_type(4)));
typedef unsigned u32x2 __attribute__((ext_vector_type(2)));
typedef GAS unsigned gu32;

constexpr size_t WS_WIN_T = 2 * MiB;
constexpr size_t WS_WO_T = 6 * MiB;
constexpr size_t WS_WSP = 8 * MiB;
constexpr size_t WS_WR_T = 8 * MiB + 512 * 1024;
constexpr size_t WS_WGU_T = 10 * MiB;
constexpr size_t WS_WD_T = 42 * MiB;
constexpr int CW_TMO = 0;
constexpr int CW_BAR = 4096;

constexpr int NWAVES = 8;
constexpr int RING_BYTES = 131072;
constexpr int LDS_BYTES = 163840;
constexpr int MISC_OFF = 163840 - 1024;
constexpr float LOG2E = 1.4426950408889634f;

__device__ __forceinline__ unsigned cvt_pk_bf16(float lo, float hi) { unsigned r; asm volatile("v_cvt_pk_bf16_f32 %0, %1, %2" : "=v"(r) : "v"(lo), "v"(hi)); return r; }
#define MFMA32(a, b, c) __builtin_amdgcn_mfma_f32_32x32x16_bf16((a), (b), (c), 0, 0, 0)
#define MFMA16(a, b, c) __builtin_amdgcn_mfma_f32_16x16x32_bf16((a), (b), (c), 0, 0, 0)
typedef short v4i16_t __attribute__((ext_vector_type(4)));
__device__ __forceinline__ s16x4 vtr(const LAS unsigned char* p) { return __builtin_bit_cast(s16x4, __builtin_amdgcn_ds_read_tr16_b64_v4i16((LAS v4i16_t*)p)); }

namespace pg8 {
constexpr int BM = 256, BK = 64, HALF = 128, HTB = HALF * BK * 2, STAGE_BYTES = 8 * HTB, NXCD = 8, WGM = 8;
__host__ __device__ __forceinline__ int lds_byte(int r, int c) { const int st = (r >> 4) * 2 + (c >> 5), rr = r & 15, cc = c & 31, ob = rr * 64 + cc * 2; return st * 1024 + (ob ^ (((ob >> 9) & 1) << 5)); }
__host__ __device__ __forceinline__ void stage_rc(int b, int& R, int& C) { const int st = b / 1024, sb = b % 1024, swz = sb ^ (((sb >> 9) & 1) << 5); R = (st >> 1) * 16 + swz / 64; C = (st & 1) * 32 + (swz % 64) / 2; }
__host__ __device__ __forceinline__ int perm32(int rho) { const int n = rho >> 4, i = rho & 15; return 8 * (i >> 2) + 4 * n + (i & 3); }

struct Unit { int pm, pn, e, pos0, ne, nv; };
struct Gemm { const bf16_t* A; const bf16_t* Bt; int K; int pad; };

__device__ __forceinline__ int xcd_remap(int L, int nwg) { const int q = nwg / NXCD, r = nwg % NXCD, xcd = L % NXCD, off = L / NXCD; return (xcd < r ? xcd * (q + 1) : r * (q + 1) + (xcd - r) * q) + off; }

struct StaticOrder {
    int nM, nN, nwg, G, c, K;
    __device__ void init(int M, int N, int K_, int G_, int c_) { nM = M / BM; nN = N / BM; nwg = nM * nN; G = G_; c = c_; K = K_; }
    __device__ __forceinline__ bool next(int i, Unit& u) const {
        const long L = (long)i * G + c; if (L >= nwg) return false;
        const int wgid = xcd_remap((int)L, nwg);
        const int nig = WGM * nN, gid = wgid / nig, fm = gid * WGM, gsz = (nM - fm) < WGM ? (nM - fm) : WGM;
        u.pm = fm + ((wgid % nig) % gsz); u.pn = (wgid % nig) / gsz; u.e = 0; u.pos0 = 0; u.ne = 0; u.nv = BM; return true;
    }
    __device__ __forceinline__ size_t b_off(const Unit& u) const { return (size_t)u.pn * BM * K; }
    __device__ __forceinline__ int a_row(const Unit& u, int r) const { return u.pm * BM + r; }
};

template <class Epi, class Sched>
__device__ __forceinline__ void gemm_phase(LAS unsigned char* lds, const Gemm g, const Sched& S, const Epi& E) {
    const int tid = threadIdx.x, wid = __builtin_amdgcn_readfirstlane(tid >> 6), lane = tid & 63, wr = wid >> 2, wc = wid & 3, fr = lane & 15, fq = lane >> 4;
    const int K = g.K, nt = K / BK;
    unsigned voffB[2];
#pragma unroll
    for (int i = 0; i < 2; ++i) { int R, C; stage_rc(tid * 16 + i * 8192, R, C); const int Rb = Epi::PERM ? ((R >> 5) * 64 + perm32(R & 31)) : R;
        voffB[i] = (unsigned)(Rb * K + C) * 2u; }
    const size_t kstep = (size_t)(BK * 2);
    const size_t hstep = (size_t)(Epi::PERM ? 32 : HALF) * K * 2;
    const unsigned ldsw = (unsigned)wid * 1024u;
    const int aoff = lds_byte(wr * 64 + fr, fq * 8), boff = lds_byte(wc * 32 + fr, fq * 8);
#define PG8_SA(b, h) (((b) * 2 + (h)) * HTB)
#define PG8_SB(b, h) ((4 + (b) * 2 + (h)) * HTB)
#define PG8_STAGE2(bufoff, gbase, v0, v1) do { \
        __builtin_amdgcn_global_load_lds((const unsigned*)((const char*)(gbase) + (v0)), (LAS unsigned*)(lds + (bufoff) + ldsw), 16, 0, 0); \
        __builtin_amdgcn_global_load_lds((const unsigned*)((const char*)(gbase) + (v1)), (LAS unsigned*)(lds + (bufoff) + ldsw + 8192), 16, 0, 0); } while (0)
#define PG8_STAGEB(bufoff, gbase) PG8_STAGE2(bufoff, gbase, voffB[0], voffB[1])
#define PG8_VOFFA(dst, U) do { _Pragma("unroll") for (int _i = 0; _i < 2; ++_i) { int _R, _C; stage_rc(threadIdx.x * 16 + _i * 8192, _R, _C); _Pragma("unroll") for (int _h = 0; _h < 2; ++_h) \
        dst[_h][_i] = ((unsigned)S.a_row(U, _h * HALF + _R) * (unsigned)K + (unsigned)_C) * 2u; } } while (0)
#define PG8_LDA(dst, b, h) do { _Pragma("unroll") for (int m = 0; m < 4; ++m) _Pragma("unroll") for (int k = 0; k < 2; ++k) dst[m][k] = *(const LAS bf16x8*)(lds + PG8_SA(b, h) + aoff + m * 2048 + k * 1024); } while (0)
#define PG8_LDB(dst, b, h) do { _Pragma("unroll") for (int n = 0; n < 2; ++n) _Pragma("unroll") for (int k = 0; k < 2; ++k) dst[n][k] = *(const LAS bf16x8*)(lds + PG8_SB(b, h) + boff + n * 2048 + k * 1024); } while (0)
#define PG8_MMA(ai, bj, At, Bt) do { if ((ai) * HALF + wr * 64 < cur.nv) { __builtin_amdgcn_s_setprio(1); _Pragma("unroll") for (int m = 0; m < 4; ++m) _Pragma("unroll") for (int n = 0; n < 2; ++n) _Pragma("unroll") for (int k = 0; k < 2; ++k) \
        acc[ai][bj][m][n] = __builtin_amdgcn_mfma_f32_16x16x32_bf16(Bt[n][k], At[m][k], acc[ai][bj][m][n], 0, 0, 0); __builtin_amdgcn_s_setprio(0); } } while (0)
#define PG8_WAIT_V(n) asm volatile("s_waitcnt vmcnt(" #n ")" ::: "memory")
#define PG8_WAIT_L(n) asm volatile("s_waitcnt lgkmcnt(" #n ")" ::: "memory")
#define PG8_BAR __builtin_amdgcn_s_barrier()
#define PG8_SCHED __builtin_amdgcn_sched_barrier(0)
    Unit cur, nxt; int ui = 0;
    if (!S.next(0, cur)) return;
    f32x4 acc[2][2][4][2];
#pragma unroll
    for (int a = 0; a < 2; ++a)
#pragma unroll
        for (int b = 0; b < 2; ++b)
#pragma unroll
            for (int m = 0; m < 4; ++m)
#pragma unroll
                for (int n = 0; n < 2; ++n) acc[a][b][m][n] = (f32x4){0.f, 0.f, 0.f, 0.f};
    bf16x8 At[4][2], B0[2][2], B1[2][2];
    const char* Ab = (const char*)g.A;
    const char* cB = (const char*)(g.Bt + S.b_off(cur));
    unsigned vA[2][2], nvA[2][2];
    PG8_VOFFA(vA, cur);
    PG8_STAGEB(PG8_SB(0, 0), cB); PG8_STAGEB(PG8_SB(0, 1), cB + hstep); PG8_STAGE2(PG8_SA(0, 0), Ab, vA[0][0], vA[0][1]); PG8_STAGE2(PG8_SA(0, 1), Ab, vA[1][0], vA[1][1]);
    if (wr == 1) PG8_BAR;
    PG8_WAIT_V(2); PG8_BAR;
    PG8_STAGEB(PG8_SB(1, 0), cB + kstep); PG8_STAGE2(PG8_SA(1, 0), Ab + kstep, vA[0][0], vA[0][1]); PG8_STAGEB(PG8_SB(1, 1), cB + hstep + kstep);
    PG8_WAIT_V(6); PG8_BAR;
    for (;;) {
        const bool has_next = S.next(ui + 1, nxt);
        const char* nB = cB;
#pragma unroll
        for (int h = 0; h < 2; ++h)
#pragma unroll
            for (int i = 0; i < 2; ++i) nvA[h][i] = vA[h][i];
        if (has_next) { nB = (const char*)(g.Bt + S.b_off(nxt)); PG8_VOFFA(nvA, nxt); }
        for (int t = 0; t < nt; t += 2) {
            const bool last = (t == nt - 2);
            const char* a1 = Ab + (size_t)(t + 1) * kstep;
            const char* a2 = last ? Ab : Ab + (size_t)(t + 2) * kstep; const char* b2 = last ? nB : cB + (size_t)(t + 2) * kstep;
            const char* a3 = a2 + kstep; const char* b3 = b2 + kstep;
            unsigned o00 = vA[0][0], o01 = vA[0][1], o10 = vA[1][0], o11 = vA[1][1];
            if (last) { asm volatile("" : "+v"(nvA[0][0]), "+v"(nvA[0][1]), "+v"(nvA[1][0]), "+v"(nvA[1][1])); o00 = nvA[0][0]; o01 = nvA[0][1]; o10 = nvA[1][0]; o11 = nvA[1][1]; }
            PG8_LDB(B0, 0, 0); PG8_LDB(B1, 0, 1); PG8_SCHED; PG8_LDA(At, 0, 0); PG8_STAGE2(PG8_SA(1, 1), a1, vA[1][0], vA[1][1]);
            PG8_WAIT_V(8); PG8_WAIT_L(0); PG8_BAR; PG8_MMA(0, 0, At, B0); PG8_MMA(0, 1, At, B1); PG8_BAR; PG8_SCHED;
            PG8_LDA(At, 0, 1); PG8_STAGEB(PG8_SB(0, 0), b2); PG8_STAGEB(PG8_SB(0, 1), b2 + hstep); PG8_STAGE2(PG8_SA(0, 0), a2, o00, o01);
            PG8_WAIT_V(8); PG8_WAIT_L(0); PG8_BAR; PG8_MMA(1, 0, At, B0); PG8_MMA(1, 1, At, B1); PG8_BAR; PG8_SCHED;
            PG8_LDB(B0, 1, 0); PG8_LDB(B1, 1, 1); PG8_SCHED; PG8_LDA(At, 1, 0); PG8_STAGE2(PG8_SA(0, 1), a2, o10, o11);
            PG8_WAIT_V(8); PG8_WAIT_L(0); PG8_BAR; PG8_MMA(0, 0, At, B0); PG8_MMA(0, 1, At, B1); PG8_BAR; PG8_SCHED;
            PG8_LDA(At, 1, 1); PG8_STAGEB(PG8_SB(1, 0), b3); PG8_STAGEB(PG8_SB(1, 1), b3 + hstep); PG8_STAGE2(PG8_SA(1, 0), a3, o00, o01);
            PG8_WAIT_V(8); PG8_WAIT_L(0); PG8_BAR; PG8_MMA(1, 0, At, B0); PG8_MMA(1, 1, At, B1); PG8_BAR; PG8_SCHED;
        }
        if (wr == 0) PG8_BAR;
        E(acc, cur, wr, wc, fr, fq);
        if (!has_next) break;
#pragma unroll
        for (int a = 0; a < 2; ++a)
#pragma unroll
            for (int b = 0; b < 2; ++b)
#pragma unroll
                for (int m = 0; m < 4; ++m)
#pragma unroll
                    for (int n = 0; n < 2; ++n) acc[a][b][m][n] = (f32x4){0.f, 0.f, 0.f, 0.f};
        cur = nxt; cB = nB; ++ui;
#pragma unroll
        for (int h = 0; h < 2; ++h)
#pragma unroll
            for (int i = 0; i < 2; ++i) vA[h][i] = nvA[h][i];
        if (wr == 1) PG8_BAR;
    }
    PG8_WAIT_V(0);
    PG8_BAR;
#undef PG8_SA
#undef PG8_SB
#undef PG8_STAGE2
#undef PG8_STAGEB
#undef PG8_VOFFA
#undef PG8_LDA
#undef PG8_LDB
#undef PG8_MMA
#undef PG8_WAIT_V
#undef PG8_WAIT_L
#undef PG8_BAR
#undef PG8_SCHED
}

__device__ __forceinline__ f32x2 gelu_pk(f32x2 v) {
    const f32x2 av = __builtin_elementwise_abs(v), d = av * 0.2316418882f + 1.0f;
    f32x2 t; t.x = __builtin_amdgcn_rcpf(d.x); t.y = __builtin_amdgcn_rcpf(d.y);
    f32x2 q = t * 0.5307027145f + (-0.7265760135f); q = q * t + 0.7107068705f; q = q * t + (-0.142248368f); q = q * t + 0.127414796f; q = q * t;
    const f32x2 s = (v * v) * (-0.72134752044f);
    f32x2 e; e.x = __builtin_amdgcn_exp2f(s.x); e.y = __builtin_amdgcn_exp2f(s.y);
    const f32x2 m = v * (q * e), r = v - m;
    f32x2 o; o.x = v.x < 0.f ? m.x : r.x; o.y = v.y < 0.f ? m.y : r.y; return o;
}

struct EpiBf16G {
    static constexpr bool PERM = true;
    bf16_t* O; int ldc; int gelu_from; f32x2* STAT; int stat_from; int pad;
    __device__ __forceinline__ void operator()(const f32x4 (&acc)[2][2][4][2], const Unit& u, int wr, int wc, int fr, int fq) const {
        const int row0 = u.pm * BM + wr * 64 + fr, col0 = u.pn * BM + wc * 64 + 8 * fq, rl0 = wr * 64 + fr;
        const bool act = u.pn >= gelu_from, st = u.pn >= stat_from;
#pragma unroll
        for (int ai = 0; ai < 2; ++ai)
#pragma unroll
            for (int m = 0; m < 4; ++m) { bf16_t* rowp = O + (size_t)(row0 + ai * HALF + m * 16) * ldc + col0; float s1 = 0.f, s2 = 0.f;
                const bool live = rl0 + ai * HALF + m * 16 < u.nv;
#pragma unroll
                for (int bj = 0; bj < 2; ++bj) { f32x4 v0 = acc[ai][bj][m][0], v1 = acc[ai][bj][m][1];
                    if (act) { f32x2 a = gelu_pk((f32x2){v0[0], v0[1]}), b = gelu_pk((f32x2){v0[2], v0[3]}), c = gelu_pk((f32x2){v1[0], v1[1]}), d = gelu_pk((f32x2){v1[2], v1[3]});
                        v0 = (f32x4){a.x, a.y, b.x, b.y}; v1 = (f32x4){c.x, c.y, d.x, d.y}; }
                    if (st) { s1 += (v0[0] + v0[1]) + (v0[2] + v0[3]) + (v1[0] + v1[1]) + (v1[2] + v1[3]);
                        s2 += (v0[0] * v0[0] + v0[1] * v0[1]) + (v0[2] * v0[2] + v0[3] * v0[3]) + (v1[0] * v1[0] + v1[1] * v1[1]) + (v1[2] * v1[2] + v1[3] * v1[3]); }
                    u32x4 w; w.x = cvt_pk_bf16(v0[0], v0[1]); w.y = cvt_pk_bf16(v0[2], v0[3]); w.z = cvt_pk_bf16(v1[0], v1[1]); w.w = cvt_pk_bf16(v1[2], v1[3]);
                    if (live) *(u32x4*)(rowp + bj * 32) = w; }
                if (st) { s1 += __shfl_xor(s1, 16); s1 += __shfl_xor(s1, 32); s2 += __shfl_xor(s2, 16); s2 += __shfl_xor(s2, 32);
                    if (fq == 0) STAT[(size_t)(row0 + ai * HALF + m * 16) * 8 + (u.pn - stat_from) * 4 + wc] = (f32x2){s1, s2}; } }
    }
};
struct EpiH {
    static constexpr bool PERM = true;
    const float* x; bf16_t* HB; float* SSQ;
    __device__ __forceinline__ void operator()(const f32x4 (&acc)[2][2][4][2], const Unit& u, int wr, int wc, int fr, int fq) const {
        const int row0 = u.pm * BM + wr * 64 + fr, col0 = u.pn * BM + wc * 64 + 8 * fq;
#pragma unroll
        for (int ai = 0; ai < 2; ++ai)
#pragma unroll
            for (int m = 0; m < 4; ++m) { const int row = row0 + ai * HALF + m * 16; const float* xr = x + (size_t)row * DM + col0; bf16_t* hr = HB + (size_t)row * DM + col0; float s = 0.f;
#pragma unroll
                for (int bj = 0; bj < 2; ++bj) { const f32x4 x0 = __builtin_nontemporal_load((const f32x4*)(xr + bj * 32)), x1 = __builtin_nontemporal_load((const f32x4*)(xr + bj * 32 + 4));
                    const f32x4 v0 = acc[ai][bj][m][0] + x0, v1 = acc[ai][bj][m][1] + x1;
                    s += (v0[0] * v0[0] + v0[1] * v0[1]) + (v0[2] * v0[2] + v0[3] * v0[3]) + (v1[0] * v1[0] + v1[1] * v1[1]) + (v1[2] * v1[2] + v1[3] * v1[3]);
                    u32x4 w; w.x = cvt_pk_bf16(v0[0], v0[1]); w.y = cvt_pk_bf16(v0[2], v0[3]); w.z = cvt_pk_bf16(v1[0], v1[1]); w.w = cvt_pk_bf16(v1[2], v1[3]);
                    *(u32x4*)(hr + bj * 32) = w; }
                s += __shfl_xor(s, 16); s += __shfl_xor(s, 32);
                if (fq == 0) SSQ[(size_t)row * 16 + u.pn * 4 + wc] = s; }
    }
};
}

template <bool GATHER>
struct MoeOrder {
    const volatile LAS int* toff;
    const int* cnt; const int* toklist;
    int nN, nwg, G, c, K, rows_per_e;
    __device__ __forceinline__ bool next(int i, pg8::Unit& u) const {
        const long L = (long)i * G + c; if (L >= nwg) return false;
        const int wgid = pg8::xcd_remap((int)L, nwg);
        const int T = wgid / nN; u.pn = wgid % nN; u.pm = T;
        int e = 0;
        for (int j = 1; j < NEXP; ++j) e += (toff[j] <= T) ? 1 : 0;
        e = __builtin_amdgcn_readfirstlane(e);
        u.e = e; u.pos0 = __builtin_amdgcn_readfirstlane((T - toff[e]) * 256); u.ne = __builtin_amdgcn_readfirstlane(toff[64 + e]); { const int left = u.ne - u.pos0; u.nv = left < 256 ? left : 256; } return true;
    }
    __device__ __forceinline__ size_t b_off(const pg8::Unit& u) const { return ((size_t)u.e * rows_per_e + (size_t)u.pn * 256) * K; }
    __device__ __forceinline__ int a_row(const pg8::Unit& u, int r) const {
        if (!GATHER) return u.pm * 256 + r;
        const int pos = u.pos0 + r;
        return pos < u.ne ? toklist[(size_t)u.e * NTOK + pos] : 0;
    }
};
struct EpiSwiglu {
    static constexpr bool PERM = true;
    bf16_t* HID; const float* rslist;
    __device__ __forceinline__ void operator()(const f32x4 (&acc)[2][2][4][2], const pg8::Unit& u, int wr, int wc, int fr, int fq) const {
        const int r0 = wr * 64 + fr, col0 = u.pn * 128 + wc * 32 + 8 * fq; const int pos0 = u.pos0, n_e = u.ne;
#pragma unroll
        for (int ai = 0; ai < 2; ++ai)
#pragma unroll
            for (int m = 0; m < 4; ++m) { const int r = r0 + ai * 128 + m * 16, pos = pos0 + r;
                const float rs = pos < n_e ? rslist[(size_t)u.e * NTOK + pos] : 0.f;
                float o[8];
#pragma unroll
                for (int n = 0; n < 2; ++n)
#pragma unroll
                    for (int j = 0; j < 4; ++j) { const float gt = acc[ai][0][m][n][j] * rs, up = acc[ai][1][m][n][j] * rs;
                        o[4 * n + j] = gt * __builtin_amdgcn_rcpf(1.f + __builtin_amdgcn_exp2f(-gt * LOG2E)) * up; }
                u32x4 w; w.x = cvt_pk_bf16(o[0], o[1]); w.y = cvt_pk_bf16(o[2], o[3]); w.z = cvt_pk_bf16(o[4], o[5]); w.w = cvt_pk_bf16(o[6], o[7]);
                if (r < u.nv || true) *(u32x4*)(HID + (size_t)(u.pm * 256 + r) * DEXP + col0) = w; }
    }
};

#define XB_TMO      128
#define XB_XCNT(j)  (256  + 64 * (j))
#define XB_XSUB(j)  (1280 + 64 * (j))
#define XB_XGEN(j)  (2304 + 64 * (j))
#define XB_TOP      3328
#define XB_TOPGEN   3392
#define XCD_BAR_WORDS 3456
#define XB_SPIN_CAP (1u << 18)
__device__ __forceinline__ unsigned xb_ld(unsigned* p)              { return __hip_atomic_load(p, __ATOMIC_RELAXED, __HIP_MEMORY_SCOPE_AGENT); }
__device__ __forceinline__ unsigned xb_add(unsigned* p, unsigned v) { return __hip_atomic_fetch_add(p, v, __ATOMIC_RELAXED, __HIP_MEMORY_SCOPE_AGENT); }
__device__ __forceinline__ unsigned xb_xcc_id() { return (unsigned)__builtin_amdgcn_s_getreg((3 << 11) | 20) & 0xFu; }
#define XB_SPIN(cond, bar) do { unsigned _sp = 0; while (cond) { __builtin_amdgcn_s_sleep(1); \
    if ((++_sp & 255u) == 0u) { if (xb_ld(&(bar)[XB_TMO])) break; if (_sp > XB_SPIN_CAP) { atomicAdd(&(bar)[XB_TMO], 1u); break; } } } } while (0)
struct XcdBarrier { unsigned* bar; unsigned x; volatile LAS unsigned* st; };
__device__ __forceinline__ XcdBarrier xcd_barrier_post(unsigned* bar, volatile LAS unsigned* st) {
    XcdBarrier b; b.bar = bar; b.x = xb_xcc_id(); b.st = st;
    if (threadIdx.x == 0) (void)xb_add(&bar[XB_XCNT(b.x)], 1u);
    return b;
}
__device__ __forceinline__ void xcd_barrier_complete(unsigned* bar, unsigned x, unsigned& nloc, unsigned& nx) {
    const unsigned G = gridDim.x * gridDim.y * gridDim.z;
    unsigned sum, cnt, mine, sp = 0u;
    for (;;) {
        sum = 0u; cnt = 0u; mine = 0u;
#pragma unroll
        for (unsigned j = 0; j < 16; ++j) { const unsigned c = xb_ld(&bar[XB_XCNT(j)]); sum += c; cnt += (c > 0u) ? 1u : 0u; mine = (j == x) ? c : mine; }
        if (sum == G) break;
        __builtin_amdgcn_s_sleep(1);
        if ((++sp & 255u) == 0u) { if (xb_ld(&bar[XB_TMO])) break; if (sp > XB_SPIN_CAP) { atomicAdd(&bar[XB_TMO], 1u); break; } }
    }
    nloc = mine > 0u ? mine : 1u; nx = cnt > 0u ? cnt : 1u;
}
__device__ __forceinline__ void xcd_barrier(const XcdBarrier& b) {
    asm volatile("s_waitcnt vmcnt(0)" ::: "memory");
    __syncthreads();
    if (threadIdx.x == 0) {
        unsigned* bar = b.bar;
        __builtin_amdgcn_s_waitcnt(0);
        unsigned nloc = b.st[0], nx = b.st[1];
        if (nloc == 0u) { xcd_barrier_complete(bar, b.x, nloc, nx); b.st[0] = nloc; b.st[1] = nx; }
        const unsigned old = xb_add(&bar[XB_XSUB(b.x)], 1u);
        const unsigned gen = old / nloc;
        if (old + 1u == (gen + 1u) * nloc) {
            __builtin_amdgcn_fence(__ATOMIC_RELEASE, "agent");
            asm volatile("s_waitcnt vmcnt(0)" ::: "memory");
            const unsigned og = xb_add(&bar[XB_TOP], 1u);
            const unsigned tg = og / nx;
            if (og + 1u == (tg + 1u) * nx) xb_add(&bar[XB_TOPGEN], 1u);
            else XB_SPIN(xb_ld(&bar[XB_TOPGEN]) == tg, bar);
            __builtin_amdgcn_fence(__ATOMIC_ACQUIRE, "agent");
            xb_add(&bar[XB_XGEN(b.x)], 1u);
            asm volatile("s_waitcnt vmcnt(0)" ::: "memory");
        } else {
            XB_SPIN(xb_ld(&bar[XB_XGEN(b.x)]) == gen, bar);
            __builtin_amdgcn_fence(__ATOMIC_ACQUIRE, "agent");
            asm volatile("s_waitcnt vmcnt(0)" ::: "memory");
        }
    }
    __syncthreads();
}

struct Frame {
    LAS unsigned char* lds;
    volatile LAS unsigned* MISC;
    int tid, lane, wave, vcu, G;
    const float* const* in; float* out; unsigned char* ws;
};
#define LDS_WAIT() asm volatile("s_waitcnt lgkmcnt(0)" ::: "memory")

__device__ __forceinline__ void transpose_tile64(const float* W, int ldw, int k0, int n0, bf16_t* WT, int ldt, int rowbase, const float* kscale, int lane, int hi32 = 32) {
    const float* src = W + (size_t)k0 * ldw + n0 + lane;
    float v[64];
#pragma unroll
    for (int k = 0; k < 64; ++k) v[k] = __builtin_nontemporal_load(src + (size_t)k * ldw);
    if (kscale) {
#pragma unroll
        for (int k = 0; k < 64; ++k) v[k] *= kscale[k0 + k];
    }
    bf16_t* dst = WT + (size_t)(rowbase + (lane & 31) + (lane >> 5) * hi32) * ldt + k0;
#pragma unroll
    for (int c = 0; c < 8; ++c) { u32x4 o; o.x = cvt_pk_bf16(v[8 * c], v[8 * c + 1]); o.y = cvt_pk_bf16(v[8 * c + 2], v[8 * c + 3]); o.z = cvt_pk_bf16(v[8 * c + 4], v[8 * c + 5]); o.w = cvt_pk_bf16(v[8 * c + 6], v[8 * c + 7]);
        *(u32x4*)(dst + 8 * c) = o; }
}
template <int WHICH> __device__ __forceinline__ void convert_rest(Frame& F, int part, int nparts);
__device__ __forceinline__ void p0_prologue(Frame& F) {
    const int gw = F.vcu * NWAVES + F.wave, NGW = F.G * NWAVES, lane = F.lane;
    unsigned char* ws = F.ws;
    for (int it = gw; it < 16 * 28; it += NGW) { const int kb = it / 28, nb = it % 28; transpose_tile64(F.in[2], NPROJ, 64 * kb, 64 * nb, (bf16_t*)(ws + WS_WIN_T), DM, 64 * nb, nullptr, lane); }
    const int gt = F.vcu * (NWAVES * 64) + F.tid, NGT = F.G * NWAVES * 64;
    for (int i = gt; i < 8 * 128 * 128; i += NGT) { const int c = i & 127, t = (i >> 7) & 127; ((bf16_t*)(ws + WS_WSP))[i] = c <= t ? f2bf(F.in[4][i]) : (bf16_t)0; }
    for (int i = gt; i < 64 * DM; i += NGT) { const int k = i & (DM - 1), c = i >> 10; float v = 0.f;
        if (c < 4) v = F.in[12][k * 4 + c] * F.in[11][k];
        else if (c < 36) { const int g = (c - 4) >> 3, e = (c - 4) & 7; v = F.in[14][((size_t)g * DM + k) * 8 + e] * F.in[11][k]; }
        ((bf16_t*)(ws + WS_WR_T))[i] = f2bf(v); }
    const float* g = F.in[1];
    f32x4 gg[4];
#pragma unroll
    for (int j = 0; j < 4; ++j) gg[j] = *(const f32x4*)(g + 256 * j + 4 * lane);
    for (int row0 = gw * 8; row0 < NTOK; row0 += NGW * 8) {
        f32x4 v[8][4];
#pragma unroll
        for (int rr = 0; rr < 8; ++rr)
#pragma unroll
            for (int j = 0; j < 4; ++j) v[rr][j] = __builtin_nontemporal_load((const f32x4*)(F.in[0] + (size_t)(row0 + rr) * DM + 256 * j + 4 * lane));
#pragma unroll
        for (int rr = 0; rr < 8; ++rr) {
            float s = 0.f;
#pragma unroll
            for (int j = 0; j < 4; ++j) s += (v[rr][j][0] * v[rr][j][0] + v[rr][j][1] * v[rr][j][1]) + (v[rr][j][2] * v[rr][j][2] + v[rr][j][3] * v[rr][j][3]);
            const float rstd = rsqrtf(wave_sum(s) * (1.f / DM) + RMS_EPS);
            bf16_t* xn = (bf16_t*)(ws + WS_XN) + (size_t)(row0 + rr) * DM;
#pragma unroll
            for (int j = 0; j < 4; ++j) { u32x2 o; o.x = cvt_pk_bf16(v[rr][j][0] * rstd * gg[j][0], v[rr][j][1] * rstd * gg[j][1]); o.y = cvt_pk_bf16(v[rr][j][2] * rstd * gg[j][2], v[rr][j][3] * rstd * gg[j][3]);
                *(u32x2*)(xn + 256 * j + 4 * lane) = o; }
        }
    }
    convert_rest<0>(F, gw, NGW);
}
template <int WHICH>
__device__ __forceinline__ void convert_rest(Frame& F, int part, int nparts) {
    unsigned char* ws = F.ws; const int lane = F.lane;
    constexpr int T_OUT = 16 * 16, T_GU = NEXP * 64, T_D = NEXP * 64;
    if (WHICH == 0) {
        for (int it = part; it < 2 * T_GU; it += nparts) {
            int r = it; const int up = r >= T_GU; if (up) r -= T_GU; const int e = r / 64, q = r % 64, kb = q / 4, nb = q % 4, n0 = 64 * nb;
            const int rowbase = e * 512 + 256 * (n0 >> 7) + 2 * (n0 & 127) + (up ? 32 : 0);
            transpose_tile64(F.in[up ? 17 : 16] + (size_t)e * DM * DEXP, DEXP, 64 * kb, n0, (bf16_t*)(ws + WS_WGU_T), DM, rowbase, F.in[11], lane, 64); }
    } else if (WHICH == 1) {
        for (int it = part; it < T_OUT; it += nparts) { const int kb = it / 16, nb = it % 16; transpose_tile64(F.in[10], DM, 64 * kb, 64 * nb, (bf16_t*)(ws + WS_WO_T), DM, 64 * nb, nullptr, lane); }
    } else {
        for (int it = part; it < T_D; it += nparts) { const int e = it / 64, q = it % 64, kb = q / 16, nb = q % 16;
            transpose_tile64(F.in[18] + (size_t)e * DEXP * DM, DM, 64 * kb, 64 * nb, (bf16_t*)(ws + WS_WD_T), DEXP, e * DM + 64 * nb, nullptr, lane); }
    }
}

constexpr int P2_K_OFF = 0, P2_KROW = 144, P2_KHEAD = 256 * P2_KROW;
constexpr int P2_V_OFF = 2 * P2_KHEAD, P2_VHEAD = 256 * 128;
constexpr int P2_VN_OFF = 0, P2_VNROW = 1088;
constexpr int P2_EXA_OFF = 139264, P2_EXG_OFF = P2_EXA_OFF + 4096;
static_assert(P2_V_OFF + 2 * P2_VHEAD <= P2_EXA_OFF && 128 * P2_VNROW <= P2_EXA_OFF && P2_EXG_OFF + 4096 <= MISC_OFF, "P2 LDS map");

__device__ __forceinline__ void p2_mix(Frame& F, const int skip) {
    const int tid = F.tid, lane = F.lane, w = F.wave;
    const int r = lane & 31, hh = lane >> 5, g4 = lane >> 4, q4 = (lane & 15) >> 2, p4 = lane & 3;
    const bf16_t* proj = (const bf16_t*)(F.ws + WS_PROJ);
    bf16_t* mixed = (bf16_t*)(F.ws + WS_MIXED);
    const bf16_t* wsp = (const bf16_t*)(F.ws + WS_WSP);
    LAS unsigned char* lds = F.lds;
    LAS float* exA = (LAS float*)(lds + P2_EXA_OFF); LAS float* exG = (LAS float*)(lds + P2_EXG_OFF);
    const float sink2 = F.in[3][w] * LOG2E;
    const float SC2 = 0.125f * LOG2E;
    for (int unit = F.vcu; unit < NTOK / 128; unit += F.G) {
        const int t0 = unit * 128; const bool first = (unit & 63) == 0;
        {
            u32x4 kv[8], vv[8];
#pragma unroll
            for (int i = 0; i < 8; ++i) { const int pc = tid + 512 * i, key = pc >> 4, sub = pc & 15;
                kv[i] = (u32x4){0u, 0u, 0u, 0u}; vv[i] = (u32x4){0u, 0u, 0u, 0u};
                if (!(first && key < 128)) { const bf16_t* rowp = proj + (size_t)(t0 - 128 + key) * NPROJ; kv[i] = *(const u32x4*)(rowp + C_K + sub * 8); vv[i] = *(const u32x4*)(rowp + C_V + sub * 8); } }
            { unsigned dummy = 0u;
#pragma unroll
              for (int i = 0; i < 4; ++i) { const int ln = tid + 512 * i, row = ln >> 4, seg = ln & 15; dummy += *(const unsigned*)(proj + (size_t)(t0 + row) * NPROJ + C_GU + seg * 64); }
              asm volatile("" :: "v"(dummy)); }
#pragma unroll
            for (int i = 0; i < 8; ++i) { const int pc = tid + 512 * i, key = pc >> 4, sub = pc & 15, kvh = sub >> 3, piece = sub & 7;
                *(LAS u32x4*)(lds + P2_K_OFF + kvh * P2_KHEAD + key * P2_KROW + piece * 16) = kv[i];
                *(LAS u32x4*)(lds + P2_V_OFF + kvh * P2_VHEAD + key * 128 + ((piece ^ (((key >> 1) & 1) << 2)) * 16)) = vv[i]; }
        }
        if (!(skip & 1)) {
            const int kvh = w >> 2;
            const LAS unsigned char* Kl = lds + P2_K_OFF + kvh * P2_KHEAD;
            const LAS unsigned char* Vl = lds + P2_V_OFF + kvh * P2_VHEAD;
            const int vflip = (q4 >> 1) & 1;
            const int vlane = (4 * hh + q4) * 128 + (g4 & 1) * 32 + p4 * 8;
            const int vh0 = vflip * 64, vh1 = (vflip ^ 1) * 64;
            const bf16_t* qbase = proj + (size_t)(t0 + r) * NPROJ + C_Q + 64 * w + 8 * hh;
            bf16x8 qn[4];
#pragma unroll
            for (int s = 0; s < 4; ++s) qn[s] = __builtin_nontemporal_load((const bf16x8*)(qbase + 16 * s));
            __syncthreads();
            for (int qb = 0; qb < 4; ++qb) {
                bf16x8 qf[4];
#pragma unroll
                for (int s = 0; s < 4; ++s) qf[s] = qn[s];
                if (qb < 3) {
#pragma unroll
                    for (int s = 0; s < 4; ++s) qn[s] = __builtin_nontemporal_load((const bf16x8*)(qbase + (size_t)(32 * (qb + 1)) * NPROJ + 16 * s));
                }
                f32x16 sa[5];
#pragma unroll
                for (int cc = 0; cc < 5; ++cc) {
#pragma unroll
                    for (int i = 0; i < 16; ++i) sa[cc][i] = 0.f;
                    const LAS unsigned char* kp = Kl + (32 * (qb + cc) + r) * P2_KROW + 16 * hh;
#pragma unroll
                    for (int s = 0; s < 4; ++s) { const bf16x8 kf = *(const LAS bf16x8*)(kp + 32 * s); sa[cc] = MFMA32(kf, qf[s], sa[cc]); }
                }
                const int q = 32 * qb + r; float mr = -1e30f;
#pragma unroll
                for (int cc = 0; cc < 5; ++cc)
#pragma unroll
                    for (int i = 0; i < 16; ++i) { const int kb = 32 * (qb + cc) + (i & 3) + 8 * (i >> 2) + 4 * hh;
                        if (cc == 0 || cc == 4 || first) { bool ok = true; if (cc == 0) ok = kb >= q + 1; if (cc == 4) ok = kb <= q + 128; if (first) ok = ok && kb >= 128; sa[cc][i] = ok ? sa[cc][i] : -1e30f; }
                        mr = fmaxf(mr, sa[cc][i]); }
                mr = fmaxf(mr, __shfl_xor(mr, 32));
                const float mx = fmaxf(mr * SC2, sink2);
                float sum = 0.f;
#pragma unroll
                for (int cc = 0; cc < 5; ++cc)
#pragma unroll
                    for (int i = 0; i < 16; ++i) { const float pe = __builtin_amdgcn_exp2f(fmaf(sa[cc][i], SC2, -mx)); sa[cc][i] = pe; sum += pe; }
                sum += __shfl_xor(sum, 32);
                const float inv = 1.f / (sum + __builtin_amdgcn_exp2f(sink2 - mx));
                f32x16 o[2];
#pragma unroll
                for (int i = 0; i < 16; ++i) { o[0][i] = 0.f; o[1][i] = 0.f; }
#pragma unroll
                for (int cc = 0; cc < 5; ++cc)
#pragma unroll
                    for (int s2 = 0; s2 < 2; ++s2) {
                        u32x4 pw; pw.x = cvt_pk_bf16(sa[cc][8 * s2 + 0], sa[cc][8 * s2 + 1]); pw.y = cvt_pk_bf16(sa[cc][8 * s2 + 2], sa[cc][8 * s2 + 3]);
                        pw.z = cvt_pk_bf16(sa[cc][8 * s2 + 4], sa[cc][8 * s2 + 5]); pw.w = cvt_pk_bf16(sa[cc][8 * s2 + 6], sa[cc][8 * s2 + 7]);
                        const bf16x8 pf = __builtin_bit_cast(bf16x8, pw);
                        const LAS unsigned char* vp = Vl + (32 * (qb + cc) + 16 * s2) * 128 + vlane;
#pragma unroll
                        for (int db = 0; db < 2; ++db) { const int vh = db ? vh1 : vh0; const s16x4 a0 = vtr(vp + vh), a1 = vtr(vp + 8 * 128 + vh);
                            const bf16x8 vf = (bf16x8){a0[0], a0[1], a0[2], a0[3], a1[0], a1[1], a1[2], a1[3]};
                            o[db] = MFMA32(vf, pf, o[db]); }
                    }
                float ss = 0.f;
#pragma unroll
                for (int db = 0; db < 2; ++db)
#pragma unroll
                    for (int i = 0; i < 16; ++i) { o[db][i] *= inv; ss += o[db][i] * o[db][i]; }
                ss += __shfl_xor(ss, 32);
                if (hh == 0) exA[(qb * 8 + w) * 32 + r] = ss;
                __syncthreads();
                float tot = 0.f;
#pragma unroll
                for (int j = 0; j < 8; ++j) tot += exA[(qb * 8 + j) * 32 + r];
                const float rstd = rsqrtf(tot * (1.f / 512) + RMS_EPS);
                bf16_t* orow = mixed + (size_t)(t0 + q) * DM + 64 * w + 4 * hh;
                const float* ga = F.in[8] + 64 * w + 4 * hh;
#pragma unroll
                for (int db = 0; db < 2; ++db)
#pragma unroll
                    for (int rg = 0; rg < 4; ++rg) { const f32x4 gg = *(const f32x4*)(ga + 32 * db + 8 * rg);
                        u32x2 ow; ow.x = cvt_pk_bf16(o[db][4 * rg] * rstd * gg[0], o[db][4 * rg + 1] * rstd * gg[1]); ow.y = cvt_pk_bf16(o[db][4 * rg + 2] * rstd * gg[2], o[db][4 * rg + 3] * rstd * gg[3]);
                        *(u32x2*)(orow + 32 * db + 8 * rg) = ow; }
            }
        }
        if (!(skip & 2)) {
            u32x4 raw[16];
#pragma unroll
            for (int i = 0; i < 16; ++i) raw[i] = __builtin_nontemporal_load((const u32x4*)(proj + (size_t)(t0 + 16 * w + i) * NPROJ + C_GV + 8 * lane));
            const f32x4 lg0 = *(const f32x4*)(F.in[6] + 8 * lane), lg1 = *(const f32x4*)(F.in[6] + 8 * lane + 4), lb0 = *(const f32x4*)(F.in[7] + 8 * lane), lb1 = *(const f32x4*)(F.in[7] + 8 * lane + 4);
            LAS f32x2* stat = (LAS f32x2*)(lds + P2_EXG_OFF);
            if (tid < 128) { const f32x4* sp = (const f32x4*)((const float*)(F.ws + WS_SSQ) + (size_t)(t0 + tid) * 16); const f32x4 a = sp[0], b = sp[1], c = sp[2], d = sp[3];
                const float s1 = (a[0] + a[2]) + (b[0] + b[2]) + (c[0] + c[2]) + (d[0] + d[2]), s2 = (a[1] + a[3]) + (b[1] + b[3]) + (c[1] + c[3]) + (d[1] + d[3]);
                const float mu = s1 * (1.f / 512), var = fmaxf(s2 * (1.f / 512) - mu * mu, 0.f); stat[tid] = (f32x2){mu, rsqrtf(var + LN_EPS)}; }
            __syncthreads();
#pragma unroll
            for (int i = 0; i < 16; ++i) { const int tok = 16 * w + i; const f32x2 st = stat[tok]; const float mu = st.x, rstd = st.y;
                float v[8];
                v[0] = __uint_as_float(raw[i].x << 16); v[1] = __uint_as_float(raw[i].x & 0xffff0000u); v[2] = __uint_as_float(raw[i].y << 16); v[3] = __uint_as_float(raw[i].y & 0xffff0000u);
                v[4] = __uint_as_float(raw[i].z << 16); v[5] = __uint_as_float(raw[i].z & 0xffff0000u); v[6] = __uint_as_float(raw[i].w << 16); v[7] = __uint_as_float(raw[i].w & 0xffff0000u);
#pragma unroll
                for (int j = 0; j < 8; ++j) v[j] = (v[j] - mu) * rstd;
                u32x4 ow; ow.x = cvt_pk_bf16(v[0] * lg0[0] + lb0[0], v[1] * lg0[1] + lb0[1]); ow.y = cvt_pk_bf16(v[2] * lg0[2] + lb0[2], v[3] * lg0[3] + lb0[3]);
                ow.z = cvt_pk_bf16(v[4] * lg1[0] + lb1[0], v[5] * lg1[1] + lb1[1]); ow.w = cvt_pk_bf16(v[6] * lg1[2] + lb1[2], v[7] * lg1[3] + lb1[3]);
                *(LAS u32x4*)(lds + P2_VN_OFF + tok * P2_VNROW + lane * 16) = ow; }
        }
        if (!(skip & 4)) {
            const LAS unsigned char* vnl = lds + P2_VN_OFF + (8 * hh + q4) * P2_VNROW + (64 * w + 16 * (g4 & 1) + 4 * p4) * 2;
            const bf16_t* wh = wsp + (size_t)w * 128 * 128 + (size_t)r * 128 + 8 * hh;
            const bf16_t* ub = proj + (size_t)(t0 + r) * NPROJ + C_GU + 64 * w + 4 * hh;
            bf16x8 wf[8]; u32x2 uu[8];
#pragma unroll
            for (int s = 0; s < 2; ++s) wf[s] = *(const bf16x8*)(wh + 16 * s);
#pragma unroll
            for (int j = 0; j < 8; ++j) uu[j] = *(const u32x2*)(ub + 32 * (j >> 2) + 8 * (j & 3));
            __syncthreads();
#pragma unroll
            for (int tb = 0; tb < 4; ++tb) {
                f32x16 acc[2];
#pragma unroll
                for (int i = 0; i < 16; ++i) { acc[0][i] = 0.f; acc[1][i] = 0.f; }
#pragma unroll
                for (int s = 0; s < 2 * tb + 2; ++s) {
#pragma unroll
                    for (int db = 0; db < 2; ++db) { const LAS unsigned char* vp = vnl + (16 * s) * P2_VNROW + db * 64;
                        const s16x4 a0 = vtr(vp), a1 = vtr(vp + 4 * P2_VNROW);
                        const bf16x8 af = (bf16x8){a0[0], a0[1], a0[2], a0[3], a1[0], a1[1], a1[2], a1[3]};
                        acc[db] = MFMA32(af, wf[s], acc[db]); }
                }
                const int t = 32 * tb + r; const float bs = F.in[5][w * 128 + t];
                float ss = 0.f;
#pragma unroll
                for (int db = 0; db < 2; ++db)
#pragma unroll
                    for (int rg = 0; rg < 4; ++rg) { const u32x2 u2 = uu[4 * db + rg];
                        const float u0 = __uint_as_float(u2.x << 16), u1 = __uint_as_float(u2.x & 0xffff0000u), u2f = __uint_as_float(u2.y << 16), u3 = __uint_as_float(u2.y & 0xffff0000u);
                        float a = u0 * (acc[db][4 * rg] + bs), b = u1 * (acc[db][4 * rg + 1] + bs), c = u2f * (acc[db][4 * rg + 2] + bs), d = u3 * (acc[db][4 * rg + 3] + bs);
                        acc[db][4 * rg] = a; acc[db][4 * rg + 1] = b; acc[db][4 * rg + 2] = c; acc[db][4 * rg + 3] = d; ss += (a * a + b * b) + (c * c + d * d); }
                if (tb < 3) {
#pragma unroll
                    for (int s = 0; s < 2 * tb + 4; ++s) wf[s] = *(const bf16x8*)(wh + (size_t)(32 * (tb + 1)) * 128 + 16 * s);
#pragma unroll
                    for (int j = 0; j < 8; ++j) uu[j] = *(const u32x2*)(ub + (size_t)(32 * (tb + 1)) * NPROJ + 32 * (j >> 2) + 8 * (j & 3));
                }
                ss += __shfl_xor(ss, 32);
                if (hh == 0) exG[(tb * 8 + w) * 32 + r] = ss;
                __syncthreads();
                float tot = 0.f;
#pragma unroll
                for (int j = 0; j < 8; ++j) tot += exG[(tb * 8 + j) * 32 + r];
                const float rstd = rsqrtf(tot * (1.f / 512) + RMS_EPS);
                bf16_t* orow = mixed + (size_t)(t0 + t) * DM + 512 + 64 * w + 4 * hh;
                const float* gg_ = F.in[9] + 64 * w + 4 * hh;
#pragma unroll
                for (int db = 0; db < 2; ++db)
#pragma unroll
                    for (int rg = 0; rg < 4; ++rg) { const f32x4 gg = *(const f32x4*)(gg_ + 32 * db + 8 * rg);
                        u32x2 ow; ow.x = cvt_pk_bf16(acc[db][4 * rg] * rstd * gg[0], acc[db][4 * rg + 1] * rstd * gg[1]); ow.y = cvt_pk_bf16(acc[db][4 * rg + 2] * rstd * gg[2], acc[db][4 * rg + 3] * rstd * gg[3]);
                        *(u32x2*)(orow + 32 * db + 8 * rg) = ow; }
            }
        }
        __syncthreads();
    }
}

constexpr int P4_WROW = 2064;
constexpr int P4_W_OFF = 0, P4_LG_OFF = 48 * P4_WROW, P4_CNT_OFF = P4_LG_OFF + 8 * 16 * 48 * 4, P4_BASE_OFF = P4_CNT_OFF + 128;
static_assert(P4_BASE_OFF + 128 <= MISC_OFF, "P4 LDS map");
__device__ __forceinline__ void p4_router(Frame& F) {
    const int lane = F.lane, w = F.wave, tid = F.tid;
    const bf16_t* hb = (const bf16_t*)(F.ws + WS_HB);
    const bf16_t* wr_t = (const bf16_t*)(F.ws + WS_WR_T);
    const float* ssq = (const float*)(F.ws + WS_SSQ);
    int* cntg = (int*)(F.ws + WS_CTL) + CW_CNT;
    int* tl = (int*)(F.ws + WS_TOKLIST); float* rl = (float*)(F.ws + WS_RSLIST);
    LAS unsigned char* lds = F.lds;
    LAS float* lg = (LAS float*)(lds + P4_LG_OFF) + w * 16 * 48;
    LAS int* cl = (LAS int*)(lds + P4_CNT_OFF); LAS int* bl = (LAS int*)(lds + P4_BASE_OFF);
#pragma unroll
    for (int i = 0; i < 12; ++i) { const int pc = tid + 512 * i, row = pc >> 7, ch = pc & 127; *(LAS u32x4*)(lds + P4_W_OFF + row * P4_WROW + ch * 16) = *(const u32x4*)(wr_t + (size_t)row * DM + ch * 8); }
    for (int blk = F.vcu; blk < NTOK / 128; blk += F.G) {
        const int tok0 = blk * 128 + 16 * w;
        if (tid < 32) cl[tid] = 0;
        const bf16_t* ap = hb + (size_t)(tok0 + (lane & 15)) * DM + 8 * (lane >> 4);
        bf16x8 af[32];
#pragma unroll
        for (int s = 0; s < 32; ++s) af[s] = *(const bf16x8*)(ap + 32 * s);
        const f32x4 sq0 = *(const f32x4*)(ssq + (size_t)(tok0 + (lane & 15)) * 16), sq1 = *(const f32x4*)(ssq + (size_t)(tok0 + (lane & 15)) * 16 + 4),
                    sq2 = *(const f32x4*)(ssq + (size_t)(tok0 + (lane & 15)) * 16 + 8), sq3 = *(const f32x4*)(ssq + (size_t)(tok0 + (lane & 15)) * 16 + 12);
        __syncthreads();
        f32x4 acc[3];
#pragma unroll
        for (int c = 0; c < 3; ++c) acc[c] = (f32x4){0.f, 0.f, 0.f, 0.f};
        const LAS unsigned char* bp = lds + P4_W_OFF + (lane & 15) * P4_WROW + 16 * (lane >> 4);
#pragma unroll
        for (int s = 0; s < 32; ++s) {
#pragma unroll
            for (int c = 0; c < 3; ++c) { const bf16x8 b = *(const LAS bf16x8*)(bp + c * 16 * P4_WROW + 64 * s); acc[c] = MFMA16(af[s], b, acc[c]); }
        }
#pragma unroll
        for (int c = 0; c < 3; ++c)
#pragma unroll
            for (int i = 0; i < 4; ++i) lg[(4 * (lane >> 4) + i) * 48 + 16 * c + (lane & 15)] = acc[c][i];
        LDS_WAIT();
        int e1 = 0, e2 = 0, l1 = 0, l2 = 0; float w1 = 0.f, w2 = 0.f, rstd = 0.f;
        if (lane < 16) {
            float s = 0.f;
#pragma unroll
            for (int i = 0; i < 4; ++i) s += sq0[i];
#pragma unroll
            for (int i = 0; i < 4; ++i) s += sq1[i];
#pragma unroll
            for (int i = 0; i < 4; ++i) s += sq2[i];
#pragma unroll
            for (int i = 0; i < 4; ++i) s += sq3[i];
            rstd = rsqrtf(s * (1.f / DM) + RMS_EPS);
            const LAS float* L = lg + lane * 48;
            float gl[4]; int gi = 0;
#pragma unroll
            for (int j = 0; j < 4; ++j) gl[j] = L[j] * rstd + F.in[13][j];
            float gm = gl[0];
#pragma unroll
            for (int j = 1; j < 4; ++j) if (gl[j] > gm) { gm = gl[j]; gi = j; }
            float den = 0.f;
#pragma unroll
            for (int j = 0; j < 4; ++j) den += __expf(gl[j] - gm);
            const float gw = 1.f / den;
            float el[8];
#pragma unroll
            for (int j = 0; j < 8; ++j) el[j] = L[4 + gi * 8 + j] * rstd + F.in[15][gi * 8 + j];
            int i1 = 0; float v1 = el[0];
#pragma unroll
            for (int j = 1; j < 8; ++j) if (el[j] > v1) { v1 = el[j]; i1 = j; }
            int i2 = 0; float v2 = -INFINITY;
#pragma unroll
            for (int j = 0; j < 8; ++j) if (j != i1 && el[j] > v2) { v2 = el[j]; i2 = j; }
            const float a1 = 1.f / (1.f + __expf(v2 - v1));
            w1 = gw * a1; w2 = gw * (1.f - a1); e1 = gi * 8 + i1; e2 = gi * 8 + i2;
            l1 = atomicAdd((int*)(cl + e1), 1); l2 = atomicAdd((int*)(cl + e2), 1);
        }
        __syncthreads();
        if (tid < 32) bl[tid] = atomicAdd(cntg + tid, (int)cl[tid]);
        __syncthreads();
        if (lane < 16) {
            const int tok = tok0 + lane; const int p1 = bl[e1] + l1, p2 = bl[e2] + l2;
            tl[(size_t)e1 * NTOK + p1] = tok; rl[(size_t)e1 * NTOK + p1] = rstd;
            tl[(size_t)e2 * NTOK + p2] = tok; rl[(size_t)e2 * NTOK + p2] = rstd;
            ((int4*)(F.ws + WS_TOKREC))[tok] = make_int4(e1, p1, e2, p2);
            ((float2*)(F.ws + WS_TOKW))[tok] = make_float2(w1, w2);
        }
        __syncthreads();
    }
}

__device__ __forceinline__ int moe_offsets(Frame& F) {
    const int* cnt = (const int*)(F.ws + WS_CTL) + CW_CNT;
    if (F.tid == 0) { int o = 0; for (int e = 0; e < NEXP; ++e) { const int n = __hip_atomic_load(cnt + e, __ATOMIC_RELAXED, __HIP_MEMORY_SCOPE_AGENT); F.MISC[16 + e] = (unsigned)o; F.MISC[16 + 64 + e] = (unsigned)n; o += (n + 255) >> 8; } F.MISC[16 + NEXP] = (unsigned)o; }
    __syncthreads();
    return __builtin_amdgcn_readfirstlane((int)F.MISC[16 + NEXP]);
}

__device__ __forceinline__ void p7_final(Frame& F) {
    const int lane = F.lane; const int gw = F.vcu * NWAVES + F.wave, NGW = F.G * NWAVES;
    const volatile LAS int* toff = (const volatile LAS int*)(F.MISC + 16);
    const float* gf = F.in[19];
    const f32x4 g0a = *(const f32x4*)(gf + 8 * lane), g0b = *(const f32x4*)(gf + 8 * lane + 4), g1a = *(const f32x4*)(gf + 512 + 8 * lane), g1b = *(const f32x4*)(gf + 512 + 8 * lane + 4);
    const bf16_t* HBp = (const bf16_t*)(F.ws + WS_HB); const bf16_t* Yp = (const bf16_t*)(F.ws + WS_Y);
    for (int tok0 = gw * 4; tok0 < NTOK; tok0 += NGW * 4) {
        int4 rec[4]; float2 wt[4];
#pragma unroll
        for (int t = 0; t < 4; ++t) { rec[t] = ((const int4*)(F.ws + WS_TOKREC))[tok0 + t]; wt[t] = ((const float2*)(F.ws + WS_TOKW))[tok0 + t]; }
        u32x4 ra[4][2], rb[4][2], rc[4][2];
#pragma unroll
        for (int t = 0; t < 4; ++t) {
            const int s1 = toff[rec[t].x] * 256 + rec[t].y, s2 = toff[rec[t].z] * 256 + rec[t].w;
            const bf16_t* hb = HBp + (size_t)(tok0 + t) * DM + 8 * lane; const bf16_t* y1 = Yp + (size_t)s1 * DM + 8 * lane; const bf16_t* y2 = Yp + (size_t)s2 * DM + 8 * lane;
#pragma unroll
            for (int j = 0; j < 2; ++j) { ra[t][j] = __builtin_nontemporal_load((const u32x4*)(hb + 512 * j)); rb[t][j] = __builtin_nontemporal_load((const u32x4*)(y1 + 512 * j)); rc[t][j] = __builtin_nontemporal_load((const u32x4*)(y2 + 512 * j)); }
        }
#pragma unroll
        for (int t = 0; t < 4; ++t) {
            float z[16]; float ss = 0.f;
#pragma unroll
            for (int j = 0; j < 2; ++j)
#pragma unroll
                for (int q = 0; q < 4; ++q) {
                    const float lo = __uint_as_float(ra[t][j][q] << 16) + wt[t].x * __uint_as_float(rb[t][j][q] << 16) + wt[t].y * __uint_as_float(rc[t][j][q] << 16);
                    const float hi = __uint_as_float(ra[t][j][q] & 0xffff0000u) + wt[t].x * __uint_as_float(rb[t][j][q] & 0xffff0000u) + wt[t].y * __uint_as_float(rc[t][j][q] & 0xffff0000u);
                    z[8 * j + 2 * q] = lo; z[8 * j + 2 * q + 1] = hi; ss += lo * lo + hi * hi; }
            const float rstd = rsqrtf(wave_sum(ss) * (1.f / DM) + RMS_EPS);
            float* o = F.out + (size_t)(tok0 + t) * DM;
            __builtin_nontemporal_store((f32x4){z[0] * rstd * g0a[0], z[1] * rstd * g0a[1], z[2] * rstd * g0a[2], z[3] * rstd * g0a[3]}, (f32x4*)(o + 8 * lane));
            __builtin_nontemporal_store((f32x4){z[4] * rstd * g0b[0], z[5] * rstd * g0b[1], z[6] * rstd * g0b[2], z[7] * rstd * g0b[3]}, (f32x4*)(o + 8 * lane + 4));
            __builtin_nontemporal_store((f32x4){z[8] * rstd * g1a[0], z[9] * rstd * g1a[1], z[10] * rstd * g1a[2], z[11] * rstd * g1a[3]}, (f32x4*)(o + 512 + 8 * lane));
            __builtin_nontemporal_store((f32x4){z[12] * rstd * g1b[0], z[13] * rstd * g1b[1], z[14] * rstd * g1b[2], z[15] * rstd * g1b[3]}, (f32x4*)(o + 512 + 8 * lane + 4));
        }
    }
}

struct Args { const float* in[20]; float* out; unsigned char* ws; int ph_lo, ph_hi, li, pad; };
constexpr int N_PHASES = 8;
__global__ void __launch_bounds__(NWAVES * 64, 2) mk_fwd(Args args) {
    extern __shared__ __attribute__((aligned(16))) unsigned char lds_raw[];
    Frame F;
    F.lds = (LAS unsigned char*)lds_raw;
    F.MISC = (volatile LAS unsigned*)(F.lds + MISC_OFF);
    F.tid = threadIdx.x; F.lane = F.tid & 63; F.wave = __builtin_amdgcn_readfirstlane(F.tid >> 6);
    F.G = gridDim.x; { const int bx = blockIdx.x; F.vcu = (F.G % 8 == 0) ? (bx % 8) * (F.G / 8) + bx / 8 : bx; }
    F.in = args.in; F.out = args.out; F.ws = args.ws;
    unsigned char* ws = args.ws;
    for (int u = F.tid; u < 256; u += NWAVES * 64) F.MISC[u] = 0u;
    __syncthreads();
    const int lo = args.ph_lo, hi = args.ph_hi;
    XcdBarrier bar; bar.bar = (unsigned*)(ws + WS_CTL) + CW_BAR + args.li * XCD_BAR_WORDS; bar.x = 0; bar.st = nullptr;
    if (hi - lo > 1) bar = xcd_barrier_post((unsigned*)(ws + WS_CTL) + CW_BAR + args.li * XCD_BAR_WORDS, F.MISC + 8);
#define IN(k) (lo <= (k) && (k) < hi)
#define SEAM(k) do { if (IN(k) && IN((k) + 1)) xcd_barrier(bar); } while (0)
    if (IN(0)) { p0_prologue(F); SEAM(0); }
    if (IN(1)) {
        pg8::Gemm g{(const bf16_t*)(ws + WS_XN), (const bf16_t*)(ws + WS_WIN_T), DM, 0}; pg8::StaticOrder S; S.init(NTOK, NPROJ, DM, F.G, (int)blockIdx.x);
        pg8::EpiBf16G E{(bf16_t*)(ws + WS_PROJ), NPROJ, 3, (f32x2*)(ws + WS_SSQ), 5, 0};
        pg8::gemm_phase<pg8::EpiBf16G, pg8::StaticOrder>(F.lds, g, S, E);
        {
            const int nu = (NTOK / 256) * (NPROJ / 256), full = nu % F.G;
            if (full == 0) convert_rest<1>(F, (int)blockIdx.x * NWAVES + F.wave, F.G * NWAVES);
            else if ((int)blockIdx.x >= full) convert_rest<1>(F, ((int)blockIdx.x - full) * NWAVES + F.wave, (F.G - full) * NWAVES);
        }
        SEAM(1);
    }
    if (IN(2)) { p2_mix(F, args.pad); SEAM(2); }
    if (IN(3)) {
        pg8::Gemm g{(const bf16_t*)(ws + WS_MIXED), (const bf16_t*)(ws + WS_WO_T), DM, 0}; pg8::StaticOrder S; S.init(NTOK, DM, DM, F.G, (int)blockIdx.x);
        pg8::EpiH E{args.in[0], (bf16_t*)(ws + WS_HB), (float*)(ws + WS_SSQ)};
        pg8::gemm_phase<pg8::EpiH, pg8::StaticOrder>(F.lds, g, S, E);
        SEAM(3);
    }
    if (IN(4)) { p4_router(F); SEAM(4); }
    if (IN(5) || IN(6) || IN(7)) {
        const int ntiles = moe_offsets(F);
        const volatile LAS int* toff = (const volatile LAS int*)(F.MISC + 16);
        const int* cnt = (const int*)(ws + WS_CTL) + CW_CNT;
        if (IN(5)) {
            pg8::Gemm g{(const bf16_t*)(ws + WS_HB), (const bf16_t*)(ws + WS_WGU_T), DM, 0};
            MoeOrder<true> S{toff, cnt, (const int*)(ws + WS_TOKLIST), 2, ntiles * 2, F.G, (int)blockIdx.x, DM, 512};
            EpiSwiglu E{(bf16_t*)(ws + WS_HID), (const float*)(ws + WS_RSLIST)};
            pg8::gemm_phase<EpiSwiglu, MoeOrder<true>>(F.lds, g, S, E);
            {
                const int nu = ntiles * 2, full = nu % F.G;
                if (full == 0) convert_rest<2>(F, (int)blockIdx.x * NWAVES + F.wave, F.G * NWAVES);
                else if ((int)blockIdx.x >= full) convert_rest<2>(F, ((int)blockIdx.x - full) * NWAVES + F.wave, (F.G - full) * NWAVES);
            }
            SEAM(5);
        }
        if (IN(6)) {
            pg8::Gemm g{(const bf16_t*)(ws + WS_HID), (const bf16_t*)(ws + WS_WD_T), DEXP, 0};
            MoeOrder<false> S{toff, cnt, (const int*)(ws + WS_TOKLIST), 4, ntiles * 4, F.G, (int)blockIdx.x, DEXP, DM};
            pg8::EpiBf16G E{(bf16_t*)(ws + WS_Y), DM, 1000, nullptr, 1000, 0};
            pg8::gemm_phase<pg8::EpiBf16G, MoeOrder<false>>(F.lds, g, S, E);
            SEAM(6);
        }
        if (IN(7)) p7_final(F);
    }
#undef IN
#undef SEAM
}
extern "C" void kernel_launch(void* const* d_in, const int* in_sizes, int n_in, void* d_out, int out_size, void* d_ws, size_t ws_size, hipStream_t stream) {
    static int grid = 0;
    if (grid == 0) {
        if (n_in != 20 || in_sizes[0] != NTOK * DM || out_size != NTOK * DM || ws_size < WS_END) {
            fprintf(stderr, "kernel_launch: unexpected shapes (n_in %d, in0 %d, out %d, ws %zu)\n", n_in, n_in > 0 ? in_sizes[0] : -1, out_size, ws_size); grid = -1; return; }
        int dev = 0, cus = 0, per_cu = 0;
        if (hipGetDevice(&dev) != hipSuccess || hipDeviceGetAttribute(&cus, hipDeviceAttributeMultiprocessorCount, dev) != hipSuccess) { fprintf(stderr, "kernel_launch: device query failed\n"); grid = -1; return; }
        if (hipFuncSetAttribute((const void*)mk_fwd, hipFuncAttributeMaxDynamicSharedMemorySize, LDS_BYTES) != hipSuccess) { fprintf(stderr, "kernel_launch: hipFuncSetAttribute(%d B LDS) failed\n", LDS_BYTES); grid = -1; return; }
        if (hipOccupancyMaxActiveBlocksPerMultiprocessor(&per_cu, (const void*)mk_fwd, NWAVES * 64, LDS_BYTES) != hipSuccess || per_cu < 1)
            fprintf(stderr, "kernel_launch: note: occupancy query reports %d workgroups per CU\n", per_cu);
        (void)hipGetLastError();
        grid = cus;
    }
    if (grid < 0) return;
    Params p{};
    for (int i = 0; i < 20; ++i) p.in[i] = (const float*)d_in[i];
    p.out = (float*)d_out; p.ws = (unsigned char*)d_ws;
    unsigned char* ws = p.ws;
    (void)hipMemsetAsync(ws + WS_CTL, 0, CTL_ZERO_BYTES, stream);
    const int* cnt = (const int*)(ws + WS_CTL) + CW_CNT;
    Args a{};
    for (int i = 0; i < 20; ++i) a.in[i] = (const float*)d_in[i];
    a.out = (float*)d_out; a.ws = ws;
#ifndef REP_PH
#define REP_PH -1
#endif
    constexpr int rp = REP_PH;
    int li = 0;
#ifdef CUM_PH
    { a.ph_lo = 0; a.ph_hi = CUM_PH; a.li = li++; hipLaunchKernelGGL(mk_fwd, dim3(grid), dim3(NWAVES * 64), LDS_BYTES, stream, a);
      (void)hipMemsetAsync(ws + WS_CTL + CW_CNT * 4, 0, NEXP * 4, stream); }
#endif
    if (rp < 0) { a.ph_lo = 0; a.ph_hi = N_PHASES; a.li = li++; hipLaunchKernelGGL(mk_fwd, dim3(grid), dim3(NWAVES * 64), LDS_BYTES, stream, a); }
    else {
        a.ph_lo = 0; a.ph_hi = rp + 1; a.li = li++; hipLaunchKernelGGL(mk_fwd, dim3(grid), dim3(NWAVES * 64), LDS_BYTES, stream, a);
        if (rp == 4) (void)hipMemsetAsync(ws + WS_CTL + CW_CNT * 4, 0, NEXP * 4, stream);
#ifdef REP_P2
        a.pad = REP_P2;
#endif
#ifdef REP_GRID
        a.ph_lo = rp; a.ph_hi = rp + 1; a.li = li++; hipLaunchKernelGGL(mk_fwd, dim3(REP_GRID), dim3(NWAVES * 64), LDS_BYTES, stream, a);
#else
        a.ph_lo = rp; a.ph_hi = rp + 1; a.li = li++; hipLaunchKernelGGL(mk_fwd, dim3(grid), dim3(NWAVES * 64), LDS_BYTES, stream, a);
#endif
        a.pad = 0;
        if (rp + 1 < N_PHASES) { a.ph_lo = rp + 1; a.ph_hi = N_PHASES; a.li = li++; hipLaunchKernelGGL(mk_fwd, dim3(grid), dim3(NWAVES * 64), LDS_BYTES, stream, a); }
    }
    (void)p; (void)cnt;
}
```

```cpp
#include <hip/hip_runtime.h>
#include <cstdio>
#include <cstdint>
#include <cmath>

constexpr int BATCH = 4, SEQ = 8192, DM = 1024, NTOK = BATCH * SEQ;
constexpr int NPROJ = 1792;
constexpr int C_Q = 0, C_K = 512, C_V = 640, C_GU = 768, C_GV = 1280;
constexpr int NEXP = 32, DEXP = 256, NGRP = 4, EPG = 8;
constexpr int SLOT_CAP = 2 * NTOK + NEXP * 256;
constexpr float RMS_EPS = 1e-6f, LN_EPS = 1e-5f;

typedef unsigned short bf16_t;
__device__ __forceinline__ float bf2f(bf16_t v) { return __uint_as_float((unsigned)v << 16); }
__device__ __forceinline__ bf16_t f2bf(float f) { unsigned u = __float_as_uint(f); return (bf16_t)((u + 0x7fffu + ((u >> 16) & 1u)) >> 16); }

constexpr size_t MiB = 1u << 20;
constexpr size_t WS_CTL = 0, CTL_ZERO_BYTES = 1 * MiB;
constexpr size_t WS_TOKLIST = 58 * MiB;
constexpr size_t WS_RSLIST = 62 * MiB;
constexpr size_t WS_TOKREC = 66 * MiB;
constexpr size_t WS_TOKW = 67 * MiB;
constexpr size_t WS_SSQ = 68 * MiB;
constexpr size_t WS_XN = 72 * MiB;
constexpr size_t WS_PROJ = 136 * MiB;
constexpr size_t WS_MIXED = 248 * MiB;
constexpr size_t WS_HB = 312 * MiB;
constexpr size_t WS_HID = 376 * MiB;
constexpr size_t WS_Y = 72 * MiB;
constexpr size_t WS_AF = 412 * MiB;
constexpr size_t WS_VN = 72 * MiB;
constexpr size_t WS_HF = 376 * MiB;
constexpr size_t WS_END = 512 * MiB;
constexpr int CW_CNT = 64;

struct Params {
    const float* in[20];
    float* out;
    unsigned char* ws;
};

__device__ __forceinline__ float wave_sum(float v) {
#pragma unroll
    for (int o = 1; o < 64; o <<= 1) v += __shfl_xor(v, o);
    return v;
}
__device__ __forceinline__ float gelu_exact(float v) { return 0.5f * v * (1.0f + erff(v * 0.70710678118654752f)); }

#define LAS __attribute__((address_space(3)))
#define GAS __attribute__((address_space(1)))
typedef short bf16x8 __attribute__((ext_vector_type(8)));
typedef short s16x4 __attribute__((ext_vector_type(4)));
typedef float f32x4 __attribute__((ext_vector_type(4)));
typedef float f32x16 __attribute__((ext_vector_type(16)));
typedef float f32x2 __attribute__((ext_vector_type(2)));
typedef unsigned u32x4 __attribute__((ext_vector_type(4)));
typedef unsigned u32x2 __attribute__((ext_vector_type(2)));
typedef GAS unsigned gu32;

constexpr size_t WS_WIN_T = 2 * MiB;
constexpr size_t WS_WO_T = 6 * MiB;
constexpr size_t WS_WSP = 8 * MiB;
constexpr size_t WS_WR_T = 8 * MiB + 512 * 1024;
constexpr size_t WS_WGU_T = 10 * MiB;
constexpr size_t WS_WD_T = 42 * MiB;
constexpr int CW_TMO = 0;
constexpr int CW_BAR = 4096;

constexpr int NWAVES = 8;
constexpr int RING_BYTES = 131072;
constexpr int LDS_BYTES = 163840;
constexpr int MISC_OFF = 163840 - 1024;
constexpr float LOG2E = 1.4426950408889634f;

__device__ __forceinline__ unsigned cvt_pk_bf16(float lo, float hi) { unsigned r; asm volatile("v_cvt_pk_bf16_f32 %0, %1, %2" : "=v"(r) : "v"(lo), "v"(hi)); return r; }
#define MFMA32(a, b, c) __builtin_amdgcn_mfma_f32_32x32x16_bf16((a), (b), (c), 0, 0, 0)
#define MFMA16(a, b, c) __builtin_amdgcn_mfma_f32_16x16x32_bf16((a), (b), (c), 0, 0, 0)
typedef short v4i16_t __attribute__((ext_vector_type(4)));
__device__ __forceinline__ s16x4 vtr(const LAS unsigned char* p) { return __builtin_bit_cast(s16x4, __builtin_amdgcn_ds_read_tr16_b64_v4i16((LAS v4i16_t*)p)); }

namespace pg8 {
constexpr int BM = 256, BK = 64, HALF = 128, HTB = HALF * BK * 2, STAGE_BYTES = 8 * HTB, NXCD = 8, WGM = 8;
__host__ __device__ __forceinline__ int lds_byte(int r, int c) { const int st = (r >> 4) * 2 + (c >> 5), rr = r & 15, cc = c & 31, ob = rr * 64 + cc * 2; return st * 1024 + (ob ^ (((ob >> 9) & 1) << 5)); }
__host__ __device__ __forceinline__ void stage_rc(int b, int& R, int& C) { const int st = b / 1024, sb = b % 1024, swz = sb ^ (((sb >> 9) & 1) << 5); R = (st >> 1) * 16 + swz / 64; C = (st & 1) * 32 + (swz % 64) / 2; }
__host__ __device__ __forceinline__ int perm32(int rho) { const int n = rho >> 4, i = rho & 15; return 8 * (i >> 2) + 4 * n + (i & 3); }

struct Unit { int pm, pn, e, pos0, ne, nv; };
struct Gemm { const bf16_t* A; const bf16_t* Bt; int K; int pad; };

__device__ __forceinline__ int xcd_remap(int L, int nwg) { const int q = nwg / NXCD, r = nwg % NXCD, xcd = L % NXCD, off = L / NXCD; return (xcd < r ? xcd * (q + 1) : r * (q + 1) + (xcd - r) * q) + off; }

struct StaticOrder {
    int nM, nN, nwg, G, c, K;
    __device__ void init(int M, int N, int K_, int G_, int c_) { nM = M / BM; nN = N / BM; nwg = nM * nN; G = G_; c = c_; K = K_; }
    __device__ __forceinline__ bool next(int i, Unit& u) const {
        const long L = (long)i * G + c; if (L >= nwg) return false;
        const int wgid = xcd_remap((int)L, nwg);
        const int nig = WGM * nN, gid = wgid / nig, fm = gid * WGM, gsz = (nM - fm) < WGM ? (nM - fm) : WGM;
        u.pm = fm + ((wgid % nig) % gsz); u.pn = (wgid % nig) / gsz; u.e = 0; u.pos0 = 0; u.ne = 0; u.nv = BM; return true;
    }
    __device__ __forceinline__ size_t b_off(const Unit& u) const { return (size_t)u.pn * BM * K; }
    __device__ __forceinline__ int a_row(const Unit& u, int r) const { return u.pm * BM + r; }
};

template <class Epi, class Sched>
__device__ __forceinline__ void gemm_phase(LAS unsigned char* lds, const Gemm g, const Sched& S, const Epi& E) {
    const int tid = threadIdx.x, wid = __builtin_amdgcn_readfirstlane(tid >> 6), lane = tid & 63, wr = wid >> 2, wc = wid & 3, fr = lane & 15, fq = lane >> 4;
    const int K = g.K, nt = K / BK;
    unsigned voffB[2];
#pragma unroll
    for (int i = 0; i < 2; ++i) { int R, C; stage_rc(tid * 16 + i * 8192, R, C); const int Rb = Epi::PERM ? ((R >> 5) * 64 + perm32(R & 31)) : R;
        voffB[i] = (unsigned)(Rb * K + C) * 2u; }
    const size_t kstep = (size_t)(BK * 2);
    const size_t hstep = (size_t)(Epi::PERM ? 32 : HALF) * K * 2;
    const unsigned ldsw = (unsigned)wid * 1024u;
    const int aoff = lds_byte(wr * 64 + fr, fq * 8), boff = lds_byte(wc * 32 + fr, fq * 8);
#define PG8_SA(b, h) (((b) * 2 + (h)) * HTB)
#define PG8_SB(b, h) ((4 + (b) * 2 + (h)) * HTB)
#define PG8_STAGE2(bufoff, gbase, v0, v1) do { \
        __builtin_amdgcn_global_load_lds((const unsigned*)((const char*)(gbase) + (v0)), (LAS unsigned*)(lds + (bufoff) + ldsw), 16, 0, 0); \
        __builtin_amdgcn_global_load_lds((const unsigned*)((const char*)(gbase) + (v1)), (LAS unsigned*)(lds + (bufoff) + ldsw + 8192), 16, 0, 0); } while (0)
#define PG8_STAGEB(bufoff, gbase) PG8_STAGE2(bufoff, gbase, voffB[0], voffB[1])
#define PG8_VOFFA(dst, U) do { _Pragma("unroll") for (int _i = 0; _i < 2; ++_i) { int _R, _C; stage_rc(threadIdx.x * 16 + _i * 8192, _R, _C); _Pragma("unroll") for (int _h = 0; _h < 2; ++_h) \
        dst[_h][_i] = ((unsigned)S.a_row(U, _h * HALF + _R) * (unsigned)K + (unsigned)_C) * 2u; } } while (0)
#define PG8_LDA(dst, b, h) do { _Pragma("unroll") for (int m = 0; m < 4; ++m) _Pragma("unroll") for (int k = 0; k < 2; ++k) dst[m][k] = *(const LAS bf16x8*)(lds + PG8_SA(b, h) + aoff + m * 2048 + k * 1024); } while (0)
#define PG8_LDB(dst, b, h) do { _Pragma("unroll") for (int n = 0; n < 2; ++n) _Pragma("unroll") for (int k = 0; k < 2; ++k) dst[n][k] = *(const LAS bf16x8*)(lds + PG8_SB(b, h) + boff + n * 2048 + k * 1024); } while (0)
#define PG8_MMA(ai, bj, At, Bt) do { if ((ai) * HALF + wr * 64 < cur.nv) { __builtin_amdgcn_s_setprio(1); _Pragma("unroll") for (int m = 0; m < 4; ++m) _Pragma("unroll") for (int n = 0; n < 2; ++n) _Pragma("unroll") for (int k = 0; k < 2; ++k) \
        acc[ai][bj][m][n] = __builtin_amdgcn_mfma_f32_16x16x32_bf16(Bt[n][k], At[m][k], acc[ai][bj][m][n], 0, 0, 0); __builtin_amdgcn_s_setprio(0); } } while (0)
#define PG8_WAIT_V(n) asm volatile("s_waitcnt vmcnt(" #n ")" ::: "memory")
#define PG8_WAIT_L(n) asm volatile("s_waitcnt lgkmcnt(" #n ")" ::: "memory")
#define PG8_BAR __builtin_amdgcn_s_barrier()
#define PG8_SCHED __builtin_amdgcn_sched_barrier(0)
    Unit cur, nxt; int ui = 0;
    if (!S.next(0, cur)) return;
    f32x4 acc[2][2][4][2];
#pragma unroll
    for (int a = 0; a < 2; ++a)
#pragma unroll
        for (int b = 0; b < 2; ++b)
#pragma unroll
            for (int m = 0; m < 4; ++m)
#pragma unroll
                for (int n = 0; n < 2; ++n) acc[a][b][m][n] = (f32x4){0.f, 0.f, 0.f, 0.f};
    bf16x8 At[4][2], B0[2][2], B1[2][2];
    const char* Ab = (const char*)g.A;
    const char* cB = (const char*)(g.Bt + S.b_off(cur));
    unsigned vA[2][2], nvA[2][2];
    PG8_VOFFA(vA, cur);
    PG8_STAGEB(PG8_SB(0, 0), cB); PG8_STAGEB(PG8_SB(0, 1), cB + hstep); PG8_STAGE2(PG8_SA(0, 0), Ab, vA[0][0], vA[0][1]); PG8_STAGE2(PG8_SA(0, 1), Ab, vA[1][0], vA[1][1]);
    if (wr == 1) PG8_BAR;
    PG8_WAIT_V(2); PG8_BAR;
    PG8_STAGEB(PG8_SB(1, 0), cB + kstep); PG8_STAGE2(PG8_SA(1, 0), Ab + kstep, vA[0][0], vA[0][1]); PG8_STAGEB(PG8_SB(1, 1), cB + hstep + kstep);
    PG8_WAIT_V(6); PG8_BAR;
    for (;;) {
        const bool has_next = S.next(ui + 1, nxt);
        const char* nB = cB;
#pragma unroll
        for (int h = 0; h < 2; ++h)
#pragma unroll
            for (int i = 0; i < 2; ++i) nvA[h][i] = vA[h][i];
        if (has_next) { nB = (const char*)(g.Bt + S.b_off(nxt)); PG8_VOFFA(nvA, nxt); }
        for (int t = 0; t < nt; t += 2) {
            const bool last = (t == nt - 2);
            const char* a1 = Ab + (size_t)(t + 1) * kstep;
            const char* a2 = last ? Ab : Ab + (size_t)(t + 2) * kstep; const char* b2 = last ? nB : cB + (size_t)(t + 2) * kstep;
            const char* a3 = a2 + kstep; const char* b3 = b2 + kstep;
            unsigned o00 = vA[0][0], o01 = vA[0][1], o10 = vA[1][0], o11 = vA[1][1];
            if (last) { asm volatile("" : "+v"(nvA[0][0]), "+v"(nvA[0][1]), "+v"(nvA[1][0]), "+v"(nvA[1][1])); o00 = nvA[0][0]; o01 = nvA[0][1]; o10 = nvA[1][0]; o11 = nvA[1][1]; }
            PG8_LDB(B0, 0, 0); PG8_LDB(B1, 0, 1); PG8_SCHED; PG8_LDA(At, 0, 0); PG8_STAGE2(PG8_SA(1, 1), a1, vA[1][0], vA[1][1]);
            PG8_WAIT_V(8); PG8_WAIT_L(0); PG8_BAR; PG8_MMA(0, 0, At, B0); PG8_MMA(0, 1, At, B1); PG8_BAR; PG8_SCHED;
            PG8_LDA(At, 0, 1); PG8_STAGEB(PG8_SB(0, 0), b2); PG8_STAGEB(PG8_SB(0, 1), b2 + hstep); PG8_STAGE2(PG8_SA(0, 0), a2, o00, o01);
            PG8_WAIT_V(8); PG8_WAIT_L(0); PG8_BAR; PG8_MMA(1, 0, At, B0); PG8_MMA(1, 1, At, B1); PG8_BAR; PG8_SCHED;
            PG8_LDB(B0, 1, 0); PG8_LDB(B1, 1, 1); PG8_SCHED; PG8_LDA(At, 1, 0); PG8_STAGE2(PG8_SA(0, 1), a2, o10, o11);
            PG8_WAIT_V(8); PG8_WAIT_L(0); PG8_BAR; PG8_MMA(0, 0, At, B0); PG8_MMA(0, 1, At, B1); PG8_BAR; PG8_SCHED;
            PG8_LDA(At, 1, 1); PG8_STAGEB(PG8_SB(1, 0), b3); PG8_STAGEB(PG8_SB(1, 1), b3 + hstep); PG8_STAGE2(PG8_SA(1, 0), a3, o00, o01);
            PG8_WAIT_V(8); PG8_WAIT_L(0); PG8_BAR; PG8_MMA(1, 0, At, B0); PG8_MMA(1, 1, At, B1); PG8_BAR; PG8_SCHED;
        }
        if (wr == 0) PG8_BAR;
        E(acc, cur, wr, wc, fr, fq);
        if (!has_next) break;
#pragma unroll
        for (int a = 0; a < 2; ++a)
#pragma unroll
            for (int b = 0; b < 2; ++b)
#pragma unroll
                for (int m = 0; m < 4; ++m)
#pragma unroll
                    for (int n = 0; n < 2; ++n) acc[a][b][m][n] = (f32x4){0.f, 0.f, 0.f, 0.f};
        cur = nxt; cB = nB; ++ui;
#pragma unroll
        for (int h = 0; h < 2; ++h)
#pragma unroll
            for (int i = 0; i < 2; ++i) vA[h][i] = nvA[h][i];
        if (wr == 1) PG8_BAR;
    }
    PG8_WAIT_V(0);
    PG8_BAR;
#undef PG8_SA
#undef PG8_SB
#undef PG8_STAGE2
#undef PG8_STAGEB
#undef PG8_VOFFA
#undef PG8_LDA
#undef PG8_LDB
#undef PG8_MMA
#undef PG8_WAIT_V
#undef PG8_WAIT_L
#undef PG8_BAR
#undef PG8_SCHED
}

__device__ __forceinline__ f32x2 gelu_pk(f32x2 v) {
    const f32x2 av = __builtin_elementwise_abs(v), d = av * 0.2316418882f + 1.0f;
    f32x2 t; t.x = __builtin_amdgcn_rcpf(d.x); t.y = __builtin_amdgcn_rcpf(d.y);
    f32x2 q = t * 0.5307027145f + (-0.7265760135f); q = q * t + 0.7107068705f; q = q * t + (-0.142248368f); q = q * t + 0.127414796f; q = q * t;
    const f32x2 s = (v * v) * (-0.72134752044f);
    f32x2 e; e.x = __builtin_amdgcn_exp2f(s.x); e.y = __builtin_amdgcn_exp2f(s.y);
    const f32x2 m = v * (q * e), r = v - m;
    f32x2 o; o.x = v.x < 0.f ? m.x : r.x; o.y = v.y < 0.f ? m.y : r.y; return o;
}

struct EpiBf16G {
    static constexpr bool PERM = true;
    bf16_t* O; int ldc; int gelu_from; f32x2* STAT; int stat_from; int pad;
    __device__ __forceinline__ void operator()(const f32x4 (&acc)[2][2][4][2], const Unit& u, int wr, int wc, int fr, int fq) const {
        const int row0 = u.pm * BM + wr * 64 + fr, col0 = u.pn * BM + wc * 64 + 8 * fq, rl0 = wr * 64 + fr;
        const bool act = u.pn >= gelu_from, st = u.pn >= stat_from;
#pragma unroll
        for (int ai = 0; ai < 2; ++ai)
#pragma unroll
            for (int m = 0; m < 4; ++m) { bf16_t* rowp = O + (size_t)(row0 + ai * HALF + m * 16) * ldc + col0; float s1 = 0.f, s2 = 0.f;
                const bool live = rl0 + ai * HALF + m * 16 < u.nv;
#pragma unroll
                for (int bj = 0; bj < 2; ++bj) { f32x4 v0 = acc[ai][bj][m][0], v1 = acc[ai][bj][m][1];
                    if (act) { f32x2 a = gelu_pk((f32x2){v0[0], v0[1]}), b = gelu_pk((f32x2){v0[2], v0[3]}), c = gelu_pk((f32x2){v1[0], v1[1]}), d = gelu_pk((f32x2){v1[2], v1[3]});
                        v0 = (f32x4){a.x, a.y, b.x, b.y}; v1 = (f32x4){c.x, c.y, d.x, d.y}; }
                    if (st) { s1 += (v0[0] + v0[1]) + (v0[2] + v0[3]) + (v1[0] + v1[1]) + (v1[2] + v1[3]);
                        s2 += (v0[0] * v0[0] + v0[1] * v0[1]) + (v0[2] * v0[2] + v0[3] * v0[3]) + (v1[0] * v1[0] + v1[1] * v1[1]) + (v1[2] * v1[2] + v1[3] * v1[3]); }
                    u32x4 w; w.x = cvt_pk_bf16(v0[0], v0[1]); w.y = cvt_pk_bf16(v0[2], v0[3]); w.z = cvt_pk_bf16(v1[0], v1[1]); w.w = cvt_pk_bf16(v1[2], v1[3]);
                    if (live) *(u32x4*)(rowp + bj * 32) = w; }
                if (st) { s1 += __shfl_xor(s1, 16); s1 += __shfl_xor(s1, 32); s2 += __shfl_xor(s2, 16); s2 += __shfl_xor(s2, 32);
                    if (fq == 0) STAT[(size_t)(row0 + ai * HALF + m * 16) * 8 + (u.pn - stat_from) * 4 + wc] = (f32x2){s1, s2}; } }
    }
};
struct EpiH {
    static constexpr bool PERM = true;
    const float* x; bf16_t* HB; float* SSQ;
    __device__ __forceinline__ void operator()(const f32x4 (&acc)[2][2][4][2], const Unit& u, int wr, int wc, int fr, int fq) const {
        const int row0 = u.pm * BM + wr * 64 + fr, col0 = u.pn * BM + wc * 64 + 8 * fq;
#pragma unroll
        for (int ai = 0; ai < 2; ++ai)
#pragma unroll
            for (int m = 0; m < 4; ++m) { const int row = row0 + ai * HALF + m * 16; const float* xr = x + (size_t)row * DM + col0; bf16_t* hr = HB + (size_t)row * DM + col0; float s = 0.f;
#pragma unroll
                for (int bj = 0; bj < 2; ++bj) { const f32x4 x0 = __builtin_nontemporal_load((const f32x4*)(xr + bj * 32)), x1 = __builtin_nontemporal_load((const f32x4*)(xr + bj * 32 + 4));
                    const f32x4 v0 = acc[ai][bj][m][0] + x0, v1 = acc[ai][bj][m][1] + x1;
                    s += (v0[0] * v0[0] + v0[1] * v0[1]) + (v0[2] * v0[2] + v0[3] * v0[3]) + (v1[0] * v1[0] + v1[1] * v1[1]) + (v1[2] * v1[2] + v1[3] * v1[3]);
                    u32x4 w; w.x = cvt_pk_bf16(v0[0], v0[1]); w.y = cvt_pk_bf16(v0[2], v0[3]); w.z = cvt_pk_bf16(v1[0], v1[1]); w.w = cvt_pk_bf16(v1[2], v1[3]);
                    *(u32x4*)(hr + bj * 32) = w; }
                s += __shfl_xor(s, 16); s += __shfl_xor(s, 32);
                if (fq == 0) SSQ[(size_t)row * 16 + u.pn * 4 + wc] = s; }
    }
};
}

template <bool GATHER>
struct MoeOrder {
    const volatile LAS int* toff;
    const int* cnt; const int* toklist;
    int nN, nwg, G, c, K, rows_per_e;
    __device__ __forceinline__ bool next(int i, pg8::Unit& u) const {
        const long L = (long)i * G + c; if (L >= nwg) return false;
        const int wgid = pg8::xcd_remap((int)L, nwg);
        const int T = wgid / nN; u.pn = wgid % nN; u.pm = T;
        int e = 0;
        for (int j = 1; j < NEXP; ++j) e += (toff[j] <= T) ? 1 : 0;
        e = __builtin_amdgcn_readfirstlane(e);
        u.e = e; u.pos0 = __builtin_amdgcn_readfirstlane((T - toff[e]) * 256); u.ne = __builtin_amdgcn_readfirstlane(toff[64 + e]); { const int left = u.ne - u.pos0; u.nv = left < 256 ? left : 256; } return true;
    }
    __device__ __forceinline__ size_t b_off(const pg8::Unit& u) const { return ((size_t)u.e * rows_per_e + (size_t)u.pn * 256) * K; }
    __device__ __forceinline__ int a_row(const pg8::Unit& u, int r) const {
        if (!GATHER) return u.pm * 256 + r;
        const int pos = u.pos0 + r;
        return pos < u.ne ? toklist[(size_t)u.e * NTOK + pos] : 0;
    }
};
struct EpiSwiglu {
    static constexpr bool PERM = true;
    bf16_t* HID; const float* rslist;
    __device__ __forceinline__ void operator()(const f32x4 (&acc)[2][2][4][2], const pg8::Unit& u, int wr, int wc, int fr, int fq) const {
        const int r0 = wr * 64 + fr, col0 = u.pn * 128 + wc * 32 + 8 * fq; const int pos0 = u.pos0, n_e = u.ne;
#pragma unroll
        for (int ai = 0; ai < 2; ++ai)
#pragma unroll
            for (int m = 0; m < 4; ++m) { const int r = r0 + ai * 128 + m * 16, pos = pos0 + r;
                const float rs = pos < n_e ? rslist[(size_t)u.e * NTOK + pos] : 0.f;
                float o[8];
#pragma unroll
                for (int n = 0; n < 2; ++n)
#pragma unroll
                    for (int j = 0; j < 4; ++j) { const float gt = acc[ai][0][m][n][j] * rs, up = acc[ai][1][m][n][j] * rs;
                        o[4 * n + j] = gt * __builtin_amdgcn_rcpf(1.f + __builtin_amdgcn_exp2f(-gt * LOG2E)) * up; }
                u32x4 w; w.x = cvt_pk_bf16(o[0], o[1]); w.y = cvt_pk_bf16(o[2], o[3]); w.z = cvt_pk_bf16(o[4], o[5]); w.w = cvt_pk_bf16(o[6], o[7]);
                if (r < u.nv || true) *(u32x4*)(HID + (size_t)(u.pm * 256 + r) * DEXP + col0) = w; }
    }
};

#define XB_TMO      128
#define XB_XCNT(j)  (256  + 64 * (j))
#define XB_XSUB(j)  (1280 + 64 * (j))
#define XB_XGEN(j)  (2304 + 64 * (j))
#define XB_TOP      3328
#define XB_TOPGEN   3392
#define XCD_BAR_WORDS 3456
#define XB_SPIN_CAP (1u << 18)
__device__ __forceinline__ unsigned xb_ld(unsigned* p)              { return __hip_atomic_load(p, __ATOMIC_RELAXED, __HIP_MEMORY_SCOPE_AGENT); }
__device__ __forceinline__ unsigned xb_add(unsigned* p, unsigned v) { return __hip_atomic_fetch_add(p, v, __ATOMIC_RELAXED, __HIP_MEMORY_SCOPE_AGENT); }
__device__ __forceinline__ unsigned xb_xcc_id() { return (unsigned)__builtin_amdgcn_s_getreg((3 << 11) | 20) & 0xFu; }
#define XB_SPIN(cond, bar) do { unsigned _sp = 0; while (cond) { __builtin_amdgcn_s_sleep(1); \
    if ((++_sp & 255u) == 0u) { if (xb_ld(&(bar)[XB_TMO])) break; if (_sp > XB_SPIN_CAP) { atomicAdd(&(bar)[XB_TMO], 1u); break; } } } } while (0)
struct XcdBarrier { unsigned* bar; unsigned x; volatile LAS unsigned* st; };
__device__ __forceinline__ XcdBarrier xcd_barrier_post(unsigned* bar, volatile LAS unsigned* st) {
    XcdBarrier b; b.bar = bar; b.x = xb_xcc_id(); b.st = st;
    if (threadIdx.x == 0) (void)xb_add(&bar[XB_XCNT(b.x)], 1u);
    return b;
}
__device__ __forceinline__ void xcd_barrier_complete(unsigned* bar, unsigned x, unsigned& nloc, unsigned& nx) {
    const unsigned G = gridDim.x * gridDim.y * gridDim.z;
    unsigned sum, cnt, mine, sp = 0u;
    for (;;) {
        sum = 0u; cnt = 0u; mine = 0u;
#pragma unroll
        for (unsigned j = 0; j < 16; ++j) { const unsigned c = xb_ld(&bar[XB_XCNT(j)]); sum += c; cnt += (c > 0u) ? 1u : 0u; mine = (j == x) ? c : mine; }
        if (sum == G) break;
        __builtin_amdgcn_s_sleep(1);
        if ((++sp & 255u) == 0u) { if (xb_ld(&bar[XB_TMO])) break; if (sp > XB_SPIN_CAP) { atomicAdd(&bar[XB_TMO], 1u); break; } }
    }
    nloc = mine > 0u ? mine : 1u; nx = cnt > 0u ? cnt : 1u;
}
__device__ __forceinline__ void xcd_barrier(const XcdBarrier& b) {
    asm volatile("s_waitcnt vmcnt(0)" ::: "memory");
    __syncthreads();
    if (threadIdx.x == 0) {
        unsigned* bar = b.bar;
        __builtin_amdgcn_s_waitcnt(0);
        unsigned nloc = b.st[0], nx = b.st[1];
        if (nloc == 0u) { xcd_barrier_complete(bar, b.x, nloc, nx); b.st[0] = nloc; b.st[1] = nx; }
        const unsigned old = xb_add(&bar[XB_XSUB(b.x)], 1u);
        const unsigned gen = old / nloc;
        if (old + 1u == (gen + 1u) * nloc) {
            __builtin_amdgcn_fence(__ATOMIC_RELEASE, "agent");
            asm volatile("s_waitcnt vmcnt(0)" ::: "memory");
            const unsigned og = xb_add(&bar[XB_TOP], 1u);
            const unsigned tg = og / nx;
            if (og + 1u == (tg + 1u) * nx) xb_add(&bar[XB_TOPGEN], 1u);
            else XB_SPIN(xb_ld(&bar[XB_TOPGEN]) == tg, bar);
            __builtin_amdgcn_fence(__ATOMIC_ACQUIRE, "agent");
            xb_add(&bar[XB_XGEN(b.x)], 1u);
            asm volatile("s_waitcnt vmcnt(0)" ::: "memory");
        } else {
            XB_SPIN(xb_ld(&bar[XB_XGEN(b.x)]) == gen, bar);
            __builtin_amdgcn_fence(__ATOMIC_ACQUIRE, "agent");
            asm volatile("s_waitcnt vmcnt(0)" ::: "memory");
        }
    }
    __syncthreads();
}

struct Frame {
    LAS unsigned char* lds;
    volatile LAS unsigned* MISC;
    int tid, lane, wave, vcu, G;
    const float* const* in; float* out; unsigned char* ws;
};
#define LDS_WAIT() asm volatile("s_waitcnt lgkmcnt(0)" ::: "memory")

__device__ __forceinline__ void transpose_tile64(const float* W, int ldw, int k0, int n0, bf16_t* WT, int ldt, int rowbase, const float* kscale, int lane, int hi32 = 32) {
    const float* src = W + (size_t)k0 * ldw + n0 + lane;
    float v[64];
#pragma unroll
    for (int k = 0; k < 64; ++k) v[k] = __builtin_nontemporal_load(src + (size_t)k * ldw);
    if (kscale) {
#pragma unroll
        for (int k = 0; k < 64; ++k) v[k] *= kscale[k0 + k];
    }
    bf16_t* dst = WT + (size_t)(rowbase + (lane & 31) + (lane >> 5) * hi32) * ldt + k0;
#pragma unroll
    for (int c = 0; c < 8; ++c) { u32x4 o; o.x = cvt_pk_bf16(v[8 * c], v[8 * c + 1]); o.y = cvt_pk_bf16(v[8 * c + 2], v[8 * c + 3]); o.z = cvt_pk_bf16(v[8 * c + 4], v[8 * c + 5]); o.w = cvt_pk_bf16(v[8 * c + 6], v[8 * c + 7]);
        *(u32x4*)(dst + 8 * c) = o; }
}
template <int WHICH> __device__ __forceinline__ void convert_rest(Frame& F, int part, int nparts);
__device__ __forceinline__ void p0_prologue(Frame& F) {
    const int gw = F.vcu * NWAVES + F.wave, NGW = F.G * NWAVES, lane = F.lane;
    unsigned char* ws = F.ws;
    for (int it = gw; it < 16 * 28; it += NGW) { const int kb = it / 28, nb = it % 28; transpose_tile64(F.in[2], NPROJ, 64 * kb, 64 * nb, (bf16_t*)(ws + WS_WIN_T), DM, 64 * nb, nullptr, lane); }
    const int gt = F.vcu * (NWAVES * 64) + F.tid, NGT = F.G * NWAVES * 64;
    for (int i = gt; i < 8 * 128 * 128; i += NGT) { const int c = i & 127, t = (i >> 7) & 127; ((bf16_t*)(ws + WS_WSP))[i] = c <= t ? f2bf(F.in[4][i]) : (bf16_t)0; }
    for (int i = gt; i < 64 * DM; i += NGT) { const int k = i & (DM - 1), c = i >> 10; float v = 0.f;
        if (c < 4) v = F.in[12][k * 4 + c] * F.in[11][k];
        else if (c < 36) { const int g = (c - 4) >> 3, e = (c - 4) & 7; v = F.in[14][((size_t)g * DM + k) * 8 + e] * F.in[11][k]; }
        ((bf16_t*)(ws + WS_WR_T))[i] = f2bf(v); }
    const float* g = F.in[1];
    f32x4 gg[4];
#pragma unroll
    for (int j = 0; j < 4; ++j) gg[j] = *(const f32x4*)(g + 256 * j + 4 * lane);
    for (int row0 = gw * 8; row0 < NTOK; row0 += NGW * 8) {
        f32x4 v[8][4];
#pragma unroll
        for (int rr = 0; rr < 8; ++rr)
#pragma unroll
            for (int j = 0; j < 4; ++j) v[rr][j] = __builtin_nontemporal_load((const f32x4*)(F.in[0] + (size_t)(row0 + rr) * DM + 256 * j + 4 * lane));
#pragma unroll
        for (int rr = 0; rr < 8; ++rr) {
            float s = 0.f;
#pragma unroll
            for (int j = 0; j < 4; ++j) s += (v[rr][j][0] * v[rr][j][0] + v[rr][j][1] * v[rr][j][1]) + (v[rr][j][2] * v[rr][j][2] + v[rr][j][3] * v[rr][j][3]);
            const float rstd = rsqrtf(wave_sum(s) * (1.f / DM) + RMS_EPS);
            bf16_t* xn = (bf16_t*)(ws + WS_XN) + (size_t)(row0 + rr) * DM;
#pragma unroll
            for (int j = 0; j < 4; ++j) { u32x2 o; o.x = cvt_pk_bf16(v[rr][j][0] * rstd * gg[j][0], v[rr][j][1] * rstd * gg[j][1]); o.y = cvt_pk_bf16(v[rr][j][2] * rstd * gg[j][2], v[rr][j][3] * rstd * gg[j][3]);
                *(u32x2*)(xn + 256 * j + 4 * lane) = o; }
        }
    }
    convert_rest<0>(F, gw, NGW);
}
template <int WHICH>
__device__ __forceinline__ void convert_rest(Frame& F, int part, int nparts) {
    unsigned char* ws = F.ws; const int lane = F.lane;
    constexpr int T_OUT = 16 * 16, T_GU = NEXP * 64, T_D = NEXP * 64;
    if (WHICH == 0) {
        for (int it = part; it < 2 * T_GU; it += nparts) {
            int r = it; const int up = r >= T_GU; if (up) r -= T_GU; const int e = r / 64, q = r % 64, kb = q / 4, nb = q % 4, n0 = 64 * nb;
            const int rowbase = e * 512 + 256 * (n0 >> 7) + 2 * (n0 & 127) + (up ? 32 : 0);
            transpose_tile64(F.in[up ? 17 : 16] + (size_t)e * DM * DEXP, DEXP, 64 * kb, n0, (bf16_t*)(ws + WS_WGU_T), DM, rowbase, F.in[11], lane, 64); }
    } else if (WHICH == 1) {
        for (int it = part; it < T_OUT; it += nparts) { const int kb = it / 16, nb = it % 16; transpose_tile64(F.in[10], DM, 64 * kb, 64 * nb, (bf16_t*)(ws + WS_WO_T), DM, 64 * nb, nullptr, lane); }
    } else {
        for (int it = part; it < T_D; it += nparts) { const int e = it / 64, q = it % 64, kb = q / 16, nb = q % 16;
            transpose_tile64(F.in[18] + (size_t)e * DEXP * DM, DM, 64 * kb, 64 * nb, (bf16_t*)(ws + WS_WD_T), DEXP, e * DM + 64 * nb, nullptr, lane); }
    }
}

constexpr int P2_K_OFF = 0, P2_KROW = 144, P2_KHEAD = 256 * P2_KROW;
constexpr int P2_V_OFF = 2 * P2_KHEAD, P2_VHEAD = 256 * 128;
constexpr int P2_VN_OFF = 0, P2_VNROW = 1088;
constexpr int P2_EXA_OFF = 139264, P2_EXG_OFF = P2_EXA_OFF + 4096;
static_assert(P2_V_OFF + 2 * P2_VHEAD <= P2_EXA_OFF && 128 * P2_VNROW <= P2_EXA_OFF && P2_EXG_OFF + 4096 <= MISC_OFF, "P2 LDS map");

__device__ __forceinline__ void p2_mix(Frame& F, const int skip) {
    const int tid = F.tid, lane = F.lane, w = F.wave;
    const int r = lane & 31, hh = lane >> 5, g4 = lane >> 4, q4 = (lane & 15) >> 2, p4 = lane & 3;
    const bf16_t* proj = (const bf16_t*)(F.ws + WS_PROJ);
    bf16_t* mixed = (bf16_t*)(F.ws + WS_MIXED);
    const bf16_t* wsp = (const bf16_t*)(F.ws + WS_WSP);
    LAS unsigned char* lds = F.lds;
    LAS float* exA = (LAS float*)(lds + P2_EXA_OFF); LAS float* exG = (LAS float*)(lds + P2_EXG_OFF);
    const float sink2 = F.in[3][w] * LOG2E;
    const float SC2 = 0.125f * LOG2E;
    for (int unit = F.vcu; unit < NTOK / 128; unit += F.G) {
        const int t0 = unit * 128; const bool first = (unit & 63) == 0;
        {
            u32x4 kv[8], vv[8];
#pragma unroll
            for (int i = 0; i < 8; ++i) { const int pc = tid + 512 * i, key = pc >> 4, sub = pc & 15;
                kv[i] = (u32x4){0u, 0u, 0u, 0u}; vv[i] = (u32x4){0u, 0u, 0u, 0u};
                if (!(first && key < 128)) { const bf16_t* rowp = proj + (size_t)(t0 - 128 + key) * NPROJ; kv[i] = *(const u32x4*)(rowp + C_K + sub * 8); vv[i] = *(const u32x4*)(rowp + C_V + sub * 8); } }
#pragma unroll
            for (int i = 0; i < 8; ++i) { const int pc = tid + 512 * i, key = pc >> 4, sub = pc & 15, kvh = sub >> 3, piece = sub & 7;
                *(LAS u32x4*)(lds + P2_K_OFF + kvh * P2_KHEAD + key * P2_KROW + piece * 16) = kv[i];
                *(LAS u32x4*)(lds + P2_V_OFF + kvh * P2_VHEAD + key * 128 + ((piece ^ (((key >> 1) & 1) << 2)) * 16)) = vv[i]; }
        }
        if (!(skip & 1)) {
            const int kvh = w >> 2;
            const LAS unsigned char* Kl = lds + P2_K_OFF + kvh * P2_KHEAD;
            const LAS unsigned char* Vl = lds + P2_V_OFF + kvh * P2_VHEAD;
            const int vflip = (q4 >> 1) & 1;
            const int vlane = (4 * hh + q4) * 128 + (g4 & 1) * 32 + p4 * 8;
            const int vh0 = vflip * 64, vh1 = (vflip ^ 1) * 64;
            const bf16_t* qbase = proj + (size_t)(t0 + r) * NPROJ + C_Q + 64 * w + 8 * hh;
            bf16x8 qn[4];
#pragma unroll
            for (int s = 0; s < 4; ++s) qn[s] = __builtin_nontemporal_load((const bf16x8*)(qbase + 16 * s));
            __syncthreads();
            for (int qb = 0; qb < 4; ++qb) {
                bf16x8 qf[4];
#pragma unroll
                for (int s = 0; s < 4; ++s) qf[s] = qn[s];
                if (qb < 3) {
#pragma unroll
                    for (int s = 0; s < 4; ++s) qn[s] = __builtin_nontemporal_load((const bf16x8*)(qbase + (size_t)(32 * (qb + 1)) * NPROJ + 16 * s));
                }
                f32x16 sa[5];
#pragma unroll
                for (int cc = 0; cc < 5; ++cc) {
#pragma unroll
                    for (int i = 0; i < 16; ++i) sa[cc][i] = 0.f;
                    const LAS unsigned char* kp = Kl + (32 * (qb + cc) + r) * P2_KROW + 16 * hh;
#pragma unroll
                    for (int s = 0; s < 4; ++s) { const bf16x8 kf = *(const LAS bf16x8*)(kp + 32 * s); sa[cc] = MFMA32(kf, qf[s], sa[cc]); }
                }
                const int q = 32 * qb + r; float mr = -1e30f;
#pragma unroll
                for (int cc = 0; cc < 5; ++cc)
#pragma unroll
                    for (int i = 0; i < 16; ++i) { const int kb = 32 * (qb + cc) + (i & 3) + 8 * (i >> 2) + 4 * hh;
                        if (cc == 0 || cc == 4 || first) { bool ok = true; if (cc == 0) ok = kb >= q + 1; if (cc == 4) ok = kb <= q + 128; if (first) ok = ok && kb >= 128; sa[cc][i] = ok ? sa[cc][i] : -1e30f; }
                        mr = fmaxf(mr, sa[cc][i]); }
                mr = fmaxf(mr, __shfl_xor(mr, 32));
                const float mx = fmaxf(mr * SC2, sink2);
                float sum = 0.f;
#pragma unroll
                for (int cc = 0; cc < 5; ++cc)
#pragma unroll
                    for (int i = 0; i < 16; ++i) { const float pe = __builtin_amdgcn_exp2f(fmaf(sa[cc][i], SC2, -mx)); sa[cc][i] = pe; sum += pe; }
                sum += __shfl_xor(sum, 32);
                const float inv = 1.f / (sum + __builtin_amdgcn_exp2f(sink2 - mx));
                f32x16 o[2];
#pragma unroll
                for (int i = 0; i < 16; ++i) { o[0][i] = 0.f; o[1][i] = 0.f; }
#pragma unroll
                for (int cc = 0; cc < 5; ++cc)
#pragma unroll
                    for (int s2 = 0; s2 < 2; ++s2) {
                        u32x4 pw; pw.x = cvt_pk_bf16(sa[cc][8 * s2 + 0], sa[cc][8 * s2 + 1]); pw.y = cvt_pk_bf16(sa[cc][8 * s2 + 2], sa[cc][8 * s2 + 3]);
                        pw.z = cvt_pk_bf16(sa[cc][8 * s2 + 4], sa[cc][8 * s2 + 5]); pw.w = cvt_pk_bf16(sa[cc][8 * s2 + 6], sa[cc][8 * s2 + 7]);
                        const bf16x8 pf = __builtin_bit_cast(bf16x8, pw);
                        const LAS unsigned char* vp = Vl + (32 * (qb + cc) + 16 * s2) * 128 + vlane;
#pragma unroll
                        for (int db = 0; db < 2; ++db) { const int vh = db ? vh1 : vh0; const s16x4 a0 = vtr(vp + vh), a1 = vtr(vp + 8 * 128 + vh);
                            const bf16x8 vf = (bf16x8){a0[0], a0[1], a0[2], a0[3], a1[0], a1[1], a1[2], a1[3]};
                            o[db] = MFMA32(vf, pf, o[db]); }
                    }
                float ss = 0.f;
#pragma unroll
                for (int db = 0; db < 2; ++db)
#pragma unroll
                    for (int i = 0; i < 16; ++i) { o[db][i] *= inv; ss += o[db][i] * o[db][i]; }
                ss += __shfl_xor(ss, 32);
                if (hh == 0) exA[(qb * 8 + w) * 32 + r] = ss;
                __syncthreads();
                float tot = 0.f;
#pragma unroll
                for (int j = 0; j < 8; ++j) tot += exA[(qb * 8 + j) * 32 + r];
                const float rstd = rsqrtf(tot * (1.f / 512) + RMS_EPS);
                bf16_t* orow = mixed + (size_t)(t0 + q) * DM + 64 * w + 4 * hh;
                const float* ga = F.in[8] + 64 * w + 4 * hh;
#pragma unroll
                for (int db = 0; db < 2; ++db)
#pragma unroll
                    for (int rg = 0; rg < 4; ++rg) { const f32x4 gg = *(const f32x4*)(ga + 32 * db + 8 * rg);
                        u32x2 ow; ow.x = cvt_pk_bf16(o[db][4 * rg] * rstd * gg[0], o[db][4 * rg + 1] * rstd * gg[1]); ow.y = cvt_pk_bf16(o[db][4 * rg + 2] * rstd * gg[2], o[db][4 * rg + 3] * rstd * gg[3]);
                        *(u32x2*)(orow + 32 * db + 8 * rg) = ow; }
            }
        }
        if (!(skip & 2)) {
            u32x4 raw[16];
#pragma unroll
            for (int i = 0; i < 16; ++i) raw[i] = __builtin_nontemporal_load((const u32x4*)(proj + (size_t)(t0 + 16 * w + i) * NPROJ + C_GV + 8 * lane));
            const f32x4 lg0 = *(const f32x4*)(F.in[6] + 8 * lane), lg1 = *(const f32x4*)(F.in[6] + 8 * lane + 4), lb0 = *(const f32x4*)(F.in[7] + 8 * lane), lb1 = *(const f32x4*)(F.in[7] + 8 * lane + 4);
            LAS f32x2* stat = (LAS f32x2*)(lds + P2_EXG_OFF);
            if (tid < 128) { const f32x4* sp = (const f32x4*)((const float*)(F.ws + WS_SSQ) + (size_t)(t0 + tid) * 16); const f32x4 a = sp[0], b = sp[1], c = sp[2], d = sp[3];
                const float s1 = (a[0] + a[2]) + (b[0] + b[2]) + (c[0] + c[2]) + (d[0] + d[2]), s2 = (a[1] + a[3]) + (b[1] + b[3]) + (c[1] + c[3]) + (d[1] + d[3]);
                const float mu = s1 * (1.f / 512), var = fmaxf(s2 * (1.f / 512) - mu * mu, 0.f); stat[tid] = (f32x2){mu, rsqrtf(var + LN_EPS)}; }
            __syncthreads();
#pragma unroll
            for (int i = 0; i < 16; ++i) { const int tok = 16 * w + i; const f32x2 st = stat[tok]; const float mu = st.x, rstd = st.y;
                float v[8];
                v[0] = __uint_as_float(raw[i].x << 16); v[1] = __uint_as_float(raw[i].x & 0xffff0000u); v[2] = __uint_as_float(raw[i].y << 16); v[3] = __uint_as_float(raw[i].y & 0xffff0000u);
                v[4] = __uint_as_float(raw[i].z << 16); v[5] = __uint_as_float(raw[i].z & 0xffff0000u); v[6] = __uint_as_float(raw[i].w << 16); v[7] = __uint_as_float(raw[i].w & 0xffff0000u);
#pragma unroll
                for (int j = 0; j < 8; ++j) v[j] = (v[j] - mu) * rstd;
                u32x4 ow; ow.x = cvt_pk_bf16(v[0] * lg0[0] + lb0[0], v[1] * lg0[1] + lb0[1]); ow.y = cvt_pk_bf16(v[2] * lg0[2] + lb0[2], v[3] * lg0[3] + lb0[3]);
                ow.z = cvt_pk_bf16(v[4] * lg1[0] + lb1[0], v[5] * lg1[1] + lb1[1]); ow.w = cvt_pk_bf16(v[6] * lg1[2] + lb1[2], v[7] * lg1[3] + lb1[3]);
                *(LAS u32x4*)(lds + P2_VN_OFF + tok * P2_VNROW + lane * 16) = ow; }
        }
        if (!(skip & 4)) {
            const LAS unsigned char* vnl = lds + P2_VN_OFF + (8 * hh + q4) * P2_VNROW + (64 * w + 16 * (g4 & 1) + 4 * p4) * 2;
            const bf16_t* wh = wsp + (size_t)w * 128 * 128 + (size_t)r * 128 + 8 * hh;
            const bf16_t* ub = proj + (size_t)(t0 + r) * NPROJ + C_GU + 64 * w + 4 * hh;
            bf16x8 wf[8]; u32x2 uu[8];
#pragma unroll
            for (int s = 0; s < 2; ++s) wf[s] = *(const bf16x8*)(wh + 16 * s);
#pragma unroll
            for (int j = 0; j < 8; ++j) uu[j] = *(const u32x2*)(ub + 32 * (j >> 2) + 8 * (j & 3));
            __syncthreads();
#pragma unroll
            for (int tb = 0; tb < 4; ++tb) {
                f32x16 acc[2];
#pragma unroll
                for (int i = 0; i < 16; ++i) { acc[0][i] = 0.f; acc[1][i] = 0.f; }
#pragma unroll
                for (int s = 0; s < 2 * tb + 2; ++s) {
#pragma unroll
                    for (int db = 0; db < 2; ++db) { const LAS unsigned char* vp = vnl + (16 * s) * P2_VNROW + db * 64;
                        const s16x4 a0 = vtr(vp), a1 = vtr(vp + 4 * P2_VNROW);
                        const bf16x8 af = (bf16x8){a0[0], a0[1], a0[2], a0[3], a1[0], a1[1], a1[2], a1[3]};
                        acc[db] = MFMA32(af, wf[s], acc[db]); }
                }
                const int t = 32 * tb + r; const float bs = F.in[5][w * 128 + t];
                float ss = 0.f;
#pragma unroll
                for (int db = 0; db < 2; ++db)
#pragma unroll
                    for (int rg = 0; rg < 4; ++rg) { const u32x2 u2 = uu[4 * db + rg];
                        const float u0 = __uint_as_float(u2.x << 16), u1 = __uint_as_float(u2.x & 0xffff0000u), u2f = __uint_as_float(u2.y << 16), u3 = __uint_as_float(u2.y & 0xffff0000u);
                        float a = u0 * (acc[db][4 * rg] + bs), b = u1 * (acc[db][4 * rg + 1] + bs), c = u2f * (acc[db][4 * rg + 2] + bs), d = u3 * (acc[db][4 * rg + 3] + bs);
                        acc[db][4 * rg] = a; acc[db][4 * rg + 1] = b; acc[db][4 * rg + 2] = c; acc[db][4 * rg + 3] = d; ss += (a * a + b * b) + (c * c + d * d); }
                if (tb < 3) {
#pragma unroll
                    for (int s = 0; s < 2 * tb + 4; ++s) wf[s] = *(const bf16x8*)(wh + (size_t)(32 * (tb + 1)) * 128 + 16 * s);
#pragma unroll
                    for (int j = 0; j < 8; ++j) uu[j] = *(const u32x2*)(ub + (size_t)(32 * (tb + 1)) * NPROJ + 32 * (j >> 2) + 8 * (j & 3));
                }
                ss += __shfl_xor(ss, 32);
                if (hh == 0) exG[(tb * 8 + w) * 32 + r] = ss;
                __syncthreads();
                float tot = 0.f;
#pragma unroll
                for (int j = 0; j < 8; ++j) tot += exG[(tb * 8 + j) * 32 + r];
                const float rstd = rsqrtf(tot * (1.f / 512) + RMS_EPS);
                bf16_t* orow = mixed + (size_t)(t0 + t) * DM + 512 + 64 * w + 4 * hh;
                const float* gg_ = F.in[9] + 64 * w + 4 * hh;
#pragma unroll
                for (int db = 0; db < 2; ++db)
#pragma unroll
                    for (int rg = 0; rg < 4; ++rg) { const f32x4 gg = *(const f32x4*)(gg_ + 32 * db + 8 * rg);
                        u32x2 ow; ow.x = cvt_pk_bf16(acc[db][4 * rg] * rstd * gg[0], acc[db][4 * rg + 1] * rstd * gg[1]); ow.y = cvt_pk_bf16(acc[db][4 * rg + 2] * rstd * gg[2], acc[db][4 * rg + 3] * rstd * gg[3]);
                        *(u32x2*)(orow + 32 * db + 8 * rg) = ow; }
            }
        }
        __syncthreads();
    }
}

constexpr int P4_WROW = 2064;
constexpr int P4_W_OFF = 0, P4_LG_OFF = 48 * P4_WROW, P4_CNT_OFF = P4_LG_OFF + 8 * 16 * 48 * 4, P4_BASE_OFF = P4_CNT_OFF + 128;
static_assert(P4_BASE_OFF + 128 <= MISC_OFF, "P4 LDS map");
__device__ __forceinline__ void p4_router(Frame& F) {
    const int lane = F.lane, w = F.wave, tid = F.tid;
    const bf16_t* hb = (const bf16_t*)(F.ws + WS_HB);
    const bf16_t* wr_t = (const bf16_t*)(F.ws + WS_WR_T);
    const float* ssq = (const float*)(F.ws + WS_SSQ);
    int* cntg = (int*)(F.ws + WS_CTL) + CW_CNT;
    int* tl = (int*)(F.ws + WS_TOKLIST); float* rl = (float*)(F.ws + WS_RSLIST);
    LAS unsigned char* lds = F.lds;
    LAS float* lg = (LAS float*)(lds + P4_LG_OFF) + w * 16 * 48;
    LAS int* cl = (LAS int*)(lds + P4_CNT_OFF); LAS int* bl = (LAS int*)(lds + P4_BASE_OFF);
#pragma unroll
    for (int i = 0; i < 12; ++i) { const int pc = tid + 512 * i, row = pc >> 7, ch = pc & 127; *(LAS u32x4*)(lds + P4_W_OFF + row * P4_WROW + ch * 16) = *(const u32x4*)(wr_t + (size_t)row * DM + ch * 8); }
    for (int blk = F.vcu; blk < NTOK / 128; blk += F.G) {
        const int tok0 = blk * 128 + 16 * w;
        if (tid < 32) cl[tid] = 0;
        const bf16_t* ap = hb + (size_t)(tok0 + (lane & 15)) * DM + 8 * (lane >> 4);
        bf16x8 af[32];
#pragma unroll
        for (int s = 0; s < 32; ++s) af[s] = *(const bf16x8*)(ap + 32 * s);
        const f32x4 sq0 = *(const f32x4*)(ssq + (size_t)(tok0 + (lane & 15)) * 16), sq1 = *(const f32x4*)(ssq + (size_t)(tok0 + (lane & 15)) * 16 + 4),
                    sq2 = *(const f32x4*)(ssq + (size_t)(tok0 + (lane & 15)) * 16 + 8), sq3 = *(const f32x4*)(ssq + (size_t)(tok0 + (lane & 15)) * 16 + 12);
        __syncthreads();
        f32x4 acc[3];
#pragma unroll
        for (int c = 0; c < 3; ++c) acc[c] = (f32x4){0.f, 0.f, 0.f, 0.f};
        const LAS unsigned char* bp = lds + P4_W_OFF + (lane & 15) * P4_WROW + 16 * (lane >> 4);
#pragma unroll
        for (int s = 0; s < 32; ++s) {
#pragma unroll
            for (int c = 0; c < 3; ++c) { const bf16x8 b = *(const LAS bf16x8*)(bp + c * 16 * P4_WROW + 64 * s); acc[c] = MFMA16(af[s], b, acc[c]); }
        }
#pragma unroll
        for (int c = 0; c < 3; ++c)
#pragma unroll
            for (int i = 0; i < 4; ++i) lg[(4 * (lane >> 4) + i) * 48 + 16 * c + (lane & 15)] = acc[c][i];
        LDS_WAIT();
        int e1 = 0, e2 = 0, l1 = 0, l2 = 0; float w1 = 0.f, w2 = 0.f, rstd = 0.f;
        if (lane < 16) {
            float s = 0.f;
#pragma unroll
            for (int i = 0; i < 4; ++i) s += sq0[i];
#pragma unroll
            for (int i = 0; i < 4; ++i) s += sq1[i];
#pragma unroll
            for (int i = 0; i < 4; ++i) s += sq2[i];
#pragma unroll
            for (int i = 0; i < 4; ++i) s += sq3[i];
            rstd = rsqrtf(s * (1.f / DM) + RMS_EPS);
            const LAS float* L = lg + lane * 48;
            float gl[4]; int gi = 0;
#pragma unroll
            for (int j = 0; j < 4; ++j) gl[j] = L[j] * rstd + F.in[13][j];
            float gm = gl[0];
#pragma unroll
            for (int j = 1; j < 4; ++j) if (gl[j] > gm) { gm = gl[j]; gi = j; }
            float den = 0.f;
#pragma unroll
            for (int j = 0; j < 4; ++j) den += __expf(gl[j] - gm);
            const float gw = 1.f / den;
            float el[8];
#pragma unroll
            for (int j = 0; j < 8; ++j) el[j] = L[4 + gi * 8 + j] * rstd + F.in[15][gi * 8 + j];
            int i1 = 0; float v1 = el[0];
#pragma unroll
            for (int j = 1; j < 8; ++j) if (el[j] > v1) { v1 = el[j]; i1 = j; }
            int i2 = 0; float v2 = -INFINITY;
#pragma unroll
            for (int j = 0; j < 8; ++j) if (j != i1 && el[j] > v2) { v2 = el[j]; i2 = j; }
            const float a1 = 1.f / (1.f + __expf(v2 - v1));
            w1 = gw * a1; w2 = gw * (1.f - a1); e1 = gi * 8 + i1; e2 = gi * 8 + i2;
            l1 = atomicAdd((int*)(cl + e1), 1); l2 = atomicAdd((int*)(cl + e2), 1);
        }
        __syncthreads();
        if (tid < 32) bl[tid] = atomicAdd(cntg + tid, (int)cl[tid]);
        __syncthreads();
        if (lane < 16) {
            const int tok = tok0 + lane; const int p1 = bl[e1] + l1, p2 = bl[e2] + l2;
            tl[(size_t)e1 * NTOK + p1] = tok; rl[(size_t)e1 * NTOK + p1] = rstd;
            tl[(size_t)e2 * NTOK + p2] = tok; rl[(size_t)e2 * NTOK + p2] = rstd;
            ((int4*)(F.ws + WS_TOKREC))[tok] = make_int4(e1, p1, e2, p2);
            ((float2*)(F.ws + WS_TOKW))[tok] = make_float2(w1, w2);
        }
        __syncthreads();
    }
}

__device__ __forceinline__ int moe_offsets(Frame& F) {
    const int* cnt = (const int*)(F.ws + WS_CTL) + CW_CNT;
    if (F.tid == 0) { int o = 0; for (int e = 0; e < NEXP; ++e) { const int n = __hip_atomic_load(cnt + e, __ATOMIC_RELAXED, __HIP_MEMORY_SCOPE_AGENT); F.MISC[16 + e] = (unsigned)o; F.MISC[16 + 64 + e] = (unsigned)n; o += (n + 255) >> 8; } F.MISC[16 + NEXP] = (unsigned)o; }
    __syncthreads();
    return __builtin_amdgcn_readfirstlane((int)F.MISC[16 + NEXP]);
}

__device__ __forceinline__ void p7_final(Frame& F) {
    const int lane = F.lane; const int gw = F.vcu * NWAVES + F.wave, NGW = F.G * NWAVES;
    const volatile LAS int* toff = (const volatile LAS int*)(F.MISC + 16);
    const float* gf = F.in[19];
    const f32x4 g0a = *(const f32x4*)(gf + 8 * lane), g0b = *(const f32x4*)(gf + 8 * lane + 4), g1a = *(const f32x4*)(gf + 512 + 8 * lane), g1b = *(const f32x4*)(gf + 512 + 8 * lane + 4);
    const bf16_t* HBp = (const bf16_t*)(F.ws + WS_HB); const bf16_t* Yp = (const bf16_t*)(F.ws + WS_Y);
    for (int tok0 = gw * 4; tok0 < NTOK; tok0 += NGW * 4) {
        int4 rec[4]; float2 wt[4];
#pragma unroll
        for (int t = 0; t < 4; ++t) { rec[t] = ((const int4*)(F.ws + WS_TOKREC))[tok0 + t]; wt[t] = ((const float2*)(F.ws + WS_TOKW))[tok0 + t]; }
        u32x4 ra[4][2], rb[4][2], rc[4][2];
#pragma unroll
        for (int t = 0; t < 4; ++t) {
            const int s1 = toff[rec[t].x] * 256 + rec[t].y, s2 = toff[rec[t].z] * 256 + rec[t].w;
            const bf16_t* hb = HBp + (size_t)(tok0 + t) * DM + 8 * lane; const bf16_t* y1 = Yp + (size_t)s1 * DM + 8 * lane; const bf16_t* y2 = Yp + (size_t)s2 * DM + 8 * lane;
#pragma unroll
            for (int j = 0; j < 2; ++j) { ra[t][j] = __builtin_nontemporal_load((const u32x4*)(hb + 512 * j)); rb[t][j] = __builtin_nontemporal_load((const u32x4*)(y1 + 512 * j)); rc[t][j] = __builtin_nontemporal_load((const u32x4*)(y2 + 512 * j)); }
        }
#pragma unroll
        for (int t = 0; t < 4; ++t) {
            float z[16]; float ss = 0.f;
#pragma unroll
            for (int j = 0; j < 2; ++j)
#pragma unroll
                for (int q = 0; q < 4; ++q) {
                    const float lo = __uint_as_float(ra[t][j][q] << 16) + wt[t].x * __uint_as_float(rb[t][j][q] << 16) + wt[t].y * __uint_as_float(rc[t][j][q] << 16);
                    const float hi = __uint_as_float(ra[t][j][q] & 0xffff0000u) + wt[t].x * __uint_as_float(rb[t][j][q] & 0xffff0000u) + wt[t].y * __uint_as_float(rc[t][j][q] & 0xffff0000u);
                    z[8 * j + 2 * q] = lo; z[8 * j + 2 * q + 1] = hi; ss += lo * lo + hi * hi; }
            const float rstd = rsqrtf(wave_sum(ss) * (1.f / DM) + RMS_EPS);
            float* o = F.out + (size_t)(tok0 + t) * DM;
            __builtin_nontemporal_store((f32x4){z[0] * rstd * g0a[0], z[1] * rstd * g0a[1], z[2] * rstd * g0a[2], z[3] * rstd * g0a[3]}, (f32x4*)(o + 8 * lane));
            __builtin_nontemporal_store((f32x4){z[4] * rstd * g0b[0], z[5] * rstd * g0b[1], z[6] * rstd * g0b[2], z[7] * rstd * g0b[3]}, (f32x4*)(o + 8 * lane + 4));
            __builtin_nontemporal_store((f32x4){z[8] * rstd * g1a[0], z[9] * rstd * g1a[1], z[10] * rstd * g1a[2], z[11] * rstd * g1a[3]}, (f32x4*)(o + 512 + 8 * lane));
            __builtin_nontemporal_store((f32x4){z[12] * rstd * g1b[0], z[13] * rstd * g1b[1], z[14] * rstd * g1b[2], z[15] * rstd * g1b[3]}, (f32x4*)(o + 512 + 8 * lane + 4));
        }
    }
}

struct Args { const float* in[20]; float* out; unsigned char* ws; int ph_lo, ph_hi, li, pad; };
constexpr int N_PHASES = 8;
__global__ void __launch_bounds__(NWAVES * 64, 2) mk_fwd(Args args) {
    extern __shared__ __attribute__((aligned(16))) unsigned char lds_raw[];
    Frame F;
    F.lds = (LAS unsigned char*)lds_raw;
    F.MISC = (volatile LAS unsigned*)(F.lds + MISC_OFF);
    F.tid = threadIdx.x; F.lane = F.tid & 63; F.wave = __builtin_amdgcn_readfirstlane(F.tid >> 6);
    F.G = gridDim.x; { const int bx = blockIdx.x; F.vcu = (F.G % 8 == 0) ? (bx % 8) * (F.G / 8) + bx / 8 : bx; }
    F.in = args.in; F.out = args.out; F.ws = args.ws;
    unsigned char* ws = args.ws;
    for (int u = F.tid; u < 256; u += NWAVES * 64) F.MISC[u] = 0u;
    __syncthreads();
    const int lo = args.ph_lo, hi = args.ph_hi;
    XcdBarrier bar; bar.bar = (unsigned*)(ws + WS_CTL) + CW_BAR + args.li * XCD_BAR_WORDS; bar.x = 0; bar.st = nullptr;
    if (hi - lo > 1) bar = xcd_barrier_post((unsigned*)(ws + WS_CTL) + CW_BAR + args.li * XCD_BAR_WORDS, F.MISC + 8);
#define IN(k) (lo <= (k) && (k) < hi)
#define SEAM(k) do { if (IN(k) && IN((k) + 1)) xcd_barrier(bar); } while (0)
    if (IN(0)) { p0_prologue(F); SEAM(0); }
    if (IN(1)) {
        pg8::Gemm g{(const bf16_t*)(ws + WS_XN), (const bf16_t*)(ws + WS_WIN_T), DM, 0}; pg8::StaticOrder S; S.init(NTOK, NPROJ, DM, F.G, (int)blockIdx.x);
        pg8::EpiBf16G E{(bf16_t*)(ws + WS_PROJ), NPROJ, 3, (f32x2*)(ws + WS_SSQ), 5, 0};
        pg8::gemm_phase<pg8::EpiBf16G, pg8::StaticOrder>(F.lds, g, S, E);
        {
            const int nu = (NTOK / 256) * (NPROJ / 256), full = nu % F.G;
            if (full == 0) convert_rest<1>(F, (int)blockIdx.x * NWAVES + F.wave, F.G * NWAVES);
            else if ((int)blockIdx.x >= full) convert_rest<1>(F, ((int)blockIdx.x - full) * NWAVES + F.wave, (F.G - full) * NWAVES);
        }
        SEAM(1);
    }
    if (IN(2)) { p2_mix(F, args.pad); SEAM(2); }
    if (IN(3)) {
        pg8::Gemm g{(const bf16_t*)(ws + WS_MIXED), (const bf16_t*)(ws + WS_WO_T), DM, 0}; pg8::StaticOrder S; S.init(NTOK, DM, DM, F.G, (int)blockIdx.x);
        pg8::EpiH E{args.in[0], (bf16_t*)(ws + WS_HB), (float*)(ws + WS_SSQ)};
        pg8::gemm_phase<pg8::EpiH, pg8::StaticOrder>(F.lds, g, S, E);
        SEAM(3);
    }
    if (IN(4)) { p4_router(F); SEAM(4); }
    if (IN(5) || IN(6) || IN(7)) {
        const int ntiles = moe_offsets(F);
        const volatile LAS int* toff = (const volatile LAS int*)(F.MISC + 16);
        const int* cnt = (const int*)(ws + WS_CTL) + CW_CNT;
        if (IN(5)) {
            pg8::Gemm g{(const bf16_t*)(ws + WS_HB), (const bf16_t*)(ws + WS_WGU_T), DM, 0};
            MoeOrder<true> S{toff, cnt, (const int*)(ws + WS_TOKLIST), 2, ntiles * 2, F.G, (int)blockIdx.x, DM, 512};
            EpiSwiglu E{(bf16_t*)(ws + WS_HID), (const float*)(ws + WS_RSLIST)};
            pg8::gemm_phase<EpiSwiglu, MoeOrder<true>>(F.lds, g, S, E);
            {
                const int nu = ntiles * 2, full = nu % F.G;
                if (full == 0) convert_rest<2>(F, (int)blockIdx.x * NWAVES + F.wave, F.G * NWAVES);
                else if ((int)blockIdx.x >= full) convert_rest<2>(F, ((int)blockIdx.x - full) * NWAVES + F.wave, (F.G - full) * NWAVES);
            }
            SEAM(5);
        }
        if (IN(6)) {
            pg8::Gemm g{(const bf16_t*)(ws + WS_HID), (const bf16_t*)(ws + WS_WD_T), DEXP, 0};
            MoeOrder<false> S{toff, cnt, (const int*)(ws + WS_TOKLIST), 4, ntiles * 4, F.G, (int)blockIdx.x, DEXP, DM};
            pg8::EpiBf16G E{(bf16_t*)(ws + WS_Y), DM, 1000, nullptr, 1000, 0};
            pg8::gemm_phase<pg8::EpiBf16G, MoeOrder<false>>(F.lds, g, S, E);
            SEAM(6);
        }
        if (IN(7)) p7_final(F);
    }
#undef IN
#undef SEAM
}
extern "C" void kernel_launch(void* const* d_in, const int* in_sizes, int n_in, void* d_out, int out_size, void* d_ws, size_t ws_size, hipStream_t stream) {
    static int grid = 0;
    if (grid == 0) {
        if (n_in != 20 || in_sizes[0] != NTOK * DM || out_size != NTOK * DM || ws_size < WS_END) {
            fprintf(stderr, "kernel_launch: unexpected shapes (n_in %d, in0 %d, out %d, ws %zu)\n", n_in, n_in > 0 ? in_sizes[0] : -1, out_size, ws_size); grid = -1; return; }
        int dev = 0, cus = 0, per_cu = 0;
        if (hipGetDevice(&dev) != hipSuccess || hipDeviceGetAttribute(&cus, hipDeviceAttributeMultiprocessorCount, dev) != hipSuccess) { fprintf(stderr, "kernel_launch: device query failed\n"); grid = -1; return; }
        if (hipFuncSetAttribute((const void*)mk_fwd, hipFuncAttributeMaxDynamicSharedMemorySize, LDS_BYTES) != hipSuccess) { fprintf(stderr, "kernel_launch: hipFuncSetAttribute(%d B LDS) failed\n", LDS_BYTES); grid = -1; return; }
        if (hipOccupancyMaxActiveBlocksPerMultiprocessor(&per_cu, (const void*)mk_fwd, NWAVES * 64, LDS_BYTES) != hipSuccess || per_cu < 1)
            fprintf(stderr, "kernel_launch: note: occupancy query reports %d workgroups per CU\n", per_cu);
        (void)hipGetLastError();
        grid = cus;
    }
    if (grid < 0) return;
    Params p{};
    for (int i = 0; i < 20; ++i) p.in[i] = (const float*)d_in[i];
    p.out = (float*)d_out; p.ws = (unsigned char*)d_ws;
    unsigned char* ws = p.ws;
    (void)hipMemsetAsync(ws + WS_CTL, 0, CTL_ZERO_BYTES, stream);
    const int* cnt = (const int*)(ws + WS_CTL) + CW_CNT;
    Args a{};
    for (int i = 0; i < 20; ++i) a.in[i] = (const float*)d_in[i];
    a.out = (float*)d_out; a.ws = ws;
#ifndef REP_PH
#define REP_PH -1
#endif
    constexpr int rp = REP_PH;
    int li = 0;
#ifdef CUM_PH
    { a.ph_lo = 0; a.ph_hi = CUM_PH; a.li = li++; hipLaunchKernelGGL(mk_fwd, dim3(grid), dim3(NWAVES * 64), LDS_BYTES, stream, a);
      (void)hipMemsetAsync(ws + WS_CTL + CW_CNT * 4, 0, NEXP * 4, stream); }
#endif
    if (rp < 0) { a.ph_lo = 0; a.ph_hi = N_PHASES; a.li = li++; hipLaunchKernelGGL(mk_fwd, dim3(grid), dim3(NWAVES * 64), LDS_BYTES, stream, a); }
    else {
        a.ph_lo = 0; a.ph_hi = rp + 1; a.li = li++; hipLaunchKernelGGL(mk_fwd, dim3(grid), dim3(NWAVES * 64), LDS_BYTES, stream, a);
        if (rp == 4) (void)hipMemsetAsync(ws + WS_CTL + CW_CNT * 4, 0, NEXP * 4, stream);
#ifdef REP_P2
        a.pad = REP_P2;
#endif
#ifdef REP_GRID
        a.ph_lo = rp; a.ph_hi = rp + 1; a.li = li++; hipLaunchKernelGGL(mk_fwd, dim3(REP_GRID), dim3(NWAVES * 64), LDS_BYTES, stream, a);
#else
        a.ph_lo = rp; a.ph_hi = rp + 1; a.li = li++; hipLaunchKernelGGL(mk_fwd, dim3(grid), dim3(NWAVES * 64), LDS_BYTES, stream, a);
#endif
        a.pad = 0;
        if (rp + 1 < N_PHASES) { a.ph_lo = rp + 1; a.ph_hi = N_PHASES; a.li = li++; hipLaunchKernelGGL(mk_fwd, dim3(grid), dim3(NWAVES * 64), LDS_BYTES, stream, a); }
    }
    (void)p; (void)cnt;
}
```

```cpp
#include <hip/hip_runtime.h>
#include <cstdio>
#include <cstdint>
#include <cmath>

constexpr int BATCH = 4, SEQ = 8192, DM = 1024, NTOK = BATCH * SEQ;
constexpr int NPROJ = 1792;
constexpr int C_Q = 0, C_K = 512, C_V = 640, C_GU = 768, C_GV = 1280;
constexpr int NEXP = 32, DEXP = 256, NGRP = 4, EPG = 8;
constexpr int SLOT_CAP = 2 * NTOK + NEXP * 256;
constexpr float RMS_EPS = 1e-6f, LN_EPS = 1e-5f;

typedef unsigned short bf16_t;
__device__ __forceinline__ float bf2f(bf16_t v) { return __uint_as_float((unsigned)v << 16); }
__device__ __forceinline__ bf16_t f2bf(float f) { unsigned u = __float_as_uint(f); return (bf16_t)((u + 0x7fffu + ((u >> 16) & 1u)) >> 16); }

constexpr size_t MiB = 1u << 20;
constexpr size_t WS_CTL = 0, CTL_ZERO_BYTES = 1 * MiB;
constexpr size_t WS_TOKLIST = 58 * MiB;
constexpr size_t WS_RSLIST = 62 * MiB;
constexpr size_t WS_TOKREC = 66 * MiB;
constexpr size_t WS_TOKW = 67 * MiB;
constexpr size_t WS_SSQ = 68 * MiB;
constexpr size_t WS_XN = 72 * MiB;
constexpr size_t WS_PROJ = 136 * MiB;
constexpr size_t WS_MIXED = 248 * MiB;
constexpr size_t WS_HB = 312 * MiB;
constexpr size_t WS_HID = 376 * MiB;
constexpr size_t WS_Y = 72 * MiB;
constexpr size_t WS_AF = 412 * MiB;
constexpr size_t WS_VN = 72 * MiB;
constexpr size_t WS_HF = 376 * MiB;
constexpr size_t WS_END = 512 * MiB;
constexpr int CW_CNT = 64;

struct Params {
    const float* in[20];
    float* out;
    unsigned char* ws;
};

__device__ __forceinline__ float wave_sum(float v) {
#pragma unroll
    for (int o = 1; o < 64; o <<= 1) v += __shfl_xor(v, o);
    return v;
}
__device__ __forceinline__ float gelu_exact(float v) { return 0.5f * v * (1.0f + erff(v * 0.70710678118654752f)); }

#define LAS __attribute__((address_space(3)))
#define GAS __attribute__((address_space(1)))
typedef short bf16x8 __attribute__((ext_vector_type(8)));
typedef short s16x4 __attribute__((ext_vector_type(4)));
typedef float f32x4 __attribute__((ext_vector_type(4)));
typedef float f32x16 __attribute__((ext_vector_type(16)));
typedef float f32x2 __attribute__((ext_vector_type(2)));
typedef unsigned u32x4 __attribute__((ext_vector_type(4)));
typedef unsigned u32x2 __attribute__((ext_vector_type(2)));
typedef GAS unsigned gu32;

constexpr size_t WS_WIN_T = 2 * MiB;
constexpr size_t WS_WO_T = 6 * MiB;
constexpr size_t WS_WSP = 8 * MiB;
constexpr size_t WS_WR_T = 8 * MiB + 512 * 1024;
constexpr size_t WS_RSX = 9 * MiB;
constexpr size_t WS_WGU_T = 10 * MiB;
constexpr size_t WS_WD_T = 42 * MiB;
constexpr int CW_TMO = 0;
constexpr int CW_BAR = 4096;

constexpr int NWAVES = 8;
constexpr int RING_BYTES = 131072;
constexpr int LDS_BYTES = 163840;
constexpr int MISC_OFF = 163840 - 1024;
constexpr float LOG2E = 1.4426950408889634f;

__device__ __forceinline__ unsigned cvt_pk_bf16(float lo, float hi) { unsigned r; asm volatile("v_cvt_pk_bf16_f32 %0, %1, %2" : "=v"(r) : "v"(lo), "v"(hi)); return r; }
#define MFMA32(a, b, c) __builtin_amdgcn_mfma_f32_32x32x16_bf16((a), (b), (c), 0, 0, 0)
#define MFMA16(a, b, c) __builtin_amdgcn_mfma_f32_16x16x32_bf16((a), (b), (c), 0, 0, 0)
typedef short v4i16_t __attribute__((ext_vector_type(4)));
__device__ __forceinline__ s16x4 vtr(const LAS unsigned char* p) { return __builtin_bit_cast(s16x4, __builtin_amdgcn_ds_read_tr16_b64_v4i16((LAS v4i16_t*)p)); }

namespace pg8 {
constexpr int BM = 256, BK = 64, HALF = 128, HTB = HALF * BK * 2, STAGE_BYTES = 8 * HTB, NXCD = 8, WGM = 8;
__host__ __device__ __forceinline__ int lds_byte(int r, int c) { const int st = (r >> 4) * 2 + (c >> 5), rr = r & 15, cc = c & 31, ob = rr * 64 + cc * 2; return st * 1024 + (ob ^ (((ob >> 9) & 1) << 5)); }
__host__ __device__ __forceinline__ void stage_rc(int b, int& R, int& C) { const int st = b / 1024, sb = b % 1024, swz = sb ^ (((sb >> 9) & 1) << 5); R = (st >> 1) * 16 + swz / 64; C = (st & 1) * 32 + (swz % 64) / 2; }
__host__ __device__ __forceinline__ int perm32(int rho) { const int n = rho >> 4, i = rho & 15; return 8 * (i >> 2) + 4 * n + (i & 3); }

struct Unit { int pm, pn, e, pos0, ne, nv; };
struct Gemm { const bf16_t* A; const bf16_t* Bt; int K; int pad; };

__device__ __forceinline__ int xcd_remap(int L, int nwg) { const int q = nwg / NXCD, r = nwg % NXCD, xcd = L % NXCD, off = L / NXCD; return (xcd < r ? xcd * (q + 1) : r * (q + 1) + (xcd - r) * q) + off; }

struct StaticOrder {
    int nM, nN, nwg, G, c, K;
    __device__ void init(int M, int N, int K_, int G_, int c_) { nM = M / BM; nN = N / BM; nwg = nM * nN; G = G_; c = c_; K = K_; }
    __device__ __forceinline__ bool next(int i, Unit& u) const {
        const long L = (long)i * G + c; if (L >= nwg) return false;
        const int wgid = xcd_remap((int)L, nwg);
        const int nig = WGM * nN, gid = wgid / nig, fm = gid * WGM, gsz = (nM - fm) < WGM ? (nM - fm) : WGM;
        u.pm = fm + ((wgid % nig) % gsz); u.pn = (wgid % nig) / gsz; u.e = 0; u.pos0 = 0; u.ne = 0; u.nv = BM; return true;
    }
    __device__ __forceinline__ size_t b_off(const Unit& u) const { return (size_t)u.pn * BM * K; }
    __device__ __forceinline__ int a_row(const Unit& u, int r) const { return u.pm * BM + r; }
};

template <class Epi, class Sched>
__device__ __forceinline__ void gemm_phase(LAS unsigned char* lds, const Gemm g, const Sched& S, const Epi& E) {
    const int tid = threadIdx.x, wid = __builtin_amdgcn_readfirstlane(tid >> 6), lane = tid & 63, wr = wid >> 2, wc = wid & 3, fr = lane & 15, fq = lane >> 4;
    const int K = g.K, nt = K / BK;
    unsigned voffB[2];
#pragma unroll
    for (int i = 0; i < 2; ++i) { int R, C; stage_rc(tid * 16 + i * 8192, R, C); const int Rb = Epi::PERM ? ((R >> 5) * 64 + perm32(R & 31)) : R;
        voffB[i] = (unsigned)(Rb * K + C) * 2u; }
    const size_t kstep = (size_t)(BK * 2);
    const size_t hstep = (size_t)(Epi::PERM ? 32 : HALF) * K * 2;
    const unsigned ldsw = (unsigned)wid * 1024u;
    const int aoff = lds_byte(wr * 64 + fr, fq * 8), boff = lds_byte(wc * 32 + fr, fq * 8);
#define PG8_SA(b, h) (((b) * 2 + (h)) * HTB)
#define PG8_SB(b, h) ((4 + (b) * 2 + (h)) * HTB)
#define PG8_STAGE2(bufoff, gbase, v0, v1) do { \
        __builtin_amdgcn_global_load_lds((const unsigned*)((const char*)(gbase) + (v0)), (LAS unsigned*)(lds + (bufoff) + ldsw), 16, 0, 0); \
        __builtin_amdgcn_global_load_lds((const unsigned*)((const char*)(gbase) + (v1)), (LAS unsigned*)(lds + (bufoff) + ldsw + 8192), 16, 0, 0); } while (0)
#define PG8_STAGEB(bufoff, gbase) PG8_STAGE2(bufoff, gbase, voffB[0], voffB[1])
#define PG8_VOFFA(dst, U) do { _Pragma("unroll") for (int _i = 0; _i < 2; ++_i) { int _R, _C; stage_rc(threadIdx.x * 16 + _i * 8192, _R, _C); _Pragma("unroll") for (int _h = 0; _h < 2; ++_h) \
        dst[_h][_i] = ((unsigned)S.a_row(U, _h * HALF + _R) * (unsigned)K + (unsigned)_C) * 2u; } } while (0)
#define PG8_LDA(dst, b, h) do { _Pragma("unroll") for (int m = 0; m < 4; ++m) _Pragma("unroll") for (int k = 0; k < 2; ++k) dst[m][k] = *(const LAS bf16x8*)(lds + PG8_SA(b, h) + aoff + m * 2048 + k * 1024); } while (0)
#define PG8_LDB(dst, b, h) do { _Pragma("unroll") for (int n = 0; n < 2; ++n) _Pragma("unroll") for (int k = 0; k < 2; ++k) dst[n][k] = *(const LAS bf16x8*)(lds + PG8_SB(b, h) + boff + n * 2048 + k * 1024); } while (0)
#define PG8_MMA(ai, bj, At, Bt) do { if ((ai) * HALF + wr * 64 < cur.nv) { __builtin_amdgcn_s_setprio(1); _Pragma("unroll") for (int m = 0; m < 4; ++m) _Pragma("unroll") for (int n = 0; n < 2; ++n) _Pragma("unroll") for (int k = 0; k < 2; ++k) \
        acc[ai][bj][m][n] = __builtin_amdgcn_mfma_f32_16x16x32_bf16(Bt[n][k], At[m][k], acc[ai][bj][m][n], 0, 0, 0); __builtin_amdgcn_s_setprio(0); } } while (0)
#define PG8_WAIT_V(n) asm volatile("s_waitcnt vmcnt(" #n ")" ::: "memory")
#define PG8_WAIT_L(n) asm volatile("s_waitcnt lgkmcnt(" #n ")" ::: "memory")
#define PG8_BAR __builtin_amdgcn_s_barrier()
#define PG8_SCHED __builtin_amdgcn_sched_barrier(0)
    Unit cur, nxt; int ui = 0;
    if (!S.next(0, cur)) return;
    f32x4 acc[2][2][4][2];
#pragma unroll
    for (int a = 0; a < 2; ++a)
#pragma unroll
        for (int b = 0; b < 2; ++b)
#pragma unroll
            for (int m = 0; m < 4; ++m)
#pragma unroll
                for (int n = 0; n < 2; ++n) acc[a][b][m][n] = (f32x4){0.f, 0.f, 0.f, 0.f};
    bf16x8 At[4][2], B0[2][2], B1[2][2];
    const char* Ab = (const char*)g.A;
    const char* cB = (const char*)(g.Bt + S.b_off(cur));
    unsigned vA[2][2], nvA[2][2];
    PG8_VOFFA(vA, cur);
    PG8_STAGEB(PG8_SB(0, 0), cB); PG8_STAGEB(PG8_SB(0, 1), cB + hstep); PG8_STAGE2(PG8_SA(0, 0), Ab, vA[0][0], vA[0][1]); PG8_STAGE2(PG8_SA(0, 1), Ab, vA[1][0], vA[1][1]);
    if (wr == 1) PG8_BAR;
    PG8_WAIT_V(2); PG8_BAR;
    PG8_STAGEB(PG8_SB(1, 0), cB + kstep); PG8_STAGE2(PG8_SA(1, 0), Ab + kstep, vA[0][0], vA[0][1]); PG8_STAGEB(PG8_SB(1, 1), cB + hstep + kstep);
    PG8_WAIT_V(6); PG8_BAR;
    for (;;) {
        const bool has_next = S.next(ui + 1, nxt);
        const char* nB = cB;
#pragma unroll
        for (int h = 0; h < 2; ++h)
#pragma unroll
            for (int i = 0; i < 2; ++i) nvA[h][i] = vA[h][i];
        if (has_next) { nB = (const char*)(g.Bt + S.b_off(nxt)); PG8_VOFFA(nvA, nxt); }
        for (int t = 0; t < nt; t += 2) {
            const bool last = (t == nt - 2);
            const char* a1 = Ab + (size_t)(t + 1) * kstep;
            const char* a2 = last ? Ab : Ab + (size_t)(t + 2) * kstep; const char* b2 = last ? nB : cB + (size_t)(t + 2) * kstep;
            const char* a3 = a2 + kstep; const char* b3 = b2 + kstep;
            unsigned o00 = vA[0][0], o01 = vA[0][1], o10 = vA[1][0], o11 = vA[1][1];
            if (last) { asm volatile("" : "+v"(nvA[0][0]), "+v"(nvA[0][1]), "+v"(nvA[1][0]), "+v"(nvA[1][1])); o00 = nvA[0][0]; o01 = nvA[0][1]; o10 = nvA[1][0]; o11 = nvA[1][1]; }
            PG8_LDB(B0, 0, 0); PG8_LDB(B1, 0, 1); PG8_SCHED; PG8_LDA(At, 0, 0); PG8_STAGE2(PG8_SA(1, 1), a1, vA[1][0], vA[1][1]);
            PG8_WAIT_V(8); PG8_WAIT_L(0); PG8_BAR; PG8_MMA(0, 0, At, B0); PG8_MMA(0, 1, At, B1); PG8_BAR; PG8_SCHED;
            PG8_LDA(At, 0, 1); PG8_STAGEB(PG8_SB(0, 0), b2); PG8_STAGEB(PG8_SB(0, 1), b2 + hstep); PG8_STAGE2(PG8_SA(0, 0), a2, o00, o01);
            PG8_WAIT_V(8); PG8_WAIT_L(0); PG8_BAR; PG8_MMA(1, 0, At, B0); PG8_MMA(1, 1, At, B1); PG8_BAR; PG8_SCHED;
            PG8_LDB(B0, 1, 0); PG8_LDB(B1, 1, 1); PG8_SCHED; PG8_LDA(At, 1, 0); PG8_STAGE2(PG8_SA(0, 1), a2, o10, o11);
            PG8_WAIT_V(8); PG8_WAIT_L(0); PG8_BAR; PG8_MMA(0, 0, At, B0); PG8_MMA(0, 1, At, B1); PG8_BAR; PG8_SCHED;
            PG8_LDA(At, 1, 1); PG8_STAGEB(PG8_SB(1, 0), b3); PG8_STAGEB(PG8_SB(1, 1), b3 + hstep); PG8_STAGE2(PG8_SA(1, 0), a3, o00, o01);
            PG8_WAIT_V(8); PG8_WAIT_L(0); PG8_BAR; PG8_MMA(1, 0, At, B0); PG8_MMA(1, 1, At, B1); PG8_BAR; PG8_SCHED;
        }
        if (wr == 0) PG8_BAR;
        E(acc, cur, wr, wc, fr, fq);
        if (!has_next) break;
#pragma unroll
        for (int a = 0; a < 2; ++a)
#pragma unroll
            for (int b = 0; b < 2; ++b)
#pragma unroll
                for (int m = 0; m < 4; ++m)
#pragma unroll
                    for (int n = 0; n < 2; ++n) acc[a][b][m][n] = (f32x4){0.f, 0.f, 0.f, 0.f};
        cur = nxt; cB = nB; ++ui;
#pragma unroll
        for (int h = 0; h < 2; ++h)
#pragma unroll
            for (int i = 0; i < 2; ++i) vA[h][i] = nvA[h][i];
        if (wr == 1) PG8_BAR;
    }
    PG8_WAIT_V(0);
    PG8_BAR;
#undef PG8_SA
#undef PG8_SB
#undef PG8_STAGE2
#undef PG8_STAGEB
#undef PG8_VOFFA
#undef PG8_LDA
#undef PG8_LDB
#undef PG8_MMA
#undef PG8_WAIT_V
#undef PG8_WAIT_L
#undef PG8_BAR
#undef PG8_SCHED
}

__device__ __forceinline__ f32x2 gelu_pk(f32x2 v) {
    const f32x2 av = __builtin_elementwise_abs(v), d = av * 0.2316418882f + 1.0f;
    f32x2 t; t.x = __builtin_amdgcn_rcpf(d.x); t.y = __builtin_amdgcn_rcpf(d.y);
    f32x2 q = t * 0.5307027145f + (-0.7265760135f); q = q * t + 0.7107068705f; q = q * t + (-0.142248368f); q = q * t + 0.127414796f; q = q * t;
    const f32x2 s = (v * v) * (-0.72134752044f);
    f32x2 e; e.x = __builtin_amdgcn_exp2f(s.x); e.y = __builtin_amdgcn_exp2f(s.y);
    const f32x2 m = v * (q * e), r = v - m;
    f32x2 o; o.x = v.x < 0.f ? m.x : r.x; o.y = v.y < 0.f ? m.y : r.y; return o;
}

struct EpiBf16G {
    static constexpr bool PERM = true;
    bf16_t* O; int ldc; int gelu_from; f32x2* STAT; int stat_from; int pad; const float* rowscale;
    __device__ __forceinline__ void operator()(const f32x4 (&acc)[2][2][4][2], const Unit& u, int wr, int wc, int fr, int fq) const {
        const int row0 = u.pm * BM + wr * 64 + fr, col0 = u.pn * BM + wc * 64 + 8 * fq, rl0 = wr * 64 + fr;
        const bool act = u.pn >= gelu_from, st = u.pn >= stat_from;
#pragma unroll
        for (int ai = 0; ai < 2; ++ai)
#pragma unroll
            for (int m = 0; m < 4; ++m) { bf16_t* rowp = O + (size_t)(row0 + ai * HALF + m * 16) * ldc + col0; float s1 = 0.f, s2 = 0.f;
                const bool live = rl0 + ai * HALF + m * 16 < u.nv; const float rsc = rowscale ? rowscale[row0 + ai * HALF + m * 16] : 1.f;
#pragma unroll
                for (int bj = 0; bj < 2; ++bj) { f32x4 v0 = acc[ai][bj][m][0] * rsc, v1 = acc[ai][bj][m][1] * rsc;
                    if (act) { f32x2 a = gelu_pk((f32x2){v0[0], v0[1]}), b = gelu_pk((f32x2){v0[2], v0[3]}), c = gelu_pk((f32x2){v1[0], v1[1]}), d = gelu_pk((f32x2){v1[2], v1[3]});
                        v0 = (f32x4){a.x, a.y, b.x, b.y}; v1 = (f32x4){c.x, c.y, d.x, d.y}; }
                    if (st) { s1 += (v0[0] + v0[1]) + (v0[2] + v0[3]) + (v1[0] + v1[1]) + (v1[2] + v1[3]);
                        s2 += (v0[0] * v0[0] + v0[1] * v0[1]) + (v0[2] * v0[2] + v0[3] * v0[3]) + (v1[0] * v1[0] + v1[1] * v1[1]) + (v1[2] * v1[2] + v1[3] * v1[3]); }
                    u32x4 w; w.x = cvt_pk_bf16(v0[0], v0[1]); w.y = cvt_pk_bf16(v0[2], v0[3]); w.z = cvt_pk_bf16(v1[0], v1[1]); w.w = cvt_pk_bf16(v1[2], v1[3]);
                    if (live) *(u32x4*)(rowp + bj * 32) = w; }
                if (st) { s1 += __shfl_xor(s1, 16); s1 += __shfl_xor(s1, 32); s2 += __shfl_xor(s2, 16); s2 += __shfl_xor(s2, 32);
                    if (fq == 0) STAT[(size_t)(row0 + ai * HALF + m * 16) * 8 + (u.pn - stat_from) * 4 + wc] = (f32x2){s1, s2}; } }
    }
};
struct EpiH {
    static constexpr bool PERM = true;
    const bf16_t* x; bf16_t* HB; float* SSQ;
    __device__ __forceinline__ void operator()(const f32x4 (&acc)[2][2][4][2], const Unit& u, int wr, int wc, int fr, int fq) const {
        const int row0 = u.pm * BM + wr * 64 + fr, col0 = u.pn * BM + wc * 64 + 8 * fq;
#pragma unroll
        for (int ai = 0; ai < 2; ++ai)
#pragma unroll
            for (int m = 0; m < 4; ++m) { const int row = row0 + ai * HALF + m * 16; const bf16_t* xr = x + (size_t)row * DM + col0; bf16_t* hr = HB + (size_t)row * DM + col0; float s = 0.f;
#pragma unroll
                for (int bj = 0; bj < 2; ++bj) { const u32x4 xw = __builtin_nontemporal_load((const u32x4*)(xr + bj * 32));
                    const f32x4 x0 = (f32x4){__uint_as_float(xw.x << 16), __uint_as_float(xw.x & 0xffff0000u), __uint_as_float(xw.y << 16), __uint_as_float(xw.y & 0xffff0000u)}, x1 = (f32x4){__uint_as_float(xw.z << 16), __uint_as_float(xw.z & 0xffff0000u), __uint_as_float(xw.w << 16), __uint_as_float(xw.w & 0xffff0000u)};
                    const f32x4 v0 = acc[ai][bj][m][0] + x0, v1 = acc[ai][bj][m][1] + x1;
                    s += (v0[0] * v0[0] + v0[1] * v0[1]) + (v0[2] * v0[2] + v0[3] * v0[3]) + (v1[0] * v1[0] + v1[1] * v1[1]) + (v1[2] * v1[2] + v1[3] * v1[3]);
                    u32x4 w; w.x = cvt_pk_bf16(v0[0], v0[1]); w.y = cvt_pk_bf16(v0[2], v0[3]); w.z = cvt_pk_bf16(v1[0], v1[1]); w.w = cvt_pk_bf16(v1[2], v1[3]);
                    *(u32x4*)(hr + bj * 32) = w; }
                s += __shfl_xor(s, 16); s += __shfl_xor(s, 32);
                if (fq == 0) SSQ[(size_t)row * 16 + u.pn * 4 + wc] = s; }
    }
};
}

template <bool GATHER>
struct MoeOrder {
    const volatile LAS int* toff;
    const int* cnt; const int* toklist;
    int nN, nwg, G, c, K, rows_per_e;
    __device__ __forceinline__ bool next(int i, pg8::Unit& u) const {
        const long L = (long)i * G + c; if (L >= nwg) return false;
        const int wgid = pg8::xcd_remap((int)L, nwg);
        const int T = wgid / nN; u.pn = wgid % nN; u.pm = T;
        int e = 0;
        for (int j = 1; j < NEXP; ++j) e += (toff[j] <= T) ? 1 : 0;
        e = __builtin_amdgcn_readfirstlane(e);
        u.e = e; u.pos0 = __builtin_amdgcn_readfirstlane((T - toff[e]) * 256); u.ne = __builtin_amdgcn_readfirstlane(toff[64 + e]); { const int left = u.ne - u.pos0; u.nv = left < 256 ? left : 256; } return true;
    }
    __device__ __forceinline__ size_t b_off(const pg8::Unit& u) const { return ((size_t)u.e * rows_per_e + (size_t)u.pn * 256) * K; }
    __device__ __forceinline__ int a_row(const pg8::Unit& u, int r) const {
        if (!GATHER) return u.pm * 256 + r;
        const int pos = u.pos0 + r;
        return pos < u.ne ? toklist[(size_t)u.e * NTOK + pos] : 0;
    }
};
struct EpiSwiglu {
    static constexpr bool PERM = true;
    bf16_t* HID; const float* rslist;
    __device__ __forceinline__ void operator()(const f32x4 (&acc)[2][2][4][2], const pg8::Unit& u, int wr, int wc, int fr, int fq) const {
        const int r0 = wr * 64 + fr, col0 = u.pn * 128 + wc * 32 + 8 * fq; const int pos0 = u.pos0, n_e = u.ne;
#pragma unroll
        for (int ai = 0; ai < 2; ++ai)
#pragma unroll
            for (int m = 0; m < 4; ++m) { const int r = r0 + ai * 128 + m * 16, pos = pos0 + r;
                const float rs = pos < n_e ? rslist[(size_t)u.e * NTOK + pos] : 0.f;
                float o[8];
#pragma unroll
                for (int n = 0; n < 2; ++n)
#pragma unroll
                    for (int j = 0; j < 4; ++j) { const float gt = acc[ai][0][m][n][j] * rs, up = acc[ai][1][m][n][j] * rs;
                        o[4 * n + j] = gt * __builtin_amdgcn_rcpf(1.f + __builtin_amdgcn_exp2f(-gt * LOG2E)) * up; }
                u32x4 w; w.x = cvt_pk_bf16(o[0], o[1]); w.y = cvt_pk_bf16(o[2], o[3]); w.z = cvt_pk_bf16(o[4], o[5]); w.w = cvt_pk_bf16(o[6], o[7]);
                if (r < u.nv || true) *(u32x4*)(HID + (size_t)(u.pm * 256 + r) * DEXP + col0) = w; }
    }
};

#define XB_TMO      128
#define XB_XCNT(j)  (256  + 64 * (j))
#define XB_XSUB(j)  (1280 + 64 * (j))
#define XB_XGEN(j)  (2304 + 64 * (j))
#define XB_TOP      3328
#define XB_TOPGEN   3392
#define XCD_BAR_WORDS 3456
#define XB_SPIN_CAP (1u << 18)
__device__ __forceinline__ unsigned xb_ld(unsigned* p)              { return __hip_atomic_load(p, __ATOMIC_RELAXED, __HIP_MEMORY_SCOPE_AGENT); }
__device__ __forceinline__ unsigned xb_add(unsigned* p, unsigned v) { return __hip_atomic_fetch_add(p, v, __ATOMIC_RELAXED, __HIP_MEMORY_SCOPE_AGENT); }
__device__ __forceinline__ unsigned xb_xcc_id() { return (unsigned)__builtin_amdgcn_s_getreg((3 << 11) | 20) & 0xFu; }
#define XB_SPIN(cond, bar) do { unsigned _sp = 0; while (cond) { __builtin_amdgcn_s_sleep(1); \
    if ((++_sp & 255u) == 0u) { if (xb_ld(&(bar)[XB_TMO])) break; if (_sp > XB_SPIN_CAP) { atomicAdd(&(bar)[XB_TMO], 1u); break; } } } } while (0)
struct XcdBarrier { unsigned* bar; unsigned x; volatile LAS unsigned* st; };
__device__ __forceinline__ XcdBarrier xcd_barrier_post(unsigned* bar, volatile LAS unsigned* st) {
    XcdBarrier b; b.bar = bar; b.x = xb_xcc_id(); b.st = st;
    if (threadIdx.x == 0) (void)xb_add(&bar[XB_XCNT(b.x)], 1u);
    return b;
}
__device__ __forceinline__ void xcd_barrier_complete(unsigned* bar, unsigned x, unsigned& nloc, unsigned& nx) {
    const unsigned G = gridDim.x * gridDim.y * gridDim.z;
    unsigned sum, cnt, mine, sp = 0u;
    for (;;) {
        sum = 0u; cnt = 0u; mine = 0u;
#pragma unroll
        for (unsigned j = 0; j < 16; ++j) { const unsigned c = xb_ld(&bar[XB_XCNT(j)]); sum += c; cnt += (c > 0u) ? 1u : 0u; mine = (j == x) ? c : mine; }
        if (sum == G) break;
        __builtin_amdgcn_s_sleep(1);
        if ((++sp & 255u) == 0u) { if (xb_ld(&bar[XB_TMO])) break; if (sp > XB_SPIN_CAP) { atomicAdd(&bar[XB_TMO], 1u); break; } }
    }
    nloc = mine > 0u ? mine : 1u; nx = cnt > 0u ? cnt : 1u;
}
struct Frame;
template <int WHICH> __device__ __forceinline__ void convert_rest(Frame& F, int part, int nparts, int lo, int hi);
__device__ __forceinline__ void barrier_background(Frame& F, int bg);
__device__ __forceinline__ void xcd_barrier(const XcdBarrier& b, Frame* Fp = nullptr, int bg = -1) {
    asm volatile("s_waitcnt vmcnt(0)" ::: "memory");
    __syncthreads();
    if (bg >= 0 && threadIdx.x >= 64) barrier_background(*Fp, bg);
    if (threadIdx.x == 0) {
        unsigned* bar = b.bar;
        __builtin_amdgcn_s_waitcnt(0);
        unsigned nloc = b.st[0], nx = b.st[1];
        if (nloc == 0u) { xcd_barrier_complete(bar, b.x, nloc, nx); b.st[0] = nloc; b.st[1] = nx; }
        const unsigned old = xb_add(&bar[XB_XSUB(b.x)], 1u);
        const unsigned gen = old / nloc;
        if (old + 1u == (gen + 1u) * nloc) {
            __builtin_amdgcn_fence(__ATOMIC_RELEASE, "agent");
            asm volatile("s_waitcnt vmcnt(0)" ::: "memory");
            const unsigned og = xb_add(&bar[XB_TOP], 1u);
            const unsigned tg = og / nx;
            if (og + 1u == (tg + 1u) * nx) xb_add(&bar[XB_TOPGEN], 1u);
            else XB_SPIN(xb_ld(&bar[XB_TOPGEN]) == tg, bar);
            __builtin_amdgcn_fence(__ATOMIC_ACQUIRE, "agent");
            xb_add(&bar[XB_XGEN(b.x)], 1u);
            asm volatile("s_waitcnt vmcnt(0)" ::: "memory");
        } else {
            XB_SPIN(xb_ld(&bar[XB_XGEN(b.x)]) == gen, bar);
            __builtin_amdgcn_fence(__ATOMIC_ACQUIRE, "agent");
            asm volatile("s_waitcnt vmcnt(0)" ::: "memory");
        }
    }
    __syncthreads();
}

struct Frame {
    LAS unsigned char* lds;
    volatile LAS unsigned* MISC;
    int tid, lane, wave, vcu, G;
    const float* const* in; float* out; unsigned char* ws;
};
#define LDS_WAIT() asm volatile("s_waitcnt lgkmcnt(0)" ::: "memory")

__device__ __forceinline__ void transpose_tile64(const float* W, int ldw, int k0, int n0, bf16_t* WT, int ldt, int rowbase, const float* kscale, int lane, int hi32 = 32) {
    const float* src = W + (size_t)k0 * ldw + n0 + lane;
    float v[64];
#pragma unroll
    for (int k = 0; k < 64; ++k) v[k] = __builtin_nontemporal_load(src + (size_t)k * ldw);
    if (kscale) {
#pragma unroll
        for (int k = 0; k < 64; ++k) v[k] *= kscale[k0 + k];
    }
    bf16_t* dst = WT + (size_t)(rowbase + (lane & 31) + (lane >> 5) * hi32) * ldt + k0;
#pragma unroll
    for (int c = 0; c < 8; ++c) { u32x4 o; o.x = cvt_pk_bf16(v[8 * c], v[8 * c + 1]); o.y = cvt_pk_bf16(v[8 * c + 2], v[8 * c + 3]); o.z = cvt_pk_bf16(v[8 * c + 4], v[8 * c + 5]); o.w = cvt_pk_bf16(v[8 * c + 6], v[8 * c + 7]);
        *(u32x4*)(dst + 8 * c) = o; }
}

__device__ __forceinline__ void p0_prologue(Frame& F) {
    const int gw = F.vcu * NWAVES + F.wave, NGW = F.G * NWAVES, lane = F.lane;
    unsigned char* ws = F.ws;
    for (int it = gw; it < 16 * 28; it += NGW) { const int kb = it / 28, nb = it % 28; transpose_tile64(F.in[2], NPROJ, 64 * kb, 64 * nb, (bf16_t*)(ws + WS_WIN_T), DM, 64 * nb, F.in[1], lane); }
    const int gt = F.vcu * (NWAVES * 64) + F.tid, NGT = F.G * NWAVES * 64;
    for (int i = gt; i < 8 * 128 * 128; i += NGT) { const int c = i & 127, t = (i >> 7) & 127; ((bf16_t*)(ws + WS_WSP))[i] = c <= t ? f2bf(F.in[4][i]) : (bf16_t)0; }
    for (int i = gt; i < 64 * DM; i += NGT) { const int k = i & (DM - 1), c = i >> 10; float v = 0.f;
        if (c < 4) v = F.in[12][k * 4 + c] * F.in[11][k];
        else if (c < 36) { const int g = (c - 4) >> 3, e = (c - 4) & 7; v = F.in[14][((size_t)g * DM + k) * 8 + e] * F.in[11][k]; }
        ((bf16_t*)(ws + WS_WR_T))[i] = f2bf(v); }
    float* rsx = (float*)(ws + WS_RSX);
    for (int row0 = gw * 8; row0 < NTOK; row0 += NGW * 8) {
        f32x4 v[8][4];
#pragma unroll
        for (int rr = 0; rr < 8; ++rr)
#pragma unroll
            for (int j = 0; j < 4; ++j) v[rr][j] = __builtin_nontemporal_load((const f32x4*)(F.in[0] + (size_t)(row0 + rr) * DM + 256 * j + 4 * lane));
#pragma unroll
        for (int rr = 0; rr < 8; ++rr) {
            float s = 0.f;
#pragma unroll
            for (int j = 0; j < 4; ++j) s += (v[rr][j][0] * v[rr][j][0] + v[rr][j][1] * v[rr][j][1]) + (v[rr][j][2] * v[rr][j][2] + v[rr][j][3] * v[rr][j][3]);
            const float rstd = rsqrtf(wave_sum(s) * (1.f / DM) + RMS_EPS);
            if (lane == 0) rsx[row0 + rr] = rstd;
            bf16_t* xn = (bf16_t*)(ws + WS_XN) + (size_t)(row0 + rr) * DM;
#pragma unroll
            for (int j = 0; j < 4; ++j) { u32x2 o; o.x = cvt_pk_bf16(v[rr][j][0], v[rr][j][1]); o.y = cvt_pk_bf16(v[rr][j][2], v[rr][j][3]);
                *(u32x2*)(xn + 256 * j + 4 * lane) = o; }
        }
    }
}
template <int WHICH>
__device__ __forceinline__ void convert_rest(Frame& F, int part, int nparts, int lo, int hi) {
    unsigned char* ws = F.ws; const int lane = F.lane;
    constexpr int T_OUT = 16 * 16, T_GU = NEXP * 64, T_D = NEXP * 64;
    if (WHICH == 0) {
        for (int it = lo + part; it < 2 * T_GU && it < hi; it += nparts) {
            int r = it; const int up = r >= T_GU; if (up) r -= T_GU; const int e = r / 64, q = r % 64, kb = q / 4, nb = q % 4, n0 = 64 * nb;
            const int rowbase = e * 512 + 256 * (n0 >> 7) + 2 * (n0 & 127) + (up ? 32 : 0);
            transpose_tile64(F.in[up ? 17 : 16] + (size_t)e * DM * DEXP, DEXP, 64 * kb, n0, (bf16_t*)(ws + WS_WGU_T), DM, rowbase, F.in[11], lane, 64); }
    } else if (WHICH == 1) {
        for (int it = part; it < T_OUT; it += nparts) { const int kb = it / 16, nb = it % 16; transpose_tile64(F.in[10], DM, 64 * kb, 64 * nb, (bf16_t*)(ws + WS_WO_T), DM, 64 * nb, nullptr, lane); }
    } else {
        for (int it = part; it < T_D; it += nparts) { const int e = it / 64, q = it % 64, kb = q / 16, nb = q % 16;
            transpose_tile64(F.in[18] + (size_t)e * DEXP * DM, DM, 64 * kb, 64 * nb, (bf16_t*)(ws + WS_WD_T), DEXP, e * DM + 64 * nb, nullptr, lane); }
    }
}

__device__ __forceinline__ void barrier_background(Frame& F, int bg) {
    constexpr int NT = 2 * NEXP * 64, PER = (NT + 2) / 3;
    convert_rest<0>(F, F.vcu * (NWAVES - 1) + (F.wave - 1), F.G * (NWAVES - 1), bg * PER, (bg + 1) * PER);
}

constexpr int P2_K_OFF = 0, P2_KROW = 144, P2_KHEAD = 256 * P2_KROW;
constexpr int P2_V_OFF = 2 * P2_KHEAD, P2_VHEAD = 256 * 128;
constexpr int P2_VN_OFF = 0, P2_VNROW = 1088;
constexpr int P2_EXA_OFF = 139264, P2_EXG_OFF = P2_EXA_OFF + 4096;
static_assert(P2_V_OFF + 2 * P2_VHEAD <= P2_EXA_OFF && 128 * P2_VNROW <= P2_EXA_OFF && P2_EXG_OFF + 4096 <= MISC_OFF, "P2 LDS map");

__device__ __forceinline__ void p2_mix(Frame& F, const int skip) {
    const int tid = F.tid, lane = F.lane, w = F.wave;
    const int r = lane & 31, hh = lane >> 5, g4 = lane >> 4, q4 = (lane & 15) >> 2, p4 = lane & 3;
    const bf16_t* proj = (const bf16_t*)(F.ws + WS_PROJ);
    bf16_t* mixed = (bf16_t*)(F.ws + WS_MIXED);
    const bf16_t* wsp = (const bf16_t*)(F.ws + WS_WSP);
    LAS unsigned char* lds = F.lds;
    LAS float* exA = (LAS float*)(lds + P2_EXA_OFF); LAS float* exG = (LAS float*)(lds + P2_EXG_OFF);
    const float sink2 = F.in[3][w] * LOG2E;
    const float SC2 = 0.125f * LOG2E;
    for (int unit = F.vcu; unit < NTOK / 128; unit += F.G) {
        const int t0 = unit * 128; const bool first = (unit & 63) == 0;
        {
            u32x4 kv[8], vv[8];
#pragma unroll
            for (int i = 0; i < 8; ++i) { const int pc = tid + 512 * i, key = pc >> 4, sub = pc & 15;
                kv[i] = (u32x4){0u, 0u, 0u, 0u}; vv[i] = (u32x4){0u, 0u, 0u, 0u};
                if (!(first && key < 128)) { const bf16_t* rowp = proj + (size_t)(t0 - 128 + key) * NPROJ; kv[i] = *(const u32x4*)(rowp + C_K + sub * 8); vv[i] = *(const u32x4*)(rowp + C_V + sub * 8); } }
#pragma unroll
            for (int i = 0; i < 8; ++i) { const int pc = tid + 512 * i, key = pc >> 4, sub = pc & 15, kvh = sub >> 3, piece = sub & 7;
                *(LAS u32x4*)(lds + P2_K_OFF + kvh * P2_KHEAD + key * P2_KROW + piece * 16) = kv[i];
                *(LAS u32x4*)(lds + P2_V_OFF + kvh * P2_VHEAD + key * 128 + ((piece ^ (((key >> 1) & 1) << 2)) * 16)) = vv[i]; }
        }
        if (!(skip & 1)) {
            const int kvh = w >> 2;
            const LAS unsigned char* Kl = lds + P2_K_OFF + kvh * P2_KHEAD;
            const LAS unsigned char* Vl = lds + P2_V_OFF + kvh * P2_VHEAD;
            const int vflip = (q4 >> 1) & 1;
            const int vlane = (4 * hh + q4) * 128 + (g4 & 1) * 32 + p4 * 8;
            const int vh0 = vflip * 64, vh1 = (vflip ^ 1) * 64;
            const bf16_t* qbase = proj + (size_t)(t0 + r) * NPROJ + C_Q + 64 * w + 8 * hh;
            bf16x8 qn[4];
#pragma unroll
            for (int s = 0; s < 4; ++s) qn[s] = __builtin_nontemporal_load((const bf16x8*)(qbase + 16 * s));
            __syncthreads();
            for (int qb = 0; qb < 4; ++qb) {
                bf16x8 qf[4];
#pragma unroll
                for (int s = 0; s < 4; ++s) qf[s] = qn[s];
                if (qb < 3) {
#pragma unroll
                    for (int s = 0; s < 4; ++s) qn[s] = __builtin_nontemporal_load((const bf16x8*)(qbase + (size_t)(32 * (qb + 1)) * NPROJ + 16 * s));
                }
                f32x16 sa[5];
#pragma unroll
                for (int cc = 0; cc < 5; ++cc) {
#pragma unroll
                    for (int i = 0; i < 16; ++i) sa[cc][i] = 0.f;
                    const LAS unsigned char* kp = Kl + (32 * (qb + cc) + r) * P2_KROW + 16 * hh;
#pragma unroll
                    for (int s = 0; s < 4; ++s) { const bf16x8 kf = *(const LAS bf16x8*)(kp + 32 * s); sa[cc] = MFMA32(kf, qf[s], sa[cc]); }
                }
                const int q = 32 * qb + r; float mr = -1e30f;
#pragma unroll
                for (int cc = 0; cc < 5; ++cc)
#pragma unroll
                    for (int i = 0; i < 16; ++i) { const int kb = 32 * (qb + cc) + (i & 3) + 8 * (i >> 2) + 4 * hh;
                        if (cc == 0 || cc == 4 || first) { bool ok = true; if (cc == 0) ok = kb >= q + 1; if (cc == 4) ok = kb <= q + 128; if (first) ok = ok && kb >= 128; sa[cc][i] = ok ? sa[cc][i] : -1e30f; }
                        mr = fmaxf(mr, sa[cc][i]); }
                mr = fmaxf(mr, __shfl_xor(mr, 32));
                const float mx = fmaxf(mr * SC2, sink2);
                float sum = 0.f;
#pragma unroll
                for (int cc = 0; cc < 5; ++cc)
#pragma unroll
                    for (int i = 0; i < 16; ++i) { const float pe = __builtin_amdgcn_exp2f(fmaf(sa[cc][i], SC2, -mx)); sa[cc][i] = pe; sum += pe; }
                sum += __shfl_xor(sum, 32);
                const float inv = 1.f / (sum + __builtin_amdgcn_exp2f(sink2 - mx));
                f32x16 o[2];
#pragma unroll
                for (int i = 0; i < 16; ++i) { o[0][i] = 0.f; o[1][i] = 0.f; }
#pragma unroll
                for (int cc = 0; cc < 5; ++cc)
#pragma unroll
                    for (int s2 = 0; s2 < 2; ++s2) {
                        u32x4 pw; pw.x = cvt_pk_bf16(sa[cc][8 * s2 + 0], sa[cc][8 * s2 + 1]); pw.y = cvt_pk_bf16(sa[cc][8 * s2 + 2], sa[cc][8 * s2 + 3]);
                        pw.z = cvt_pk_bf16(sa[cc][8 * s2 + 4], sa[cc][8 * s2 + 5]); pw.w = cvt_pk_bf16(sa[cc][8 * s2 + 6], sa[cc][8 * s2 + 7]);
                        const bf16x8 pf = __builtin_bit_cast(bf16x8, pw);
                        const LAS unsigned char* vp = Vl + (32 * (qb + cc) + 16 * s2) * 128 + vlane;
#pragma unroll
                        for (int db = 0; db < 2; ++db) { const int vh = db ? vh1 : vh0; const s16x4 a0 = vtr(vp + vh), a1 = vtr(vp + 8 * 128 + vh);
                            const bf16x8 vf = (bf16x8){a0[0], a0[1], a0[2], a0[3], a1[0], a1[1], a1[2], a1[3]};
                            o[db] = MFMA32(vf, pf, o[db]); }
                    }
                float ss = 0.f;
#pragma unroll
                for (int db = 0; db < 2; ++db)
#pragma unroll
                    for (int i = 0; i < 16; ++i) { o[db][i] *= inv; ss += o[db][i] * o[db][i]; }
                ss += __shfl_xor(ss, 32);
                if (hh == 0) exA[(qb * 8 + w) * 32 + r] = ss;
                __syncthreads();
                float tot = 0.f;
#pragma unroll
                for (int j = 0; j < 8; ++j) tot += exA[(qb * 8 + j) * 32 + r];
                const float rstd = rsqrtf(tot * (1.f / 512) + RMS_EPS);
                bf16_t* orow = mixed + (size_t)(t0 + q) * DM + 64 * w + 4 * hh;
                const float* ga = F.in[8] + 64 * w + 4 * hh;
#pragma unroll
                for (int db = 0; db < 2; ++db)
#pragma unroll
                    for (int rg = 0; rg < 4; ++rg) { const f32x4 gg = *(const f32x4*)(ga + 32 * db + 8 * rg);
                        u32x2 ow; ow.x = cvt_pk_bf16(o[db][4 * rg] * rstd * gg[0], o[db][4 * rg + 1] * rstd * gg[1]); ow.y = cvt_pk_bf16(o[db][4 * rg + 2] * rstd * gg[2], o[db][4 * rg + 3] * rstd * gg[3]);
                        *(u32x2*)(orow + 32 * db + 8 * rg) = ow; }
            }
        }
        if (!(skip & 2)) {
            u32x4 raw[16];
#pragma unroll
            for (int i = 0; i < 16; ++i) raw[i] = __builtin_nontemporal_load((const u32x4*)(proj + (size_t)(t0 + 16 * w + i) * NPROJ + C_GV + 8 * lane));
            const f32x4 lg0 = *(const f32x4*)(F.in[6] + 8 * lane), lg1 = *(const f32x4*)(F.in[6] + 8 * lane + 4), lb0 = *(const f32x4*)(F.in[7] + 8 * lane), lb1 = *(const f32x4*)(F.in[7] + 8 * lane + 4);
            LAS f32x2* stat = (LAS f32x2*)(lds + P2_EXG_OFF);
            if (tid < 128) { const f32x4* sp = (const f32x4*)((const float*)(F.ws + WS_SSQ) + (size_t)(t0 + tid) * 16); const f32x4 a = sp[0], b = sp[1], c = sp[2], d = sp[3];
                const float s1 = (a[0] + a[2]) + (b[0] + b[2]) + (c[0] + c[2]) + (d[0] + d[2]), s2 = (a[1] + a[3]) + (b[1] + b[3]) + (c[1] + c[3]) + (d[1] + d[3]);
                const float mu = s1 * (1.f / 512), var = fmaxf(s2 * (1.f / 512) - mu * mu, 0.f); stat[tid] = (f32x2){mu, rsqrtf(var + LN_EPS)}; }
            __syncthreads();
#pragma unroll
            for (int i = 0; i < 16; ++i) { const int tok = 16 * w + i; const f32x2 st = stat[tok]; const float mu = st.x, rstd = st.y;
                float v[8];
                v[0] = __uint_as_float(raw[i].x << 16); v[1] = __uint_as_float(raw[i].x & 0xffff0000u); v[2] = __uint_as_float(raw[i].y << 16); v[3] = __uint_as_float(raw[i].y & 0xffff0000u);
                v[4] = __uint_as_float(raw[i].z << 16); v[5] = __uint_as_float(raw[i].z & 0xffff0000u); v[6] = __uint_as_float(raw[i].w << 16); v[7] = __uint_as_float(raw[i].w & 0xffff0000u);
#pragma unroll
                for (int j = 0; j < 8; ++j) v[j] = (v[j] - mu) * rstd;
                u32x4 ow; ow.x = cvt_pk_bf16(v[0] * lg0[0] + lb0[0], v[1] * lg0[1] + lb0[1]); ow.y = cvt_pk_bf16(v[2] * lg0[2] + lb0[2], v[3] * lg0[3] + lb0[3]);
                ow.z = cvt_pk_bf16(v[4] * lg1[0] + lb1[0], v[5] * lg1[1] + lb1[1]); ow.w = cvt_pk_bf16(v[6] * lg1[2] + lb1[2], v[7] * lg1[3] + lb1[3]);
                *(LAS u32x4*)(lds + P2_VN_OFF + tok * P2_VNROW + lane * 16) = ow; }
        }
        if (!(skip & 4)) {
            const LAS unsigned char* vnl = lds + P2_VN_OFF + (8 * hh + q4) * P2_VNROW + (64 * w + 16 * (g4 & 1) + 4 * p4) * 2;
            const bf16_t* wh = wsp + (size_t)w * 128 * 128 + (size_t)r * 128 + 8 * hh;
            const bf16_t* ub = proj + (size_t)(t0 + r) * NPROJ + C_GU + 64 * w + 4 * hh;
            bf16x8 wf[8]; u32x2 uu[8];
#pragma unroll
            for (int s = 0; s < 2; ++s) wf[s] = *(const bf16x8*)(wh + 16 * s);
#pragma unroll
            for (int j = 0; j < 8; ++j) uu[j] = *(const u32x2*)(ub + 32 * (j >> 2) + 8 * (j & 3));
            __syncthreads();
#pragma unroll
            for (int tb = 0; tb < 4; ++tb) {
                f32x16 acc[2];
#pragma unroll
                for (int i = 0; i < 16; ++i) { acc[0][i] = 0.f; acc[1][i] = 0.f; }
#pragma unroll
                for (int s = 0; s < 2 * tb + 2; ++s) {
#pragma unroll
                    for (int db = 0; db < 2; ++db) { const LAS unsigned char* vp = vnl + (16 * s) * P2_VNROW + db * 64;
                        const s16x4 a0 = vtr(vp), a1 = vtr(vp + 4 * P2_VNROW);
                        const bf16x8 af = (bf16x8){a0[0], a0[1], a0[2], a0[3], a1[0], a1[1], a1[2], a1[3]};
                        acc[db] = MFMA32(af, wf[s], acc[db]); }
                }
                const int t = 32 * tb + r; const float bs = F.in[5][w * 128 + t];
                float ss = 0.f;
#pragma unroll
                for (int db = 0; db < 2; ++db)
#pragma unroll
                    for (int rg = 0; rg < 4; ++rg) { const u32x2 u2 = uu[4 * db + rg];
                        const float u0 = __uint_as_float(u2.x << 16), u1 = __uint_as_float(u2.x & 0xffff0000u), u2f = __uint_as_float(u2.y << 16), u3 = __uint_as_float(u2.y & 0xffff0000u);
                        float a = u0 * (acc[db][4 * rg] + bs), b = u1 * (acc[db][4 * rg + 1] + bs), c = u2f * (acc[db][4 * rg + 2] + bs), d = u3 * (acc[db][4 * rg + 3] + bs);
                        acc[db][4 * rg] = a; acc[db][4 * rg + 1] = b; acc[db][4 * rg + 2] = c; acc[db][4 * rg + 3] = d; ss += (a * a + b * b) + (c * c + d * d); }
                if (tb < 3) {
#pragma unroll
                    for (int s = 0; s < 2 * tb + 4; ++s) wf[s] = *(const bf16x8*)(wh + (size_t)(32 * (tb + 1)) * 128 + 16 * s);
#pragma unroll
                    for (int j = 0; j < 8; ++j) uu[j] = *(const u32x2*)(ub + (size_t)(32 * (tb + 1)) * NPROJ + 32 * (j >> 2) + 8 * (j & 3));
                }
                ss += __shfl_xor(ss, 32);
                if (hh == 0) exG[(tb * 8 + w) * 32 + r] = ss;
                __syncthreads();
                float tot = 0.f;
#pragma unroll
                for (int j = 0; j < 8; ++j) tot += exG[(tb * 8 + j) * 32 + r];
                const float rstd = rsqrtf(tot * (1.f / 512) + RMS_EPS);
                bf16_t* orow = mixed + (size_t)(t0 + t) * DM + 512 + 64 * w + 4 * hh;
                const float* gg_ = F.in[9] + 64 * w + 4 * hh;
#pragma unroll
                for (int db = 0; db < 2; ++db)
#pragma unroll
                    for (int rg = 0; rg < 4; ++rg) { const f32x4 gg = *(const f32x4*)(gg_ + 32 * db + 8 * rg);
                        u32x2 ow; ow.x = cvt_pk_bf16(acc[db][4 * rg] * rstd * gg[0], acc[db][4 * rg + 1] * rstd * gg[1]); ow.y = cvt_pk_bf16(acc[db][4 * rg + 2] * rstd * gg[2], acc[db][4 * rg + 3] * rstd * gg[3]);
                        *(u32x2*)(orow + 32 * db + 8 * rg) = ow; }
            }
        }
        __syncthreads();
    }
}

constexpr int P4_WROW = 2064;
constexpr int P4_W_OFF = 0, P4_LG_OFF = 48 * P4_WROW, P4_CNT_OFF = P4_LG_OFF + 8 * 16 * 48 * 4, P4_BASE_OFF = P4_CNT_OFF + 128;
static_assert(P4_BASE_OFF + 128 <= MISC_OFF, "P4 LDS map");
__device__ __forceinline__ void p4_router(Frame& F) {
    const int lane = F.lane, w = F.wave, tid = F.tid;
    const bf16_t* hb = (const bf16_t*)(F.ws + WS_HB);
    const bf16_t* wr_t = (const bf16_t*)(F.ws + WS_WR_T);
    const float* ssq = (const float*)(F.ws + WS_SSQ);
    int* cntg = (int*)(F.ws + WS_CTL) + CW_CNT;
    int* tl = (int*)(F.ws + WS_TOKLIST); float* rl = (float*)(F.ws + WS_RSLIST);
    LAS unsigned char* lds = F.lds;
    LAS float* lg = (LAS float*)(lds + P4_LG_OFF) + w * 16 * 48;
    LAS int* cl = (LAS int*)(lds + P4_CNT_OFF); LAS int* bl = (LAS int*)(lds + P4_BASE_OFF);
#pragma unroll
    for (int i = 0; i < 12; ++i) { const int pc = tid + 512 * i, row = pc >> 7, ch = pc & 127; *(LAS u32x4*)(lds + P4_W_OFF + row * P4_WROW + ch * 16) = *(const u32x4*)(wr_t + (size_t)row * DM + ch * 8); }
    for (int blk = F.vcu; blk < NTOK / 128; blk += F.G) {
        const int tok0 = blk * 128 + 16 * w;
        if (tid < 32) cl[tid] = 0;
        const bf16_t* ap = hb + (size_t)(tok0 + (lane & 15)) * DM + 8 * (lane >> 4);
        bf16x8 af[32];
#pragma unroll
        for (int s = 0; s < 32; ++s) af[s] = *(const bf16x8*)(ap + 32 * s);
        const f32x4 sq0 = *(const f32x4*)(ssq + (size_t)(tok0 + (lane & 15)) * 16), sq1 = *(const f32x4*)(ssq + (size_t)(tok0 + (lane & 15)) * 16 + 4),
                    sq2 = *(const f32x4*)(ssq + (size_t)(tok0 + (lane & 15)) * 16 + 8), sq3 = *(const f32x4*)(ssq + (size_t)(tok0 + (lane & 15)) * 16 + 12);
        __syncthreads();
        f32x4 acc[3];
#pragma unroll
        for (int c = 0; c < 3; ++c) acc[c] = (f32x4){0.f, 0.f, 0.f, 0.f};
        const LAS unsigned char* bp = lds + P4_W_OFF + (lane & 15) * P4_WROW + 16 * (lane >> 4);
#pragma unroll
        for (int s = 0; s < 32; ++s) {
#pragma unroll
            for (int c = 0; c < 3; ++c) { const bf16x8 b = *(const LAS bf16x8*)(bp + c * 16 * P4_WROW + 64 * s); acc[c] = MFMA16(af[s], b, acc[c]); }
        }
#pragma unroll
        for (int c = 0; c < 3; ++c)
#pragma unroll
            for (int i = 0; i < 4; ++i) lg[(4 * (lane >> 4) + i) * 48 + 16 * c + (lane & 15)] = acc[c][i];
        LDS_WAIT();
        int e1 = 0, e2 = 0, l1 = 0, l2 = 0; float w1 = 0.f, w2 = 0.f, rstd = 0.f;
        if (lane < 16) {
            float s = 0.f;
#pragma unroll
            for (int i = 0; i < 4; ++i) s += sq0[i];
#pragma unroll
            for (int i = 0; i < 4; ++i) s += sq1[i];
#pragma unroll
            for (int i = 0; i < 4; ++i) s += sq2[i];
#pragma unroll
            for (int i = 0; i < 4; ++i) s += sq3[i];
            rstd = rsqrtf(s * (1.f / DM) + RMS_EPS);
            const LAS float* L = lg + lane * 48;
            float gl[4]; int gi = 0;
#pragma unroll
            for (int j = 0; j < 4; ++j) gl[j] = L[j] * rstd + F.in[13][j];
            float gm = gl[0];
#pragma unroll
            for (int j = 1; j < 4; ++j) if (gl[j] > gm) { gm = gl[j]; gi = j; }
            float den = 0.f;
#pragma unroll
            for (int j = 0; j < 4; ++j) den += __expf(gl[j] - gm);
            const float gw = 1.f / den;
            float el[8];
#pragma unroll
            for (int j = 0; j < 8; ++j) el[j] = L[4 + gi * 8 + j] * rstd + F.in[15][gi * 8 + j];
            int i1 = 0; float v1 = el[0];
#pragma unroll
            for (int j = 1; j < 8; ++j) if (el[j] > v1) { v1 = el[j]; i1 = j; }
            int i2 = 0; float v2 = -INFINITY;
#pragma unroll
            for (int j = 0; j < 8; ++j) if (j != i1 && el[j] > v2) { v2 = el[j]; i2 = j; }
            const float a1 = 1.f / (1.f + __expf(v2 - v1));
            w1 = gw * a1; w2 = gw * (1.f - a1); e1 = gi * 8 + i1; e2 = gi * 8 + i2;
            l1 = atomicAdd((int*)(cl + e1), 1); l2 = atomicAdd((int*)(cl + e2), 1);
        }
        __syncthreads();
        if (tid < 32) bl[tid] = atomicAdd(cntg + tid, (int)cl[tid]);
        __syncthreads();
        if (lane < 16) {
            const int tok = tok0 + lane; const int p1 = bl[e1] + l1, p2 = bl[e2] + l2;
            tl[(size_t)e1 * NTOK + p1] = tok; rl[(size_t)e1 * NTOK + p1] = rstd;
            tl[(size_t)e2 * NTOK + p2] = tok; rl[(size_t)e2 * NTOK + p2] = rstd;
            ((int4*)(F.ws + WS_TOKREC))[tok] = make_int4(e1, p1, e2, p2);
            ((float2*)(F.ws + WS_TOKW))[tok] = make_float2(w1, w2);
        }
        __syncthreads();
    }
}

__device__ __forceinline__ int moe_offsets(Frame& F) {
    const int* cnt = (const int*)(F.ws + WS_CTL) + CW_CNT;
    if (F.tid == 0) { int o = 0; for (int e = 0; e < NEXP; ++e) { const int n = __hip_atomic_load(cnt + e, __ATOMIC_RELAXED, __HIP_MEMORY_SCOPE_AGENT); F.MISC[16 + e] = (unsigned)o; F.MISC[16 + 64 + e] = (unsigned)n; o += (n + 255) >> 8; } F.MISC[16 + NEXP] = (unsigned)o; }
    __syncthreads();
    return __builtin_amdgcn_readfirstlane((int)F.MISC[16 + NEXP]);
}

__device__ __forceinline__ void p7_final(Frame& F) {
    const int lane = F.lane; const int gw = F.vcu * NWAVES + F.wave, NGW = F.G * NWAVES;
    const volatile LAS int* toff = (const volatile LAS int*)(F.MISC + 16);
    const float* gf = F.in[19];
    const f32x4 g0a = *(const f32x4*)(gf + 8 * lane), g0b = *(const f32x4*)(gf + 8 * lane + 4), g1a = *(const f32x4*)(gf + 512 + 8 * lane), g1b = *(const f32x4*)(gf + 512 + 8 * lane + 4);
    const bf16_t* HBp = (const bf16_t*)(F.ws + WS_HB); const bf16_t* Yp = (const bf16_t*)(F.ws + WS_Y);
    for (int tok0 = gw * 4; tok0 < NTOK; tok0 += NGW * 4) {
        int4 rec[4]; float2 wt[4];
#pragma unroll
        for (int t = 0; t < 4; ++t) { rec[t] = ((const int4*)(F.ws + WS_TOKREC))[tok0 + t]; wt[t] = ((const float2*)(F.ws + WS_TOKW))[tok0 + t]; }
        u32x4 ra[4][2], rb[4][2], rc[4][2];
#pragma unroll
        for (int t = 0; t < 4; ++t) {
            const int s1 = toff[rec[t].x] * 256 + rec[t].y, s2 = toff[rec[t].z] * 256 + rec[t].w;
            const bf16_t* hb = HBp + (size_t)(tok0 + t) * DM + 8 * lane; const bf16_t* y1 = Yp + (size_t)s1 * DM + 8 * lane; const bf16_t* y2 = Yp + (size_t)s2 * DM + 8 * lane;
#pragma unroll
            for (int j = 0; j < 2; ++j) { ra[t][j] = __builtin_nontemporal_load((const u32x4*)(hb + 512 * j)); rb[t][j] = __builtin_nontemporal_load((const u32x4*)(y1 + 512 * j)); rc[t][j] = __builtin_nontemporal_load((const u32x4*)(y2 + 512 * j)); }
        }
#pragma unroll
        for (int t = 0; t < 4; ++t) {
            float z[16]; float ss = 0.f;
#pragma unroll
            for (int j = 0; j < 2; ++j)
#pragma unroll
                for (int q = 0; q < 4; ++q) {
                    const float lo = __uint_as_float(ra[t][j][q] << 16) + wt[t].x * __uint_as_float(rb[t][j][q] << 16) + wt[t].y * __uint_as_float(rc[t][j][q] << 16);
                    const float hi = __uint_as_float(ra[t][j][q] & 0xffff0000u) + wt[t].x * __uint_as_float(rb[t][j][q] & 0xffff0000u) + wt[t].y * __uint_as_float(rc[t][j][q] & 0xffff0000u);
                    z[8 * j + 2 * q] = lo; z[8 * j + 2 * q + 1] = hi; ss += lo * lo + hi * hi; }
            const float rstd = rsqrtf(wave_sum(ss) * (1.f / DM) + RMS_EPS);
            float* o = F.out + (size_t)(tok0 + t) * DM;
            __builtin_nontemporal_store((f32x4){z[0] * rstd * g0a[0], z[1] * rstd * g0a[1], z[2] * rstd * g0a[2], z[3] * rstd * g0a[3]}, (f32x4*)(o + 8 * lane));
            __builtin_nontemporal_store((f32x4){z[4] * rstd * g0b[0], z[5] * rstd * g0b[1], z[6] * rstd * g0b[2], z[7] * rstd * g0b[3]}, (f32x4*)(o + 8 * lane + 4));
            __builtin_nontemporal_store((f32x4){z[8] * rstd * g1a[0], z[9] * rstd * g1a[1], z[10] * rstd * g1a[2], z[11] * rstd * g1a[3]}, (f32x4*)(o + 512 + 8 * lane));
            __builtin_nontemporal_store((f32x4){z[12] * rstd * g1b[0], z[13] * rstd * g1b[1], z[14] * rstd * g1b[2], z[15] * rstd * g1b[3]}, (f32x4*)(o + 512 + 8 * lane + 4));
        }
    }
}

struct Args { const float* in[20]; float* out; unsigned char* ws; int ph_lo, ph_hi, li, pad; };
constexpr int N_PHASES = 8;
__global__ void __launch_bounds__(NWAVES * 64, 2) mk_fwd(Args args) {
    extern __shared__ __attribute__((aligned(16))) unsigned char lds_raw[];
    Frame F;
    F.lds = (LAS unsigned char*)lds_raw;
    F.MISC = (volatile LAS unsigned*)(F.lds + MISC_OFF);
    F.tid = threadIdx.x; F.lane = F.tid & 63; F.wave = __builtin_amdgcn_readfirstlane(F.tid >> 6);
    F.G = gridDim.x; { const int bx = blockIdx.x; F.vcu = (F.G % 8 == 0) ? (bx % 8) * (F.G / 8) + bx / 8 : bx; }
    F.in = args.in; F.out = args.out; F.ws = args.ws;
    unsigned char* ws = args.ws;
    for (int u = F.tid; u < 256; u += NWAVES * 64) F.MISC[u] = 0u;
    __syncthreads();
    const int lo = args.ph_lo, hi = args.ph_hi;
    XcdBarrier bar; bar.bar = (unsigned*)(ws + WS_CTL) + CW_BAR + args.li * XCD_BAR_WORDS; bar.x = 0; bar.st = nullptr;
    if (hi - lo > 1) bar = xcd_barrier_post((unsigned*)(ws + WS_CTL) + CW_BAR + args.li * XCD_BAR_WORDS, F.MISC + 8);
#define IN(k) (lo <= (k) && (k) < hi)
#define SEAM(k) do { if (IN(k) && IN((k) + 1)) xcd_barrier(bar, &F, (k) < 3 ? (k) : -1); } while (0)
    if (IN(0)) { p0_prologue(F); SEAM(0); }
    if (IN(1)) {
        pg8::Gemm g{(const bf16_t*)(ws + WS_XN), (const bf16_t*)(ws + WS_WIN_T), DM, 0}; pg8::StaticOrder S; S.init(NTOK, NPROJ, DM, F.G, (int)blockIdx.x);
        pg8::EpiBf16G E{(bf16_t*)(ws + WS_PROJ), NPROJ, 3, (f32x2*)(ws + WS_SSQ), 5, 0, (const float*)(ws + WS_RSX)};
        pg8::gemm_phase<pg8::EpiBf16G, pg8::StaticOrder>(F.lds, g, S, E);
        {
            const int nu = (NTOK / 256) * (NPROJ / 256), full = nu % F.G;
            if (full == 0) convert_rest<1>(F, (int)blockIdx.x * NWAVES + F.wave, F.G * NWAVES, 0, 1 << 30);
            else if ((int)blockIdx.x >= full) convert_rest<1>(F, ((int)blockIdx.x - full) * NWAVES + F.wave, (F.G - full) * NWAVES, 0, 1 << 30);
        }
        SEAM(1);
    }
    if (IN(2)) { p2_mix(F, args.pad); SEAM(2); }
    if (IN(3)) {
        pg8::Gemm g{(const bf16_t*)(ws + WS_MIXED), (const bf16_t*)(ws + WS_WO_T), DM, 0}; pg8::StaticOrder S; S.init(NTOK, DM, DM, F.G, (int)blockIdx.x);
        pg8::EpiH E{(const bf16_t*)(ws + WS_XN), (bf16_t*)(ws + WS_HB), (float*)(ws + WS_SSQ)};
        pg8::gemm_phase<pg8::EpiH, pg8::StaticOrder>(F.lds, g, S, E);
        SEAM(3);
    }
    if (IN(4)) { p4_router(F); SEAM(4); }
    if (IN(5) || IN(6) || IN(7)) {
        const int ntiles = moe_offsets(F);
        const volatile LAS int* toff = (const volatile LAS int*)(F.MISC + 16);
        const int* cnt = (const int*)(ws + WS_CTL) + CW_CNT;
        if (IN(5)) {
            pg8::Gemm g{(const bf16_t*)(ws + WS_HB), (const bf16_t*)(ws + WS_WGU_T), DM, 0};
            MoeOrder<true> S{toff, cnt, (const int*)(ws + WS_TOKLIST), 2, ntiles * 2, F.G, (int)blockIdx.x, DM, 512};
            EpiSwiglu E{(bf16_t*)(ws + WS_HID), (const float*)(ws + WS_RSLIST)};
            pg8::gemm_phase<EpiSwiglu, MoeOrder<true>>(F.lds, g, S, E);
            {
                const int nu = ntiles * 2, full = nu % F.G;
                if (full == 0) convert_rest<2>(F, (int)blockIdx.x * NWAVES + F.wave, F.G * NWAVES, 0, 1 << 30);
                else if ((int)blockIdx.x >= full) convert_rest<2>(F, ((int)blockIdx.x - full) * NWAVES + F.wave, (F.G - full) * NWAVES, 0, 1 << 30);
            }
            SEAM(5);
        }
        if (IN(6)) {
            pg8::Gemm g{(const bf16_t*)(ws + WS_HID), (const bf16_t*)(ws + WS_WD_T), DEXP, 0};
            MoeOrder<false> S{toff, cnt, (const int*)(ws + WS_TOKLIST), 4, ntiles * 4, F.G, (int)blockIdx.x, DEXP, DM};
            pg8::EpiBf16G E{(bf16_t*)(ws + WS_Y), DM, 1000, nullptr, 1000, 0, nullptr};
            pg8::gemm_phase<pg8::EpiBf16G, MoeOrder<false>>(F.lds, g, S, E);
            SEAM(6);
        }
        if (IN(7)) p7_final(F);
    }
#undef IN
#undef SEAM
}
extern "C" void kernel_launch(void* const* d_in, const int* in_sizes, int n_in, void* d_out, int out_size, void* d_ws, size_t ws_size, hipStream_t stream) {
    static int grid = 0;
    if (grid == 0) {
        if (n_in != 20 || in_sizes[0] != NTOK * DM || out_size != NTOK * DM || ws_size < WS_END) {
            fprintf(stderr, "kernel_launch: unexpected shapes (n_in %d, in0 %d, out %d, ws %zu)\n", n_in, n_in > 0 ? in_sizes[0] : -1, out_size, ws_size); grid = -1; return; }
        int dev = 0, cus = 0, per_cu = 0;
        if (hipGetDevice(&dev) != hipSuccess || hipDeviceGetAttribute(&cus, hipDeviceAttributeMultiprocessorCount, dev) != hipSuccess) { fprintf(stderr, "kernel_launch: device query failed\n"); grid = -1; return; }
        if (hipFuncSetAttribute((const void*)mk_fwd, hipFuncAttributeMaxDynamicSharedMemorySize, LDS_BYTES) != hipSuccess) { fprintf(stderr, "kernel_launch: hipFuncSetAttribute(%d B LDS) failed\n", LDS_BYTES); grid = -1; return; }
        if (hipOccupancyMaxActiveBlocksPerMultiprocessor(&per_cu, (const void*)mk_fwd, NWAVES * 64, LDS_BYTES) != hipSuccess || per_cu < 1)
            fprintf(stderr, "kernel_launch: note: occupancy query reports %d workgroups per CU\n", per_cu);
        (void)hipGetLastError();
        grid = cus;
    }
    if (grid < 0) return;
    Params p{};
    for (int i = 0; i < 20; ++i) p.in[i] = (const float*)d_in[i];
    p.out = (float*)d_out; p.ws = (unsigned char*)d_ws;
    unsigned char* ws = p.ws;
    (void)hipMemsetAsync(ws + WS_CTL, 0, CTL_ZERO_BYTES, stream);
    const int* cnt = (const int*)(ws + WS_CTL) + CW_CNT;
    Args a{};
    for (int i = 0; i < 20; ++i) a.in[i] = (const float*)d_in[i];
    a.out = (float*)d_out; a.ws = ws;
#ifndef REP_PH
#define REP_PH -1
#endif
    constexpr int rp = REP_PH;
    int li = 0;
#ifdef CUM_PH
    { a.ph_lo = 0; a.ph_hi = CUM_PH; a.li = li++; hipLaunchKernelGGL(mk_fwd, dim3(grid), dim3(NWAVES * 64), LDS_BYTES, stream, a);
      (void)hipMemsetAsync(ws + WS_CTL + CW_CNT * 4, 0, NEXP * 4, stream); }
#endif
    if (rp < 0) { a.ph_lo = 0; a.ph_hi = N_PHASES; a.li = li++; hipLaunchKernelGGL(mk_fwd, dim3(grid), dim3(NWAVES * 64), LDS_BYTES, stream, a); }
    else {
        a.ph_lo = 0; a.ph_hi = rp + 1; a.li = li++; hipLaunchKernelGGL(mk_fwd, dim3(grid), dim3(NWAVES * 64), LDS_BYTES, stream, a);
        if (rp == 4) (void)hipMemsetAsync(ws + WS_CTL + CW_CNT * 4, 0, NEXP * 4, stream);
#ifdef REP_P2
        a.pad = REP_P2;
#endif
#ifdef REP_GRID
        a.ph_lo = rp; a.ph_hi = rp + 1; a.li = li++; hipLaunchKernelGGL(mk_fwd, dim3(REP_GRID), dim3(NWAVES * 64), LDS_BYTES, stream, a);
#else
        a.ph_lo = rp; a.ph_hi = rp + 1; a.li = li++; hipLaunchKernelGGL(mk_fwd, dim3(grid), dim3(NWAVES * 64), LDS_BYTES, stream, a);
#endif
        a.pad = 0;
        if (rp + 1 < N_PHASES) { a.ph_lo = rp + 1; a.ph_hi = N_PHASES; a.li = li++; hipLaunchKernelGGL(mk_fwd, dim3(grid), dim3(NWAVES * 64), LDS_BYTES, stream, a); }
    }
    (void)p; (void)cnt;
}
```

```cpp
#include <hip/hip_runtime.h>
#include <cstdio>
#include <cstdint>
#include <cmath>

constexpr int BATCH = 4, SEQ = 8192, DM = 1024, NTOK = BATCH * SEQ;
constexpr int NPROJ = 1792;
constexpr int C_Q = 0, C_K = 512, C_V = 640, C_GU = 768, C_GV = 1280;
constexpr int NEXP = 32, DEXP = 256, NGRP = 4, EPG = 8;
constexpr int SLOT_CAP = 2 * NTOK + NEXP * 256;
constexpr float RMS_EPS = 1e-6f, LN_EPS = 1e-5f;

typedef unsigned short bf16_t;
__device__ __forceinline__ float bf2f(bf16_t v) { return __uint_as_float((unsigned)v << 16); }
__device__ __forceinline__ bf16_t f2bf(float f) { unsigned u = __float_as_uint(f); return (bf16_t)((u + 0x7fffu + ((u >> 16) & 1u)) >> 16); }

constexpr size_t MiB = 1u << 20;
constexpr size_t WS_CTL = 0, CTL_ZERO_BYTES = 1 * MiB;
constexpr size_t WS_TOKLIST = 58 * MiB;
constexpr size_t WS_RSLIST = 62 * MiB;
constexpr size_t WS_TOKREC = 66 * MiB;
constexpr size_t WS_TOKW = 67 * MiB;
constexpr size_t WS_SSQ = 68 * MiB;
constexpr size_t WS_XN = 72 * MiB;
constexpr size_t WS_PROJ = 136 * MiB;
constexpr size_t WS_MIXED = 248 * MiB;
constexpr size_t WS_HB = 312 * MiB;
constexpr size_t WS_HID = 376 * MiB;
constexpr size_t WS_Y = 72 * MiB;
constexpr size_t WS_AF = 412 * MiB;
constexpr size_t WS_VN = 72 * MiB;
constexpr size_t WS_HF = 376 * MiB;
constexpr size_t WS_END = 512 * MiB;
constexpr int CW_CNT = 64;

struct Params {
    const float* in[20];
    float* out;
    unsigned char* ws;
};

__device__ __forceinline__ float wave_sum(float v) {
#pragma unroll
    for (int o = 1; o < 64; o <<= 1) v += __shfl_xor(v, o);
    return v;
}
__device__ __forceinline__ float gelu_exact(float v) { return 0.5f * v * (1.0f + erff(v * 0.70710678118654752f)); }

#define LAS __attribute__((address_space(3)))
#define GAS __attribute__((address_space(1)))
typedef short bf16x8 __attribute__((ext_vector_type(8)));
typedef short s16x4 __attribute__((ext_vector_type(4)));
typedef float f32x4 __attribute__((ext_vector_type(4)));
typedef float f32x16 __attribute__((ext_vector_type(16)));
typedef float f32x2 __attribute__((ext_vector_type(2)));
typedef unsigned u32x4 __attribute__((ext_vector_type(4)));
typedef unsigned u32x2 __attribute__((ext_vector_type(2)));
typedef GAS unsigned gu32;

constexpr size_t WS_WIN_T = 2 * MiB;
constexpr size_t WS_WO_T = 6 * MiB;
constexpr size_t WS_WSP = 8 * MiB;
constexpr size_t WS_WR_T = 8 * MiB + 512 * 1024;
constexpr size_t WS_RSX = 9 * MiB;
constexpr size_t WS_WGU_T = 10 * MiB;
constexpr size_t WS_WD_T = 42 * MiB;
constexpr int CW_TMO = 0;
constexpr int CW_BAR = 4096;

constexpr int NWAVES = 8;
constexpr int RING_BYTES = 131072;
constexpr int LDS_BYTES = 163840;
constexpr int MISC_OFF = 163840 - 1024;
constexpr float LOG2E = 1.4426950408889634f;

__device__ __forceinline__ unsigned cvt_pk_bf16(float lo, float hi) { unsigned r; asm volatile("v_cvt_pk_bf16_f32 %0, %1, %2" : "=v"(r) : "v"(lo), "v"(hi)); return r; }
#define MFMA32(a, b, c) __builtin_amdgcn_mfma_f32_32x32x16_bf16((a), (b), (c), 0, 0, 0)
#define MFMA16(a, b, c) __builtin_amdgcn_mfma_f32_16x16x32_bf16((a), (b), (c), 0, 0, 0)
typedef short v4i16_t __attribute__((ext_vector_type(4)));
__device__ __forceinline__ s16x4 vtr(const LAS unsigned char* p) { return __builtin_bit_cast(s16x4, __builtin_amdgcn_ds_read_tr16_b64_v4i16((LAS v4i16_t*)p)); }

namespace pg8 {
constexpr int BM = 256, BK = 64, HALF = 128, HTB = HALF * BK * 2, STAGE_BYTES = 8 * HTB, NXCD = 8, WGM = 8;
__host__ __device__ __forceinline__ int lds_byte(int r, int c) { const int st = (r >> 4) * 2 + (c >> 5), rr = r & 15, cc = c & 31, ob = rr * 64 + cc * 2; return st * 1024 + (ob ^ (((ob >> 9) & 1) << 5)); }
__host__ __device__ __forceinline__ void stage_rc(int b, int& R, int& C) { const int st = b / 1024, sb = b % 1024, swz = sb ^ (((sb >> 9) & 1) << 5); R = (st >> 1) * 16 + swz / 64; C = (st & 1) * 32 + (swz % 64) / 2; }
__host__ __device__ __forceinline__ int perm32(int rho) { const int n = rho >> 4, i = rho & 15; return 8 * (i >> 2) + 4 * n + (i & 3); }

struct Unit { int pm, pn, e, pos0, ne, nv; };
struct Gemm { const bf16_t* A; const bf16_t* Bt; int K; int pad; };

__device__ __forceinline__ int xcd_remap(int L, int nwg) { const int q = nwg / NXCD, r = nwg % NXCD, xcd = L % NXCD, off = L / NXCD; return (xcd < r ? xcd * (q + 1) : r * (q + 1) + (xcd - r) * q) + off; }

struct StaticOrder {
    int nM, nN, nwg, G, c, K;
    __device__ void init(int M, int N, int K_, int G_, int c_) { nM = M / BM; nN = N / BM; nwg = nM * nN; G = G_; c = c_; K = K_; }
    __device__ __forceinline__ bool next(int i, Unit& u) const {
        const long L = (long)i * G + c; if (L >= nwg) return false;
        const int wgid = xcd_remap((int)L, nwg);
        const int nig = WGM * nN, gid = wgid / nig, fm = gid * WGM, gsz = (nM - fm) < WGM ? (nM - fm) : WGM;
        u.pm = fm + ((wgid % nig) % gsz); u.pn = (wgid % nig) / gsz; u.e = 0; u.pos0 = 0; u.ne = 0; u.nv = BM; return true;
    }
    __device__ __forceinline__ size_t b_off(const Unit& u) const { return (size_t)u.pn * BM * K; }
    __device__ __forceinline__ int a_row(const Unit& u, int r) const { return u.pm * BM + r; }
};

template <class Epi, class Sched>
__device__ __forceinline__ void gemm_phase(LAS unsigned char* lds, const Gemm g, const Sched& S, const Epi& E) {
    const int tid = threadIdx.x, wid = __builtin_amdgcn_readfirstlane(tid >> 6), lane = tid & 63, wr = wid >> 2, wc = wid & 3, fr = lane & 15, fq = lane >> 4;
    const int K = g.K, nt = K / BK;
    unsigned voffB[2];
#pragma unroll
    for (int i = 0; i < 2; ++i) { int R, C; stage_rc(tid * 16 + i * 8192, R, C); const int Rb = Epi::PERM ? ((R >> 5) * 64 + perm32(R & 31)) : R;
        voffB[i] = (unsigned)(Rb * K + C) * 2u; }
    const size_t kstep = (size_t)(BK * 2);
    const size_t hstep = (size_t)(Epi::PERM ? 32 : HALF) * K * 2;
    const unsigned ldsw = (unsigned)wid * 1024u;
    const int aoff = lds_byte(wr * 64 + fr, fq * 8), boff = lds_byte(wc * 32 + fr, fq * 8);
#define PG8_SA(b, h) (((b) * 2 + (h)) * HTB)
#define PG8_SB(b, h) ((4 + (b) * 2 + (h)) * HTB)
#define PG8_STAGE2(bufoff, gbase, v0, v1) do { \
        __builtin_amdgcn_global_load_lds((const unsigned*)((const char*)(gbase) + (v0)), (LAS unsigned*)(lds + (bufoff) + ldsw), 16, 0, 0); \
        __builtin_amdgcn_global_load_lds((const unsigned*)((const char*)(gbase) + (v1)), (LAS unsigned*)(lds + (bufoff) + ldsw + 8192), 16, 0, 0); } while (0)
#define PG8_STAGEB(bufoff, gbase) PG8_STAGE2(bufoff, gbase, voffB[0], voffB[1])
#define PG8_VOFFA(dst, U) do { _Pragma("unroll") for (int _i = 0; _i < 2; ++_i) { int _R, _C; stage_rc(threadIdx.x * 16 + _i * 8192, _R, _C); _Pragma("unroll") for (int _h = 0; _h < 2; ++_h) \
        dst[_h][_i] = ((unsigned)S.a_row(U, _h * HALF + _R) * (unsigned)K + (unsigned)_C) * 2u; } } while (0)
#define PG8_LDA(dst, b, h) do { _Pragma("unroll") for (int m = 0; m < 4; ++m) _Pragma("unroll") for (int k = 0; k < 2; ++k) dst[m][k] = *(const LAS bf16x8*)(lds + PG8_SA(b, h) + aoff + m * 2048 + k * 1024); } while (0)
#define PG8_LDB(dst, b, h) do { _Pragma("unroll") for (int n = 0; n < 2; ++n) _Pragma("unroll") for (int k = 0; k < 2; ++k) dst[n][k] = *(const LAS bf16x8*)(lds + PG8_SB(b, h) + boff + n * 2048 + k * 1024); } while (0)
#define PG8_MMA(ai, bj, At, Bt) do { if ((ai) * HALF + wr * 64 < cur.nv) { __builtin_amdgcn_s_setprio(1); _Pragma("unroll") for (int m = 0; m < 4; ++m) _Pragma("unroll") for (int n = 0; n < 2; ++n) _Pragma("unroll") for (int k = 0; k < 2; ++k) \
        acc[ai][bj][m][n] = __builtin_amdgcn_mfma_f32_16x16x32_bf16(Bt[n][k], At[m][k], acc[ai][bj][m][n], 0, 0, 0); __builtin_amdgcn_s_setprio(0); } } while (0)
#define PG8_WAIT_V(n) asm volatile("s_waitcnt vmcnt(" #n ")" ::: "memory")
#define PG8_WAIT_L(n) asm volatile("s_waitcnt lgkmcnt(" #n ")" ::: "memory")
#define PG8_BAR __builtin_amdgcn_s_barrier()
#define PG8_SCHED __builtin_amdgcn_sched_barrier(0)
    Unit cur, nxt; int ui = 0;
    if (!S.next(0, cur)) return;
    f32x4 acc[2][2][4][2];
#pragma unroll
    for (int a = 0; a < 2; ++a)
#pragma unroll
        for (int b = 0; b < 2; ++b)
#pragma unroll
            for (int m = 0; m < 4; ++m)
#pragma unroll
                for (int n = 0; n < 2; ++n) acc[a][b][m][n] = (f32x4){0.f, 0.f, 0.f, 0.f};
    bf16x8 At[4][2], B0[2][2], B1[2][2];
    const char* Ab = (const char*)g.A;
    const char* cB = (const char*)(g.Bt + S.b_off(cur));
    unsigned vA[2][2], nvA[2][2];
    PG8_VOFFA(vA, cur);
    PG8_STAGEB(PG8_SB(0, 0), cB); PG8_STAGEB(PG8_SB(0, 1), cB + hstep); PG8_STAGE2(PG8_SA(0, 0), Ab, vA[0][0], vA[0][1]); PG8_STAGE2(PG8_SA(0, 1), Ab, vA[1][0], vA[1][1]);
    if (wr == 1) PG8_BAR;
    PG8_WAIT_V(2); PG8_BAR;
    PG8_STAGEB(PG8_SB(1, 0), cB + kstep); PG8_STAGE2(PG8_SA(1, 0), Ab + kstep, vA[0][0], vA[0][1]); PG8_STAGEB(PG8_SB(1, 1), cB + hstep + kstep);
    PG8_WAIT_V(6); PG8_BAR;
    for (;;) {
        const bool has_next = S.next(ui + 1, nxt);
        const char* nB = cB;
#pragma unroll
        for (int h = 0; h < 2; ++h)
#pragma unroll
            for (int i = 0; i < 2; ++i) nvA[h][i] = vA[h][i];
        if (has_next) { nB = (const char*)(g.Bt + S.b_off(nxt)); PG8_VOFFA(nvA, nxt); }
        for (int t = 0; t < nt; t += 2) {
            const bool last = (t == nt - 2);
            const char* a1 = Ab + (size_t)(t + 1) * kstep;
            const char* a2 = last ? Ab : Ab + (size_t)(t + 2) * kstep; const char* b2 = last ? nB : cB + (size_t)(t + 2) * kstep;
            const char* a3 = a2 + kstep; const char* b3 = b2 + kstep;
            unsigned o00 = vA[0][0], o01 = vA[0][1], o10 = vA[1][0], o11 = vA[1][1];
            if (last) { asm volatile("" : "+v"(nvA[0][0]), "+v"(nvA[0][1]), "+v"(nvA[1][0]), "+v"(nvA[1][1])); o00 = nvA[0][0]; o01 = nvA[0][1]; o10 = nvA[1][0]; o11 = nvA[1][1]; }
            PG8_LDB(B0, 0, 0); PG8_LDB(B1, 0, 1); PG8_SCHED; PG8_LDA(At, 0, 0); PG8_STAGE2(PG8_SA(1, 1), a1, vA[1][0], vA[1][1]);
            PG8_WAIT_V(8); PG8_WAIT_L(0); PG8_BAR; PG8_MMA(0, 0, At, B0); PG8_MMA(0, 1, At, B1); PG8_BAR; PG8_SCHED;
            PG8_LDA(At, 0, 1); PG8_STAGEB(PG8_SB(0, 0), b2); PG8_STAGEB(PG8_SB(0, 1), b2 + hstep); PG8_STAGE2(PG8_SA(0, 0), a2, o00, o01);
            PG8_WAIT_V(8); PG8_WAIT_L(0); PG8_BAR; PG8_MMA(1, 0, At, B0); PG8_MMA(1, 1, At, B1); PG8_BAR; PG8_SCHED;
            PG8_LDB(B0, 1, 0); PG8_LDB(B1, 1, 1); PG8_SCHED; PG8_LDA(At, 1, 0); PG8_STAGE2(PG8_SA(0, 1), a2, o10, o11);
            PG8_WAIT_V(8); PG8_WAIT_L(0); PG8_BAR; PG8_MMA(0, 0, At, B0); PG8_MMA(0, 1, At, B1); PG8_BAR; PG8_SCHED;
            PG8_LDA(At, 1, 1); PG8_STAGEB(PG8_SB(1, 0), b3); PG8_STAGEB(PG8_SB(1, 1), b3 + hstep); PG8_STAGE2(PG8_SA(1, 0), a3, o00, o01);
            PG8_WAIT_V(8); PG8_WAIT_L(0); PG8_BAR; PG8_MMA(1, 0, At, B0); PG8_MMA(1, 1, At, B1); PG8_BAR; PG8_SCHED;
        }
        if (wr == 0) PG8_BAR;
        E(acc, cur, wr, wc, fr, fq);
        if (!has_next) break;
#pragma unroll
        for (int a = 0; a < 2; ++a)
#pragma unroll
            for (int b = 0; b < 2; ++b)
#pragma unroll
                for (int m = 0; m < 4; ++m)
#pragma unroll
                    for (int n = 0; n < 2; ++n) acc[a][b][m][n] = (f32x4){0.f, 0.f, 0.f, 0.f};
        cur = nxt; cB = nB; ++ui;
#pragma unroll
        for (int h = 0; h < 2; ++h)
#pragma unroll
            for (int i = 0; i < 2; ++i) vA[h][i] = nvA[h][i];
        if (wr == 1) PG8_BAR;
    }
    PG8_WAIT_V(0);
    PG8_BAR;
#undef PG8_SA
#undef PG8_SB
#undef PG8_STAGE2
#undef PG8_STAGEB
#undef PG8_VOFFA
#undef PG8_LDA
#undef PG8_LDB
#undef PG8_MMA
#undef PG8_WAIT_V
#undef PG8_WAIT_L
#undef PG8_BAR
#undef PG8_SCHED
}

__device__ __forceinline__ f32x2 gelu_pk(f32x2 v) {
    const f32x2 av = __builtin_elementwise_abs(v), d = av * 0.2316418882f + 1.0f;
    f32x2 t; t.x = __builtin_amdgcn_rcpf(d.x); t.y = __builtin_amdgcn_rcpf(d.y);
    f32x2 q = t * 0.5307027145f + (-0.7265760135f); q = q * t + 0.7107068705f; q = q * t + (-0.142248368f); q = q * t + 0.127414796f; q = q * t;
    const f32x2 s = (v * v) * (-0.72134752044f);
    f32x2 e; e.x = __builtin_amdgcn_exp2f(s.x); e.y = __builtin_amdgcn_exp2f(s.y);
    const f32x2 m = v * (q * e), r = v - m;
    f32x2 o; o.x = v.x < 0.f ? m.x : r.x; o.y = v.y < 0.f ? m.y : r.y; return o;
}

struct EpiBf16G {
    static constexpr bool PERM = true;
    bf16_t* O; int ldc; int gelu_from; f32x2* STAT; int stat_from; int pad; const float* rowscale;
    __device__ __forceinline__ void operator()(const f32x4 (&acc)[2][2][4][2], const Unit& u, int wr, int wc, int fr, int fq) const {
        const int row0 = u.pm * BM + wr * 64 + fr, col0 = u.pn * BM + wc * 64 + 8 * fq, rl0 = wr * 64 + fr;
        const bool act = u.pn >= gelu_from, st = u.pn >= stat_from;
#pragma unroll
        for (int ai = 0; ai < 2; ++ai)
#pragma unroll
            for (int m = 0; m < 4; ++m) { bf16_t* rowp = O + (size_t)(row0 + ai * HALF + m * 16) * ldc + col0; float s1 = 0.f, s2 = 0.f;
                const bool live = rl0 + ai * HALF + m * 16 < u.nv; const float rsc = rowscale ? rowscale[row0 + ai * HALF + m * 16] : 1.f;
#pragma unroll
                for (int bj = 0; bj < 2; ++bj) { f32x4 v0 = acc[ai][bj][m][0] * rsc, v1 = acc[ai][bj][m][1] * rsc;
                    if (act) { f32x2 a = gelu_pk((f32x2){v0[0], v0[1]}), b = gelu_pk((f32x2){v0[2], v0[3]}), c = gelu_pk((f32x2){v1[0], v1[1]}), d = gelu_pk((f32x2){v1[2], v1[3]});
                        v0 = (f32x4){a.x, a.y, b.x, b.y}; v1 = (f32x4){c.x, c.y, d.x, d.y}; }
                    if (st) { s1 += (v0[0] + v0[1]) + (v0[2] + v0[3]) + (v1[0] + v1[1]) + (v1[2] + v1[3]);
                        s2 += (v0[0] * v0[0] + v0[1] * v0[1]) + (v0[2] * v0[2] + v0[3] * v0[3]) + (v1[0] * v1[0] + v1[1] * v1[1]) + (v1[2] * v1[2] + v1[3] * v1[3]); }
                    u32x4 w; w.x = cvt_pk_bf16(v0[0], v0[1]); w.y = cvt_pk_bf16(v0[2], v0[3]); w.z = cvt_pk_bf16(v1[0], v1[1]); w.w = cvt_pk_bf16(v1[2], v1[3]);
                    if (live) *(u32x4*)(rowp + bj * 32) = w; }
                if (st) { s1 += __shfl_xor(s1, 16); s1 += __shfl_xor(s1, 32); s2 += __shfl_xor(s2, 16); s2 += __shfl_xor(s2, 32);
                    if (fq == 0) STAT[(size_t)(row0 + ai * HALF + m * 16) * 8 + (u.pn - stat_from) * 4 + wc] = (f32x2){s1, s2}; } }
    }
};
struct EpiH {
    static constexpr bool PERM = true;
    const bf16_t* x; bf16_t* HB; float* SSQ;
    __device__ __forceinline__ void operator()(const f32x4 (&acc)[2][2][4][2], const Unit& u, int wr, int wc, int fr, int fq) const {
        const int row0 = u.pm * BM + wr * 64 + fr, col0 = u.pn * BM + wc * 64 + 8 * fq;
#pragma unroll
        for (int ai = 0; ai < 2; ++ai)
#pragma unroll
            for (int m = 0; m < 4; ++m) { const int row = row0 + ai * HALF + m * 16; const bf16_t* xr = x + (size_t)row * DM + col0; bf16_t* hr = HB + (size_t)row * DM + col0; float s = 0.f;
#pragma unroll
                for (int bj = 0; bj < 2; ++bj) { const u32x4 xw = *(const u32x4*)(xr + bj * 32);
                    const f32x4 x0 = (f32x4){__uint_as_float(xw.x << 16), __uint_as_float(xw.x & 0xffff0000u), __uint_as_float(xw.y << 16), __uint_as_float(xw.y & 0xffff0000u)}, x1 = (f32x4){__uint_as_float(xw.z << 16), __uint_as_float(xw.z & 0xffff0000u), __uint_as_float(xw.w << 16), __uint_as_float(xw.w & 0xffff0000u)};
                    const f32x4 v0 = acc[ai][bj][m][0] + x0, v1 = acc[ai][bj][m][1] + x1;
                    s += (v0[0] * v0[0] + v0[1] * v0[1]) + (v0[2] * v0[2] + v0[3] * v0[3]) + (v1[0] * v1[0] + v1[1] * v1[1]) + (v1[2] * v1[2] + v1[3] * v1[3]);
                    u32x4 w; w.x = cvt_pk_bf16(v0[0], v0[1]); w.y = cvt_pk_bf16(v0[2], v0[3]); w.z = cvt_pk_bf16(v1[0], v1[1]); w.w = cvt_pk_bf16(v1[2], v1[3]);
                    *(u32x4*)(hr + bj * 32) = w; }
                s += __shfl_xor(s, 16); s += __shfl_xor(s, 32);
                if (fq == 0) SSQ[(size_t)row * 16 + u.pn * 4 + wc] = s; }
    }
};
}

template <bool GATHER>
struct MoeOrder {
    const volatile LAS int* toff;
    const int* cnt; const int* toklist;
    int nN, nwg, G, c, K, rows_per_e;
    __device__ __forceinline__ bool next(int i, pg8::Unit& u) const {
        const long L = (long)i * G + c; if (L >= nwg) return false;
        const int wgid = pg8::xcd_remap((int)L, nwg);
        const int T = wgid / nN; u.pn = wgid % nN; u.pm = T;
        int e = 0;
        for (int j = 1; j < NEXP; ++j) e += (toff[j] <= T) ? 1 : 0;
        e = __builtin_amdgcn_readfirstlane(e);
        u.e = e; u.pos0 = __builtin_amdgcn_readfirstlane((T - toff[e]) * 256); u.ne = __builtin_amdgcn_readfirstlane(toff[64 + e]); { const int left = u.ne - u.pos0; u.nv = left < 256 ? left : 256; } return true;
    }
    __device__ __forceinline__ size_t b_off(const pg8::Unit& u) const { return ((size_t)u.e * rows_per_e + (size_t)u.pn * 256) * K; }
    __device__ __forceinline__ int a_row(const pg8::Unit& u, int r) const {
        if (!GATHER) return u.pm * 256 + r;
        const int pos = u.pos0 + r;
        return pos < u.ne ? toklist[(size_t)u.e * NTOK + pos] : 0;
    }
};
struct EpiSwiglu {
    static constexpr bool PERM = true;
    bf16_t* HID; const float* rslist;
    __device__ __forceinline__ void operator()(const f32x4 (&acc)[2][2][4][2], const pg8::Unit& u, int wr, int wc, int fr, int fq) const {
        const int r0 = wr * 64 + fr, col0 = u.pn * 128 + wc * 32 + 8 * fq; const int pos0 = u.pos0, n_e = u.ne;
#pragma unroll
        for (int ai = 0; ai < 2; ++ai)
#pragma unroll
            for (int m = 0; m < 4; ++m) { const int r = r0 + ai * 128 + m * 16, pos = pos0 + r;
                const float rs = pos < n_e ? rslist[(size_t)u.e * NTOK + pos] : 0.f;
                float o[8];
#pragma unroll
                for (int n = 0; n < 2; ++n)
#pragma unroll
                    for (int j = 0; j < 4; ++j) { const float gt = acc[ai][0][m][n][j] * rs, up = acc[ai][1][m][n][j] * rs;
                        o[4 * n + j] = gt * __builtin_amdgcn_rcpf(1.f + __builtin_amdgcn_exp2f(-gt * LOG2E)) * up; }
                u32x4 w; w.x = cvt_pk_bf16(o[0], o[1]); w.y = cvt_pk_bf16(o[2], o[3]); w.z = cvt_pk_bf16(o[4], o[5]); w.w = cvt_pk_bf16(o[6], o[7]);
                if (r < u.nv || true) *(u32x4*)(HID + (size_t)(u.pm * 256 + r) * DEXP + col0) = w; }
    }
};

#define XB_TMO      128
#define XB_XCNT(j)  (256  + 64 * (j))
#define XB_XSUB(j)  (1280 + 64 * (j))
#define XB_XGEN(j)  (2304 + 64 * (j))
#define XB_TOP      3328
#define XB_TOPGEN   3392
#define XCD_BAR_WORDS 3456
#define XB_SPIN_CAP (1u << 18)
__device__ __forceinline__ unsigned xb_ld(unsigned* p)              { return __hip_atomic_load(p, __ATOMIC_RELAXED, __HIP_MEMORY_SCOPE_AGENT); }
__device__ __forceinline__ unsigned xb_add(unsigned* p, unsigned v) { return __hip_atomic_fetch_add(p, v, __ATOMIC_RELAXED, __HIP_MEMORY_SCOPE_AGENT); }
__device__ __forceinline__ unsigned xb_xcc_id() { return (unsigned)__builtin_amdgcn_s_getreg((3 << 11) | 20) & 0xFu; }
#define XB_SPIN(cond, bar) do { unsigned _sp = 0; while (cond) { __builtin_amdgcn_s_sleep(1); \
    if ((++_sp & 255u) == 0u) { if (xb_ld(&(bar)[XB_TMO])) break; if (_sp > XB_SPIN_CAP) { atomicAdd(&(bar)[XB_TMO], 1u); break; } } } } while (0)
struct XcdBarrier { unsigned* bar; unsigned x; volatile LAS unsigned* st; };
__device__ __forceinline__ XcdBarrier xcd_barrier_post(unsigned* bar, volatile LAS unsigned* st) {
    XcdBarrier b; b.bar = bar; b.x = xb_xcc_id(); b.st = st;
    if (threadIdx.x == 0) (void)xb_add(&bar[XB_XCNT(b.x)], 1u);
    return b;
}
__device__ __forceinline__ void xcd_barrier_complete(unsigned* bar, unsigned x, unsigned& nloc, unsigned& nx) {
    const unsigned G = gridDim.x * gridDim.y * gridDim.z;
    unsigned sum, cnt, mine, sp = 0u;
    for (;;) {
        sum = 0u; cnt = 0u; mine = 0u;
#pragma unroll
        for (unsigned j = 0; j < 16; ++j) { const unsigned c = xb_ld(&bar[XB_XCNT(j)]); sum += c; cnt += (c > 0u) ? 1u : 0u; mine = (j == x) ? c : mine; }
        if (sum == G) break;
        __builtin_amdgcn_s_sleep(1);
        if ((++sp & 255u) == 0u) { if (xb_ld(&bar[XB_TMO])) break; if (sp > XB_SPIN_CAP) { atomicAdd(&bar[XB_TMO], 1u); break; } }
    }
    nloc = mine > 0u ? mine : 1u; nx = cnt > 0u ? cnt : 1u;
}
struct Frame;
template <int WHICH> __device__ __forceinline__ void convert_rest(Frame& F, int part, int nparts, int lo, int hi);
__device__ __forceinline__ void barrier_background(Frame& F, int bg);
__device__ __forceinline__ void xcd_barrier(const XcdBarrier& b, Frame* Fp = nullptr, int bg = -1) {
    asm volatile("s_waitcnt vmcnt(0)" ::: "memory");
    __syncthreads();
    if (bg >= 0 && threadIdx.x >= 64) barrier_background(*Fp, bg);
    if (threadIdx.x == 0) {
        unsigned* bar = b.bar;
        __builtin_amdgcn_s_waitcnt(0);
        unsigned nloc = b.st[0], nx = b.st[1];
        if (nloc == 0u) { xcd_barrier_complete(bar, b.x, nloc, nx); b.st[0] = nloc; b.st[1] = nx; }
        const unsigned old = xb_add(&bar[XB_XSUB(b.x)], 1u);
        const unsigned gen = old / nloc;
        if (old + 1u == (gen + 1u) * nloc) {
            __builtin_amdgcn_fence(__ATOMIC_RELEASE, "agent");
            asm volatile("s_waitcnt vmcnt(0)" ::: "memory");
            const unsigned og = xb_add(&bar[XB_TOP], 1u);
            const unsigned tg = og / nx;
            if (og + 1u == (tg + 1u) * nx) xb_add(&bar[XB_TOPGEN], 1u);
            else XB_SPIN(xb_ld(&bar[XB_TOPGEN]) == tg, bar);
            __builtin_amdgcn_fence(__ATOMIC_ACQUIRE, "agent");
            xb_add(&bar[XB_XGEN(b.x)], 1u);
            asm volatile("s_waitcnt vmcnt(0)" ::: "memory");
        } else {
            XB_SPIN(xb_ld(&bar[XB_XGEN(b.x)]) == gen, bar);
            __builtin_amdgcn_fence(__ATOMIC_ACQUIRE, "agent");
            asm volatile("s_waitcnt vmcnt(0)" ::: "memory");
        }
    }
    __syncthreads();
}

struct Frame {
    LAS unsigned char* lds;
    volatile LAS unsigned* MISC;
    int tid, lane, wave, vcu, G;
    const float* const* in; float* out; unsigned char* ws;
};
#define LDS_WAIT() asm volatile("s_waitcnt lgkmcnt(0)" ::: "memory")

__device__ __forceinline__ void transpose_tile64(const float* W, int ldw, int k0, int n0, bf16_t* WT, int ldt, int rowbase, const float* kscale, int lane, int hi32 = 32) {
    const float* src = W + (size_t)k0 * ldw + n0 + lane;
    float v[64];
#pragma unroll
    for (int k = 0; k < 64; ++k) v[k] = __builtin_nontemporal_load(src + (size_t)k * ldw);
    if (kscale) {
#pragma unroll
        for (int k = 0; k < 64; ++k) v[k] *= kscale[k0 + k];
    }
    bf16_t* dst = WT + (size_t)(rowbase + (lane & 31) + (lane >> 5) * hi32) * ldt + k0;
#pragma unroll
    for (int c = 0; c < 8; ++c) { u32x4 o; o.x = cvt_pk_bf16(v[8 * c], v[8 * c + 1]); o.y = cvt_pk_bf16(v[8 * c + 2], v[8 * c + 3]); o.z = cvt_pk_bf16(v[8 * c + 4], v[8 * c + 5]); o.w = cvt_pk_bf16(v[8 * c + 6], v[8 * c + 7]);
        *(u32x4*)(dst + 8 * c) = o; }
}

__device__ __forceinline__ void p0_prologue(Frame& F) {
    const int gw = F.vcu * NWAVES + F.wave, NGW = F.G * NWAVES, lane = F.lane;
    unsigned char* ws = F.ws;
    for (int it = gw; it < 16 * 28; it += NGW) { const int kb = it / 28, nb = it % 28; transpose_tile64(F.in[2], NPROJ, 64 * kb, 64 * nb, (bf16_t*)(ws + WS_WIN_T), DM, 64 * nb, F.in[1], lane); }
    const int gt = F.vcu * (NWAVES * 64) + F.tid, NGT = F.G * NWAVES * 64;
    for (int i = gt; i < 8 * 128 * 128; i += NGT) { const int c = i & 127, t = (i >> 7) & 127; ((bf16_t*)(ws + WS_WSP))[i] = c <= t ? f2bf(F.in[4][i]) : (bf16_t)0; }
    for (int i = gt; i < 64 * DM; i += NGT) { const int k = i & (DM - 1), c = i >> 10; float v = 0.f;
        if (c < 4) v = F.in[12][k * 4 + c] * F.in[11][k];
        else if (c < 36) { const int g = (c - 4) >> 3, e = (c - 4) & 7; v = F.in[14][((size_t)g * DM + k) * 8 + e] * F.in[11][k]; }
        ((bf16_t*)(ws + WS_WR_T))[i] = f2bf(v); }
    float* rsx = (float*)(ws + WS_RSX);
    for (int row0 = gw * 8; row0 < NTOK; row0 += NGW * 8) {
        f32x4 v[8][4];
#pragma unroll
        for (int rr = 0; rr < 8; ++rr)
#pragma unroll
            for (int j = 0; j < 4; ++j) v[rr][j] = __builtin_nontemporal_load((const f32x4*)(F.in[0] + (size_t)(row0 + rr) * DM + 256 * j + 4 * lane));
#pragma unroll
        for (int rr = 0; rr < 8; ++rr) {
            float s = 0.f;
#pragma unroll
            for (int j = 0; j < 4; ++j) s += (v[rr][j][0] * v[rr][j][0] + v[rr][j][1] * v[rr][j][1]) + (v[rr][j][2] * v[rr][j][2] + v[rr][j][3] * v[rr][j][3]);
            const float rstd = rsqrtf(wave_sum(s) * (1.f / DM) + RMS_EPS);
            if (lane == 0) rsx[row0 + rr] = rstd;
            bf16_t* xn = (bf16_t*)(ws + WS_XN) + (size_t)(row0 + rr) * DM;
#pragma unroll
            for (int j = 0; j < 4; ++j) { u32x2 o; o.x = cvt_pk_bf16(v[rr][j][0], v[rr][j][1]); o.y = cvt_pk_bf16(v[rr][j][2], v[rr][j][3]);
                *(u32x2*)(xn + 256 * j + 4 * lane) = o; }
        }
    }
}
template <int WHICH>
__device__ __forceinline__ void convert_rest(Frame& F, int part, int nparts, int lo, int hi) {
    unsigned char* ws = F.ws; const int lane = F.lane;
    constexpr int T_OUT = 16 * 16, T_GU = NEXP * 64, T_D = NEXP * 64;
    if (WHICH == 0) {
        for (int it = lo + part; it < 2 * T_GU && it < hi; it += nparts) {
            int r = it; const int up = r >= T_GU; if (up) r -= T_GU; const int e = r / 64, q = r % 64, kb = q / 4, nb = q % 4, n0 = 64 * nb;
            const int rowbase = e * 512 + 256 * (n0 >> 7) + 2 * (n0 & 127) + (up ? 32 : 0);
            transpose_tile64(F.in[up ? 17 : 16] + (size_t)e * DM * DEXP, DEXP, 64 * kb, n0, (bf16_t*)(ws + WS_WGU_T), DM, rowbase, F.in[11], lane, 64); }
    } else if (WHICH == 1) {
        for (int it = part; it < T_OUT; it += nparts) { const int kb = it / 16, nb = it % 16; transpose_tile64(F.in[10], DM, 64 * kb, 64 * nb, (bf16_t*)(ws + WS_WO_T), DM, 64 * nb, nullptr, lane); }
    } else {
        for (int it = part; it < T_D; it += nparts) { const int e = it / 64, q = it % 64, kb = q / 16, nb = q % 16;
            transpose_tile64(F.in[18] + (size_t)e * DEXP * DM, DM, 64 * kb, 64 * nb, (bf16_t*)(ws + WS_WD_T), DEXP, e * DM + 64 * nb, nullptr, lane); }
    }
}

__device__ __forceinline__ void barrier_background(Frame& F, int bg) {
    constexpr int NT = 2 * NEXP * 64, PER = (NT + 2) / 3;
    convert_rest<0>(F, F.vcu * (NWAVES - 1) + (F.wave - 1), F.G * (NWAVES - 1), bg * PER, (bg + 1) * PER);
}

constexpr int P2_K_OFF = 0, P2_KROW = 144, P2_KHEAD = 256 * P2_KROW;
constexpr int P2_V_OFF = 2 * P2_KHEAD, P2_VHEAD = 256 * 128;
constexpr int P2_VN_OFF = 0, P2_VNROW = 1088;
constexpr int P2_EXA_OFF = 139264, P2_EXG_OFF = P2_EXA_OFF + 4096;
static_assert(P2_V_OFF + 2 * P2_VHEAD <= P2_EXA_OFF && 128 * P2_VNROW <= P2_EXA_OFF && P2_EXG_OFF + 4096 <= MISC_OFF, "P2 LDS map");

__device__ __forceinline__ void p2_mix(Frame& F, const int skip) {
    const int tid = F.tid, lane = F.lane, w = F.wave;
    const int r = lane & 31, hh = lane >> 5, g4 = lane >> 4, q4 = (lane & 15) >> 2, p4 = lane & 3;
    const bf16_t* proj = (const bf16_t*)(F.ws + WS_PROJ);
    bf16_t* mixed = (bf16_t*)(F.ws + WS_MIXED);
    const bf16_t* wsp = (const bf16_t*)(F.ws + WS_WSP);
    LAS unsigned char* lds = F.lds;
    LAS float* exA = (LAS float*)(lds + P2_EXA_OFF); LAS float* exG = (LAS float*)(lds + P2_EXG_OFF);
    const float sink2 = F.in[3][w] * LOG2E;
    const float SC2 = 0.125f * LOG2E;
    for (int unit = F.vcu; unit < NTOK / 128; unit += F.G) {
        const int t0 = unit * 128; const bool first = (unit & 63) == 0;
        {
            u32x4 kv[8], vv[8];
#pragma unroll
            for (int i = 0; i < 8; ++i) { const int pc = tid + 512 * i, key = pc >> 4, sub = pc & 15;
                kv[i] = (u32x4){0u, 0u, 0u, 0u}; vv[i] = (u32x4){0u, 0u, 0u, 0u};
                if (!(first && key < 128)) { const bf16_t* rowp = proj + (size_t)(t0 - 128 + key) * NPROJ; kv[i] = *(const u32x4*)(rowp + C_K + sub * 8); vv[i] = *(const u32x4*)(rowp + C_V + sub * 8); } }
#pragma unroll
            for (int i = 0; i < 8; ++i) { const int pc = tid + 512 * i, key = pc >> 4, sub = pc & 15, kvh = sub >> 3, piece = sub & 7;
                *(LAS u32x4*)(lds + P2_K_OFF + kvh * P2_KHEAD + key * P2_KROW + piece * 16) = kv[i];
                *(LAS u32x4*)(lds + P2_V_OFF + kvh * P2_VHEAD + key * 128 + ((piece ^ (((key >> 1) & 1) << 2)) * 16)) = vv[i]; }
        }
        if (!(skip & 1)) {
            const int kvh = w >> 2;
            const LAS unsigned char* Kl = lds + P2_K_OFF + kvh * P2_KHEAD;
            const LAS unsigned char* Vl = lds + P2_V_OFF + kvh * P2_VHEAD;
            const int vflip = (q4 >> 1) & 1;
            const int vlane = (4 * hh + q4) * 128 + (g4 & 1) * 32 + p4 * 8;
            const int vh0 = vflip * 64, vh1 = (vflip ^ 1) * 64;
            const bf16_t* qbase = proj + (size_t)(t0 + r) * NPROJ + C_Q + 64 * w + 8 * hh;
            bf16x8 qn[4];
#pragma unroll
            for (int s = 0; s < 4; ++s) qn[s] = __builtin_nontemporal_load((const bf16x8*)(qbase + 16 * s));
            __syncthreads();
            for (int qb = 0; qb < 4; ++qb) {
                bf16x8 qf[4];
#pragma unroll
                for (int s = 0; s < 4; ++s) qf[s] = qn[s];
                if (qb < 3) {
#pragma unroll
                    for (int s = 0; s < 4; ++s) qn[s] = __builtin_nontemporal_load((const bf16x8*)(qbase + (size_t)(32 * (qb + 1)) * NPROJ + 16 * s));
                }
                f32x16 sa[5];
#pragma unroll
                for (int cc = 0; cc < 5; ++cc) {
#pragma unroll
                    for (int i = 0; i < 16; ++i) sa[cc][i] = 0.f;
                    const LAS unsigned char* kp = Kl + (32 * (qb + cc) + r) * P2_KROW + 16 * hh;
#pragma unroll
                    for (int s = 0; s < 4; ++s) { const bf16x8 kf = *(const LAS bf16x8*)(kp + 32 * s); sa[cc] = MFMA32(kf, qf[s], sa[cc]); }
                }
                const int q = 32 * qb + r; float mr = -1e30f;
#pragma unroll
                for (int cc = 0; cc < 5; ++cc)
#pragma unroll
                    for (int i = 0; i < 16; ++i) { const int kb = 32 * (qb + cc) + (i & 3) + 8 * (i >> 2) + 4 * hh;
                        if (cc == 0 || cc == 4 || first) { bool ok = true; if (cc == 0) ok = kb >= q + 1; if (cc == 4) ok = kb <= q + 128; if (first) ok = ok && kb >= 128; sa[cc][i] = ok ? sa[cc][i] : -1e30f; }
                        mr = fmaxf(mr, sa[cc][i]); }
                mr = fmaxf(mr, __shfl_xor(mr, 32));
                const float mx = fmaxf(mr * SC2, sink2);
                float sum = 0.f;
#pragma unroll
                for (int cc = 0; cc < 5; ++cc)
#pragma unroll
                    for (int i = 0; i < 16; ++i) { const float pe = __builtin_amdgcn_exp2f(fmaf(sa[cc][i], SC2, -mx)); sa[cc][i] = pe; sum += pe; }
                sum += __shfl_xor(sum, 32);
                const float inv = 1.f / (sum + __builtin_amdgcn_exp2f(sink2 - mx));
                f32x16 o[2];
#pragma unroll
                for (int i = 0; i < 16; ++i) { o[0][i] = 0.f; o[1][i] = 0.f; }
#pragma unroll
                for (int cc = 0; cc < 5; ++cc)
#pragma unroll
                    for (int s2 = 0; s2 < 2; ++s2) {
                        u32x4 pw; pw.x = cvt_pk_bf16(sa[cc][8 * s2 + 0], sa[cc][8 * s2 + 1]); pw.y = cvt_pk_bf16(sa[cc][8 * s2 + 2], sa[cc][8 * s2 + 3]);
                        pw.z = cvt_pk_bf16(sa[cc][8 * s2 + 4], sa[cc][8 * s2 + 5]); pw.w = cvt_pk_bf16(sa[cc][8 * s2 + 6], sa[cc][8 * s2 + 7]);
                        const bf16x8 pf = __builtin_bit_cast(bf16x8, pw);
                        const LAS unsigned char* vp = Vl + (32 * (qb + cc) + 16 * s2) * 128 + vlane;
#pragma unroll
                        for (int db = 0; db < 2; ++db) { const int vh = db ? vh1 : vh0; const s16x4 a0 = vtr(vp + vh), a1 = vtr(vp + 8 * 128 + vh);
                            const bf16x8 vf = (bf16x8){a0[0], a0[1], a0[2], a0[3], a1[0], a1[1], a1[2], a1[3]};
                            o[db] = MFMA32(vf, pf, o[db]); }
                    }
                float ss = 0.f;
#pragma unroll
                for (int db = 0; db < 2; ++db)
#pragma unroll
                    for (int i = 0; i < 16; ++i) { o[db][i] *= inv; ss += o[db][i] * o[db][i]; }
                ss += __shfl_xor(ss, 32);
                if (hh == 0) exA[(qb * 8 + w) * 32 + r] = ss;
                __syncthreads();
                float tot = 0.f;
#pragma unroll
                for (int j = 0; j < 8; ++j) tot += exA[(qb * 8 + j) * 32 + r];
                const float rstd = rsqrtf(tot * (1.f / 512) + RMS_EPS);
                bf16_t* orow = mixed + (size_t)(t0 + q) * DM + 64 * w + 4 * hh;
                const float* ga = F.in[8] + 64 * w + 4 * hh;
#pragma unroll
                for (int db = 0; db < 2; ++db)
#pragma unroll
                    for (int rg = 0; rg < 4; ++rg) { const f32x4 gg = *(const f32x4*)(ga + 32 * db + 8 * rg);
                        u32x2 ow; ow.x = cvt_pk_bf16(o[db][4 * rg] * rstd * gg[0], o[db][4 * rg + 1] * rstd * gg[1]); ow.y = cvt_pk_bf16(o[db][4 * rg + 2] * rstd * gg[2], o[db][4 * rg + 3] * rstd * gg[3]);
                        *(u32x2*)(orow + 32 * db + 8 * rg) = ow; }
            }
        }
        if (!(skip & 2)) {
            u32x4 raw[16];
#pragma unroll
            for (int i = 0; i < 16; ++i) raw[i] = __builtin_nontemporal_load((const u32x4*)(proj + (size_t)(t0 + 16 * w + i) * NPROJ + C_GV + 8 * lane));
            const f32x4 lg0 = *(const f32x4*)(F.in[6] + 8 * lane), lg1 = *(const f32x4*)(F.in[6] + 8 * lane + 4), lb0 = *(const f32x4*)(F.in[7] + 8 * lane), lb1 = *(const f32x4*)(F.in[7] + 8 * lane + 4);
            LAS f32x2* stat = (LAS f32x2*)(lds + P2_EXG_OFF);
            if (tid < 128) { const f32x4* sp = (const f32x4*)((const float*)(F.ws + WS_SSQ) + (size_t)(t0 + tid) * 16); const f32x4 a = sp[0], b = sp[1], c = sp[2], d = sp[3];
                const float s1 = (a[0] + a[2]) + (b[0] + b[2]) + (c[0] + c[2]) + (d[0] + d[2]), s2 = (a[1] + a[3]) + (b[1] + b[3]) + (c[1] + c[3]) + (d[1] + d[3]);
                const float mu = s1 * (1.f / 512), var = fmaxf(s2 * (1.f / 512) - mu * mu, 0.f); stat[tid] = (f32x2){mu, rsqrtf(var + LN_EPS)}; }
            __syncthreads();
#pragma unroll
            for (int i = 0; i < 16; ++i) { const int tok = 16 * w + i; const f32x2 st = stat[tok]; const float mu = st.x, rstd = st.y;
                float v[8];
                v[0] = __uint_as_float(raw[i].x << 16); v[1] = __uint_as_float(raw[i].x & 0xffff0000u); v[2] = __uint_as_float(raw[i].y << 16); v[3] = __uint_as_float(raw[i].y & 0xffff0000u);
                v[4] = __uint_as_float(raw[i].z << 16); v[5] = __uint_as_float(raw[i].z & 0xffff0000u); v[6] = __uint_as_float(raw[i].w << 16); v[7] = __uint_as_float(raw[i].w & 0xffff0000u);
#pragma unroll
                for (int j = 0; j < 8; ++j) v[j] = (v[j] - mu) * rstd;
                u32x4 ow; ow.x = cvt_pk_bf16(v[0] * lg0[0] + lb0[0], v[1] * lg0[1] + lb0[1]); ow.y = cvt_pk_bf16(v[2] * lg0[2] + lb0[2], v[3] * lg0[3] + lb0[3]);
                ow.z = cvt_pk_bf16(v[4] * lg1[0] + lb1[0], v[5] * lg1[1] + lb1[1]); ow.w = cvt_pk_bf16(v[6] * lg1[2] + lb1[2], v[7] * lg1[3] + lb1[3]);
                *(LAS u32x4*)(lds + P2_VN_OFF + tok * P2_VNROW + lane * 16) = ow; }
        }
        if (!(skip & 4)) {
            const LAS unsigned char* vnl = lds + P2_VN_OFF + (8 * hh + q4) * P2_VNROW + (64 * w + 16 * (g4 & 1) + 4 * p4) * 2;
            const bf16_t* wh = wsp + (size_t)w * 128 * 128 + (size_t)r * 128 + 8 * hh;
            const bf16_t* ub = proj + (size_t)(t0 + r) * NPROJ + C_GU + 64 * w + 4 * hh;
            bf16x8 wf[8]; u32x2 uu[8];
#pragma unroll
            for (int s = 0; s < 2; ++s) wf[s] = *(const bf16x8*)(wh + 16 * s);
#pragma unroll
            for (int j = 0; j < 8; ++j) uu[j] = *(const u32x2*)(ub + 32 * (j >> 2) + 8 * (j & 3));
            __syncthreads();
#pragma unroll
            for (int tb = 0; tb < 4; ++tb) {
                f32x16 acc[2];
#pragma unroll
                for (int i = 0; i < 16; ++i) { acc[0][i] = 0.f; acc[1][i] = 0.f; }
#pragma unroll
                for (int s = 0; s < 2 * tb + 2; ++s) {
#pragma unroll
                    for (int db = 0; db < 2; ++db) { const LAS unsigned char* vp = vnl + (16 * s) * P2_VNROW + db * 64;
                        const s16x4 a0 = vtr(vp), a1 = vtr(vp + 4 * P2_VNROW);
                        const bf16x8 af = (bf16x8){a0[0], a0[1], a0[2], a0[3], a1[0], a1[1], a1[2], a1[3]};
                        acc[db] = MFMA32(af, wf[s], acc[db]); }
                }
                const int t = 32 * tb + r; const float bs = F.in[5][w * 128 + t];
                float ss = 0.f;
#pragma unroll
                for (int db = 0; db < 2; ++db)
#pragma unroll
                    for (int rg = 0; rg < 4; ++rg) { const u32x2 u2 = uu[4 * db + rg];
                        const float u0 = __uint_as_float(u2.x << 16), u1 = __uint_as_float(u2.x & 0xffff0000u), u2f = __uint_as_float(u2.y << 16), u3 = __uint_as_float(u2.y & 0xffff0000u);
                        float a = u0 * (acc[db][4 * rg] + bs), b = u1 * (acc[db][4 * rg + 1] + bs), c = u2f * (acc[db][4 * rg + 2] + bs), d = u3 * (acc[db][4 * rg + 3] + bs);
                        acc[db][4 * rg] = a; acc[db][4 * rg + 1] = b; acc[db][4 * rg + 2] = c; acc[db][4 * rg + 3] = d; ss += (a * a + b * b) + (c * c + d * d); }
                if (tb < 3) {
#pragma unroll
                    for (int s = 0; s < 2 * tb + 4; ++s) wf[s] = *(const bf16x8*)(wh + (size_t)(32 * (tb + 1)) * 128 + 16 * s);
#pragma unroll
                    for (int j = 0; j < 8; ++j) uu[j] = *(const u32x2*)(ub + (size_t)(32 * (tb + 1)) * NPROJ + 32 * (j >> 2) + 8 * (j & 3));
                }
                ss += __shfl_xor(ss, 32);
                if (hh == 0) exG[(tb * 8 + w) * 32 + r] = ss;
                __syncthreads();
                float tot = 0.f;
#pragma unroll
                for (int j = 0; j < 8; ++j) tot += exG[(tb * 8 + j) * 32 + r];
                const float rstd = rsqrtf(tot * (1.f / 512) + RMS_EPS);
                bf16_t* orow = mixed + (size_t)(t0 + t) * DM + 512 + 64 * w + 4 * hh;
                const float* gg_ = F.in[9] + 64 * w + 4 * hh;
#pragma unroll
                for (int db = 0; db < 2; ++db)
#pragma unroll
                    for (int rg = 0; rg < 4; ++rg) { const f32x4 gg = *(const f32x4*)(gg_ + 32 * db + 8 * rg);
                        u32x2 ow; ow.x = cvt_pk_bf16(acc[db][4 * rg] * rstd * gg[0], acc[db][4 * rg + 1] * rstd * gg[1]); ow.y = cvt_pk_bf16(acc[db][4 * rg + 2] * rstd * gg[2], acc[db][4 * rg + 3] * rstd * gg[3]);
                        *(u32x2*)(orow + 32 * db + 8 * rg) = ow; }
            }
        }
        __syncthreads();
    }
}

constexpr int P4_WROW = 2064;
constexpr int P4_W_OFF = 0, P4_LG_OFF = 48 * P4_WROW, P4_CNT_OFF = P4_LG_OFF + 8 * 16 * 48 * 4, P4_BASE_OFF = P4_CNT_OFF + 128;
static_assert(P4_BASE_OFF + 128 <= MISC_OFF, "P4 LDS map");
__device__ __forceinline__ void p4_router(Frame& F) {
    const int lane = F.lane, w = F.wave, tid = F.tid;
    const bf16_t* hb = (const bf16_t*)(F.ws + WS_HB);
    const bf16_t* wr_t = (const bf16_t*)(F.ws + WS_WR_T);
    const float* ssq = (const float*)(F.ws + WS_SSQ);
    int* cntg = (int*)(F.ws + WS_CTL) + CW_CNT;
    int* tl = (int*)(F.ws + WS_TOKLIST); float* rl = (float*)(F.ws + WS_RSLIST);
    LAS unsigned char* lds = F.lds;
    LAS float* lg = (LAS float*)(lds + P4_LG_OFF) + w * 16 * 48;
    LAS int* cl = (LAS int*)(lds + P4_CNT_OFF); LAS int* bl = (LAS int*)(lds + P4_BASE_OFF);
#pragma unroll
    for (int i = 0; i < 12; ++i) { const int pc = tid + 512 * i, row = pc >> 7, ch = pc & 127; *(LAS u32x4*)(lds + P4_W_OFF + row * P4_WROW + ch * 16) = *(const u32x4*)(wr_t + (size_t)row * DM + ch * 8); }
    for (int blk = F.vcu; blk < NTOK / 128; blk += F.G) {
        const int tok0 = blk * 128 + 16 * w;
        if (tid < 32) cl[tid] = 0;
        const bf16_t* ap = hb + (size_t)(tok0 + (lane & 15)) * DM + 8 * (lane >> 4);
        bf16x8 af[32];
#pragma unroll
        for (int s = 0; s < 32; ++s) af[s] = *(const bf16x8*)(ap + 32 * s);
        const f32x4 sq0 = *(const f32x4*)(ssq + (size_t)(tok0 + (lane & 15)) * 16), sq1 = *(const f32x4*)(ssq + (size_t)(tok0 + (lane & 15)) * 16 + 4),
                    sq2 = *(const f32x4*)(ssq + (size_t)(tok0 + (lane & 15)) * 16 + 8), sq3 = *(const f32x4*)(ssq + (size_t)(tok0 + (lane & 15)) * 16 + 12);
        __syncthreads();
        f32x4 acc[3];
#pragma unroll
        for (int c = 0; c < 3; ++c) acc[c] = (f32x4){0.f, 0.f, 0.f, 0.f};
        const LAS unsigned char* bp = lds + P4_W_OFF + (lane & 15) * P4_WROW + 16 * (lane >> 4);
#pragma unroll
        for (int s = 0; s < 32; ++s) {
#pragma unroll
            for (int c = 0; c < 3; ++c) { const bf16x8 b = *(const LAS bf16x8*)(bp + c * 16 * P4_WROW + 64 * s); acc[c] = MFMA16(af[s], b, acc[c]); }
        }
#pragma unroll
        for (int c = 0; c < 3; ++c)
#pragma unroll
            for (int i = 0; i < 4; ++i) lg[(4 * (lane >> 4) + i) * 48 + 16 * c + (lane & 15)] = acc[c][i];
        LDS_WAIT();
        int e1 = 0, e2 = 0, l1 = 0, l2 = 0; float w1 = 0.f, w2 = 0.f, rstd = 0.f;
        if (lane < 16) {
            float s = 0.f;
#pragma unroll
            for (int i = 0; i < 4; ++i) s += sq0[i];
#pragma unroll
            for (int i = 0; i < 4; ++i) s += sq1[i];
#pragma unroll
            for (int i = 0; i < 4; ++i) s += sq2[i];
#pragma unroll
            for (int i = 0; i < 4; ++i) s += sq3[i];
            rstd = rsqrtf(s * (1.f / DM) + RMS_EPS);
            const LAS float* L = lg + lane * 48;
            float gl[4]; int gi = 0;
#pragma unroll
            for (int j = 0; j < 4; ++j) gl[j] = L[j] * rstd + F.in[13][j];
            float gm = gl[0];
#pragma unroll
            for (int j = 1; j < 4; ++j) if (gl[j] > gm) { gm = gl[j]; gi = j; }
            float den = 0.f;
#pragma unroll
            for (int j = 0; j < 4; ++j) den += __expf(gl[j] - gm);
            const float gw = 1.f / den;
            float el[8];
#pragma unroll
            for (int j = 0; j < 8; ++j) el[j] = L[4 + gi * 8 + j] * rstd + F.in[15][gi * 8 + j];
            int i1 = 0; float v1 = el[0];
#pragma unroll
            for (int j = 1; j < 8; ++j) if (el[j] > v1) { v1 = el[j]; i1 = j; }
            int i2 = 0; float v2 = -INFINITY;
#pragma unroll
            for (int j = 0; j < 8; ++j) if (j != i1 && el[j] > v2) { v2 = el[j]; i2 = j; }
            const float a1 = 1.f / (1.f + __expf(v2 - v1));
            w1 = gw * a1; w2 = gw * (1.f - a1); e1 = gi * 8 + i1; e2 = gi * 8 + i2;
            l1 = atomicAdd((int*)(cl + e1), 1); l2 = atomicAdd((int*)(cl + e2), 1);
        }
        __syncthreads();
        if (tid < 32) bl[tid] = atomicAdd(cntg + tid, (int)cl[tid]);
        __syncthreads();
        if (lane < 16) {
            const int tok = tok0 + lane; const int p1 = bl[e1] + l1, p2 = bl[e2] + l2;
            tl[(size_t)e1 * NTOK + p1] = tok; rl[(size_t)e1 * NTOK + p1] = rstd;
            tl[(size_t)e2 * NTOK + p2] = tok; rl[(size_t)e2 * NTOK + p2] = rstd;
            ((int4*)(F.ws + WS_TOKREC))[tok] = make_int4(e1, p1, e2, p2);
            ((float2*)(F.ws + WS_TOKW))[tok] = make_float2(w1, w2);
        }
        __syncthreads();
    }
}

__device__ __forceinline__ int moe_offsets(Frame& F) {
    const int* cnt = (const int*)(F.ws + WS_CTL) + CW_CNT;
    if (F.tid == 0) { int o = 0; for (int e = 0; e < NEXP; ++e) { const int n = __hip_atomic_load(cnt + e, __ATOMIC_RELAXED, __HIP_MEMORY_SCOPE_AGENT); F.MISC[16 + e] = (unsigned)o; F.MISC[16 + 64 + e] = (unsigned)n; o += (n + 255) >> 8; } F.MISC[16 + NEXP] = (unsigned)o; }
    __syncthreads();
    return __builtin_amdgcn_readfirstlane((int)F.MISC[16 + NEXP]);
}

__device__ __forceinline__ void p7_final(Frame& F) {
    const int lane = F.lane; const int gw = F.vcu * NWAVES + F.wave, NGW = F.G * NWAVES;
    const volatile LAS int* toff = (const volatile LAS int*)(F.MISC + 16);
    const float* gf = F.in[19];
    const f32x4 g0a = *(const f32x4*)(gf + 8 * lane), g0b = *(const f32x4*)(gf + 8 * lane + 4), g1a = *(const f32x4*)(gf + 512 + 8 * lane), g1b = *(const f32x4*)(gf + 512 + 8 * lane + 4);
    const bf16_t* HBp = (const bf16_t*)(F.ws + WS_HB); const bf16_t* Yp = (const bf16_t*)(F.ws + WS_Y);
    for (int tok0 = gw * 4; tok0 < NTOK; tok0 += NGW * 4) {
        int4 rec[4]; float2 wt[4];
#pragma unroll
        for (int t = 0; t < 4; ++t) { rec[t] = ((const int4*)(F.ws + WS_TOKREC))[tok0 + t]; wt[t] = ((const float2*)(F.ws + WS_TOKW))[tok0 + t]; }
        u32x4 ra[4][2], rb[4][2], rc[4][2];
#pragma unroll
        for (int t = 0; t < 4; ++t) {
            const int s1 = toff[rec[t].x] * 256 + rec[t].y, s2 = toff[rec[t].z] * 256 + rec[t].w;
            const bf16_t* hb = HBp + (size_t)(tok0 + t) * DM + 8 * lane; const bf16_t* y1 = Yp + (size_t)s1 * DM + 8 * lane; const bf16_t* y2 = Yp + (size_t)s2 * DM + 8 * lane;
#pragma unroll
            for (int j = 0; j < 2; ++j) { ra[t][j] = __builtin_nontemporal_load((const u32x4*)(hb + 512 * j)); rb[t][j] = __builtin_nontemporal_load((const u32x4*)(y1 + 512 * j)); rc[t][j] = __builtin_nontemporal_load((const u32x4*)(y2 + 512 * j)); }
        }
#pragma unroll
        for (int t = 0; t < 4; ++t) {
            float z[16]; float ss = 0.f;
#pragma unroll
            for (int j = 0; j < 2; ++j)
#pragma unroll
                for (int q = 0; q < 4; ++q) {
                    const float lo = __uint_as_float(ra[t][j][q] << 16) + wt[t].x * __uint_as_float(rb[t][j][q] << 16) + wt[t].y * __uint_as_float(rc[t][j][q] << 16);
                    const float hi = __uint_as_float(ra[t][j][q] & 0xffff0000u) + wt[t].x * __uint_as_float(rb[t][j][q] & 0xffff0000u) + wt[t].y * __uint_as_float(rc[t][j][q] & 0xffff0000u);
                    z[8 * j + 2 * q] = lo; z[8 * j + 2 * q + 1] = hi; ss += lo * lo + hi * hi; }
            const float rstd = rsqrtf(wave_sum(ss) * (1.f / DM) + RMS_EPS);
            float* o = F.out + (size_t)(tok0 + t) * DM;
            __builtin_nontemporal_store((f32x4){z[0] * rstd * g0a[0], z[1] * rstd * g0a[1], z[2] * rstd * g0a[2], z[3] * rstd * g0a[3]}, (f32x4*)(o + 8 * lane));
            __builtin_nontemporal_store((f32x4){z[4] * rstd * g0b[0], z[5] * rstd * g0b[1], z[6] * rstd * g0b[2], z[7] * rstd * g0b[3]}, (f32x4*)(o + 8 * lane + 4));
            __builtin_nontemporal_store((f32x4){z[8] * rstd * g1a[0], z[9] * rstd * g1a[1], z[10] * rstd * g1a[2], z[11] * rstd * g1a[3]}, (f32x4*)(o + 512 + 8 * lane));
            __builtin_nontemporal_store((f32x4){z[12] * rstd * g1b[0], z[13] * rstd * g1b[1], z[14] * rstd * g1b[2], z[15] * rstd * g1b[3]}, (f32x4*)(o + 512 + 8 * lane + 4));
        }
    }
}

struct Args { const float* in[20]; float* out; unsigned char* ws; int ph_lo, ph_hi, li, pad; };
constexpr int N_PHASES = 8;
__global__ void __launch_bounds__(NWAVES * 64, 2) mk_fwd(Args args) {
    extern __shared__ __attribute__((aligned(16))) unsigned char lds_raw[];
    Frame F;
    F.lds = (LAS unsigned char*)lds_raw;
    F.MISC = (volatile LAS unsigned*)(F.lds + MISC_OFF);
    F.tid = threadIdx.x; F.lane = F.tid & 63; F.wave = __builtin_amdgcn_readfirstlane(F.tid >> 6);
    F.G = gridDim.x; { const int bx = blockIdx.x; F.vcu = (F.G % 8 == 0) ? (bx % 8) * (F.G / 8) + bx / 8 : bx; }
    F.in = args.in; F.out = args.out; F.ws = args.ws;
    unsigned char* ws = args.ws;
    for (int u = F.tid; u < 256; u += NWAVES * 64) F.MISC[u] = 0u;
    __syncthreads();
    const int lo = args.ph_lo, hi = args.ph_hi;
    XcdBarrier bar; bar.bar = (unsigned*)(ws + WS_CTL) + CW_BAR + args.li * XCD_BAR_WORDS; bar.x = 0; bar.st = nullptr;
    if (hi - lo > 1) bar = xcd_barrier_post((unsigned*)(ws + WS_CTL) + CW_BAR + args.li * XCD_BAR_WORDS, F.MISC + 8);
#define IN(k) (lo <= (k) && (k) < hi)
#define SEAM(k) do { if (IN(k) && IN((k) + 1)) xcd_barrier(bar, &F, (k) < 3 ? (k) : -1); } while (0)
    if (IN(0)) { p0_prologue(F); SEAM(0); }
    if (IN(1)) {
        pg8::Gemm g{(const bf16_t*)(ws + WS_XN), (const bf16_t*)(ws + WS_WIN_T), DM, 0}; pg8::StaticOrder S; S.init(NTOK, NPROJ, DM, F.G, (int)blockIdx.x);
        pg8::EpiBf16G E{(bf16_t*)(ws + WS_PROJ), NPROJ, 3, (f32x2*)(ws + WS_SSQ), 5, 0, (const float*)(ws + WS_RSX)};
        pg8::gemm_phase<pg8::EpiBf16G, pg8::StaticOrder>(F.lds, g, S, E);
        {
            const int nu = (NTOK / 256) * (NPROJ / 256), full = nu % F.G;
            if (full == 0) convert_rest<1>(F, (int)blockIdx.x * NWAVES + F.wave, F.G * NWAVES, 0, 1 << 30);
            else if ((int)blockIdx.x >= full) convert_rest<1>(F, ((int)blockIdx.x - full) * NWAVES + F.wave, (F.G - full) * NWAVES, 0, 1 << 30);
        }
        SEAM(1);
    }
    if (IN(2)) { p2_mix(F, args.pad); SEAM(2); }
    if (IN(3)) {
        pg8::Gemm g{(const bf16_t*)(ws + WS_MIXED), (const bf16_t*)(ws + WS_WO_T), DM, 0}; pg8::StaticOrder S; S.init(NTOK, DM, DM, F.G, (int)blockIdx.x);
        pg8::EpiH E{(const bf16_t*)(ws + WS_XN), (bf16_t*)(ws + WS_HB), (float*)(ws + WS_SSQ)};
        pg8::gemm_phase<pg8::EpiH, pg8::StaticOrder>(F.lds, g, S, E);
        SEAM(3);
    }
    if (IN(4)) { p4_router(F); SEAM(4); }
    if (IN(5) || IN(6) || IN(7)) {
        const int ntiles = moe_offsets(F);
        const volatile LAS int* toff = (const volatile LAS int*)(F.MISC + 16);
        const int* cnt = (const int*)(ws + WS_CTL) + CW_CNT;
        if (IN(5)) {
            pg8::Gemm g{(const bf16_t*)(ws + WS_HB), (const bf16_t*)(ws + WS_WGU_T), DM, 0};
            MoeOrder<true> S{toff, cnt, (const int*)(ws + WS_TOKLIST), 2, ntiles * 2, F.G, (int)blockIdx.x, DM, 512};
            EpiSwiglu E{(bf16_t*)(ws + WS_HID), (const float*)(ws + WS_RSLIST)};
            pg8::gemm_phase<EpiSwiglu, MoeOrder<true>>(F.lds, g, S, E);
            {
                const int nu = ntiles * 2, full = nu % F.G;
                if (full == 0) convert_rest<2>(F, (int)blockIdx.x * NWAVES + F.wave, F.G * NWAVES, 0, 1 << 30);
                else if ((int)blockIdx.x >= full) convert_rest<2>(F, ((int)blockIdx.x - full) * NWAVES + F.wave, (F.G - full) * NWAVES, 0, 1 << 30);
            }
            SEAM(5);
        }
        if (IN(6)) {
            pg8::Gemm g{(const bf16_t*)(ws + WS_HID), (const bf16_t*)(ws + WS_WD_T), DEXP, 0};
            MoeOrder<false> S{toff, cnt, (const int*)(ws + WS_TOKLIST), 4, ntiles * 4, F.G, (int)blockIdx.x, DEXP, DM};
            pg8::EpiBf16G E{(bf16_t*)(ws + WS_Y), DM, 1000, nullptr, 1000, 0, nullptr};
            pg8::gemm_phase<pg8::EpiBf16G, MoeOrder<false>>(F.lds, g, S, E);
            SEAM(6);
        }
        if (IN(7)) p7_final(F);
    }
#undef IN
#undef SEAM
}
extern "C" void kernel_launch(void* const* d_in, const int* in_sizes, int n_in, void* d_out, int out_size, void* d_ws, size_t ws_size, hipStream_t stream) {
    static int grid = 0;
    if (grid == 0) {
        if (n_in != 20 || in_sizes[0] != NTOK * DM || out_size != NTOK * DM || ws_size < WS_END) {
            fprintf(stderr, "kernel_launch: unexpected shapes (n_in %d, in0 %d, out %d, ws %zu)\n", n_in, n_in > 0 ? in_sizes[0] : -1, out_size, ws_size); grid = -1; return; }
        int dev = 0, cus = 0, per_cu = 0;
        if (hipGetDevice(&dev) != hipSuccess || hipDeviceGetAttribute(&cus, hipDeviceAttributeMultiprocessorCount, dev) != hipSuccess) { fprintf(stderr, "kernel_launch: device query failed\n"); grid = -1; return; }
        if (hipFuncSetAttribute((const void*)mk_fwd, hipFuncAttributeMaxDynamicSharedMemorySize, LDS_BYTES) != hipSuccess) { fprintf(stderr, "kernel_launch: hipFuncSetAttribute(%d B LDS) failed\n", LDS_BYTES); grid = -1; return; }
        if (hipOccupancyMaxActiveBlocksPerMultiprocessor(&per_cu, (const void*)mk_fwd, NWAVES * 64, LDS_BYTES) != hipSuccess || per_cu < 1)
            fprintf(stderr, "kernel_launch: note: occupancy query reports %d workgroups per CU\n", per_cu);
        (void)hipGetLastError();
        grid = cus;
    }
    if (grid < 0) return;
    Params p{};
    for (int i = 0; i < 20; ++i) p.in[i] = (const float*)d_in[i];
    p.out = (float*)d_out; p.ws = (unsigned char*)d_ws;
    unsigned char* ws = p.ws;
    (void)hipMemsetAsync(ws + WS_CTL, 0, CTL_ZERO_BYTES, stream);
    const int* cnt = (const int*)(ws + WS_CTL) + CW_CNT;
    Args a{};
    for (int i = 0; i < 20; ++i) a.in[i] = (const float*)d_in[i];
    a.out = (float*)d_out; a.ws = ws;
#ifndef REP_PH
#define REP_PH -1
#endif
    constexpr int rp = REP_PH;
    int li = 0;
#ifdef CUM_PH
    { a.ph_lo = 0; a.ph_hi = CUM_PH; a.li = li++; hipLaunchKernelGGL(mk_fwd, dim3(grid), dim3(NWAVES * 64), LDS_BYTES, stream, a);
      (void)hipMemsetAsync(ws + WS_CTL + CW_CNT * 4, 0, NEXP * 4, stream); }
#endif
    if (rp < 0) { a.ph_lo = 0; a.ph_hi = N_PHASES; a.li = li++; hipLaunchKernelGGL(mk_fwd, dim3(grid), dim3(NWAVES * 64), LDS_BYTES, stream, a); }
    else {
        a.ph_lo = 0; a.ph_hi = rp + 1; a.li = li++; hipLaunchKernelGGL(mk_fwd, dim3(grid), dim3(NWAVES * 64), LDS_BYTES, stream, a);
        if (rp == 4) (void)hipMemsetAsync(ws + WS_CTL + CW_CNT * 4, 0, NEXP * 4, stream);
#ifdef REP_P2
        a.pad = REP_P2;
#endif
#ifdef REP_GRID
        a.ph_lo = rp; a.ph_hi = rp + 1; a.li = li++; hipLaunchKernelGGL(mk_fwd, dim3(REP_GRID), dim3(NWAVES * 64), LDS_BYTES, stream, a);
#else
        a.ph_lo = rp; a.ph_hi = rp + 1; a.li = li++; hipLaunchKernelGGL(mk_fwd, dim3(grid), dim3(NWAVES * 64), LDS_BYTES, stream, a);
#endif
        a.pad = 0;
        if (rp + 1 < N_PHASES) { a.ph_lo = rp + 1; a.ph_hi = N_PHASES; a.li = li++; hipLaunchKernelGGL(mk_fwd, dim3(grid), dim3(NWAVES * 64), LDS_BYTES, stream, a); }
    }
    (void)p; (void)cnt;
}
```

```cpp
#include <hip/hip_runtime.h>
#include <cstdio>
#include <cstdint>
#include <cmath>

constexpr int BATCH = 4, SEQ = 8192, DM = 1024, NTOK = BATCH * SEQ;
constexpr int NPROJ = 1792;
constexpr int C_Q = 0, C_K = 512, C_V = 640, C_GU = 768, C_GV = 1280;
constexpr int NEXP = 32, DEXP = 256, NGRP = 4, EPG = 8;
constexpr int SLOT_CAP = 2 * NTOK + NEXP * 256;
constexpr float RMS_EPS = 1e-6f, LN_EPS = 1e-5f;

typedef unsigned short bf16_t;
__device__ __forceinline__ float bf2f(bf16_t v) { return __uint_as_float((unsigned)v << 16); }
__device__ __forceinline__ bf16_t f2bf(float f) { unsigned u = __float_as_uint(f); return (bf16_t)((u + 0x7fffu + ((u >> 16) & 1u)) >> 16); }

constexpr size_t MiB = 1u << 20;
constexpr size_t WS_CTL = 0, CTL_ZERO_BYTES = 1 * MiB;
constexpr size_t WS_TOKLIST = 58 * MiB;
constexpr size_t WS_RSLIST = 62 * MiB;
constexpr size_t WS_TOKREC = 66 * MiB;
constexpr size_t WS_TOKW = 67 * MiB;
constexpr size_t WS_SSQ = 68 * MiB;
constexpr size_t WS_XN = 72 * MiB;
constexpr size_t WS_PROJ = 136 * MiB;
constexpr size_t WS_MIXED = 248 * MiB;
constexpr size_t WS_HB = 312 * MiB;
constexpr size_t WS_HID = 376 * MiB;
constexpr size_t WS_Y = 72 * MiB;
constexpr size_t WS_AF = 412 * MiB;
constexpr size_t WS_VN = 72 * MiB;
constexpr size_t WS_HF = 376 * MiB;
constexpr size_t WS_END = 512 * MiB;
constexpr int CW_CNT = 64;

struct Params {
    const float* in[20];
    float* out;
    unsigned char* ws;
};

__device__ __forceinline__ float wave_sum(float v) {
#pragma unroll
    for (int o = 1; o < 64; o <<= 1) v += __shfl_xor(v, o);
    return v;
}
__device__ __forceinline__ float gelu_exact(float v) { return 0.5f * v * (1.0f + erff(v * 0.70710678118654752f)); }

#define LAS __attribute__((address_space(3)))
#define GAS __attribute__((address_space(1)))
typedef short bf16x8 __attribute__((ext_vector_type(8)));
typedef short s16x4 __attribute__((ext_vector_type(4)));
typedef float f32x4 __attribute__((ext_vector_type(4)));
typedef float f32x16 __attribute__((ext_vector_type(16)));
typedef float f32x2 __attribute__((ext_vector_type(2)));
typedef unsigned u32x4 __attribute__((ext_vector_type(4)));
typedef unsigned u32x2 __attribute__((ext_vector_type(2)));
typedef GAS unsigned gu32;

constexpr size_t WS_WIN_T = 2 * MiB;
constexpr size_t WS_WO_T = 6 * MiB;
constexpr size_t WS_WSP = 8 * MiB;
constexpr size_t WS_WR_T = 8 * MiB + 512 * 1024;
constexpr size_t WS_SSQM = 70 * MiB;
constexpr size_t WS_RSX = 9 * MiB;
constexpr size_t WS_WGU_T = 10 * MiB;
constexpr size_t WS_WD_T = 42 * MiB;
constexpr int CW_TMO = 0;
constexpr int CW_BAR = 4096;

constexpr int NWAVES = 8;
constexpr int RING_BYTES = 131072;
constexpr int LDS_BYTES = 163840;
constexpr int MISC_OFF = 163840 - 1024;
constexpr float LOG2E = 1.4426950408889634f;

__device__ __forceinline__ unsigned cvt_pk_bf16(float lo, float hi) { unsigned r; asm volatile("v_cvt_pk_bf16_f32 %0, %1, %2" : "=v"(r) : "v"(lo), "v"(hi)); return r; }
#define MFMA32(a, b, c) __builtin_amdgcn_mfma_f32_32x32x16_bf16((a), (b), (c), 0, 0, 0)
#define MFMA16(a, b, c) __builtin_amdgcn_mfma_f32_16x16x32_bf16((a), (b), (c), 0, 0, 0)
typedef short v4i16_t __attribute__((ext_vector_type(4)));
__device__ __forceinline__ s16x4 vtr(const LAS unsigned char* p) { return __builtin_bit_cast(s16x4, __builtin_amdgcn_ds_read_tr16_b64_v4i16((LAS v4i16_t*)p)); }

namespace pg8 {
constexpr int BM = 256, BK = 64, HALF = 128, HTB = HALF * BK * 2, STAGE_BYTES = 8 * HTB, NXCD = 8, WGM = 8;
__host__ __device__ __forceinline__ int lds_byte(int r, int c) { const int st = (r >> 4) * 2 + (c >> 5), rr = r & 15, cc = c & 31, ob = rr * 64 + cc * 2; return st * 1024 + (ob ^ (((ob >> 9) & 1) << 5)); }
__host__ __device__ __forceinline__ void stage_rc(int b, int& R, int& C) { const int st = b / 1024, sb = b % 1024, swz = sb ^ (((sb >> 9) & 1) << 5); R = (st >> 1) * 16 + swz / 64; C = (st & 1) * 32 + (swz % 64) / 2; }
__host__ __device__ __forceinline__ int perm32(int rho) { const int n = rho >> 4, i = rho & 15; return 8 * (i >> 2) + 4 * n + (i & 3); }

struct Unit { int pm, pn, e, pos0, ne, nv; };
struct Gemm { const bf16_t* A; const bf16_t* Bt; int K; int pad; };

__device__ __forceinline__ int xcd_remap(int L, int nwg) { const int q = nwg / NXCD, r = nwg % NXCD, xcd = L % NXCD, off = L / NXCD; return (xcd < r ? xcd * (q + 1) : r * (q + 1) + (xcd - r) * q) + off; }

struct StaticOrder {
    int nM, nN, nwg, G, c, K;
    __device__ void init(int M, int N, int K_, int G_, int c_) { nM = M / BM; nN = N / BM; nwg = nM * nN; G = G_; c = c_; K = K_; }
    __device__ __forceinline__ bool next(int i, Unit& u) const {
        const long L = (long)i * G + c; if (L >= nwg) return false;
        const int wgid = xcd_remap((int)L, nwg);
        const int nig = WGM * nN, gid = wgid / nig, fm = gid * WGM, gsz = (nM - fm) < WGM ? (nM - fm) : WGM;
        u.pm = fm + ((wgid % nig) % gsz); u.pn = (wgid % nig) / gsz; u.e = 0; u.pos0 = 0; u.ne = 0; u.nv = BM; return true;
    }
    __device__ __forceinline__ size_t b_off(const Unit& u) const { return (size_t)u.pn * BM * K; }
    __device__ __forceinline__ int a_row(const Unit& u, int r) const { return u.pm * BM + r; }
};

template <class Epi, class Sched>
__device__ __forceinline__ void gemm_phase(LAS unsigned char* lds, const Gemm g, const Sched& S, const Epi& E) {
    const int tid = threadIdx.x, wid = __builtin_amdgcn_readfirstlane(tid >> 6), lane = tid & 63, wr = wid >> 2, wc = wid & 3, fr = lane & 15, fq = lane >> 4;
    const int K = g.K, nt = K / BK;
    unsigned voffB[2];
#pragma unroll
    for (int i = 0; i < 2; ++i) { int R, C; stage_rc(tid * 16 + i * 8192, R, C); const int Rb = Epi::PERM ? ((R >> 5) * 64 + perm32(R & 31)) : R;
        voffB[i] = (unsigned)(Rb * K + C) * 2u; }
    const size_t kstep = (size_t)(BK * 2);
    const size_t hstep = (size_t)(Epi::PERM ? 32 : HALF) * K * 2;
    const unsigned ldsw = (unsigned)wid * 1024u;
    const int aoff = lds_byte(wr * 64 + fr, fq * 8), boff = lds_byte(wc * 32 + fr, fq * 8);
#define PG8_SA(b, h) (((b) * 2 + (h)) * HTB)
#define PG8_SB(b, h) ((4 + (b) * 2 + (h)) * HTB)
#define PG8_STAGE2(bufoff, gbase, v0, v1) do { \
        __builtin_amdgcn_global_load_lds((const unsigned*)((const char*)(gbase) + (v0)), (LAS unsigned*)(lds + (bufoff) + ldsw), 16, 0, 0); \
        __builtin_amdgcn_global_load_lds((const unsigned*)((const char*)(gbase) + (v1)), (LAS unsigned*)(lds + (bufoff) + ldsw + 8192), 16, 0, 0); } while (0)
#define PG8_STAGEB(bufoff, gbase) PG8_STAGE2(bufoff, gbase, voffB[0], voffB[1])
#define PG8_VOFFA(dst, U) do { _Pragma("unroll") for (int _i = 0; _i < 2; ++_i) { int _R, _C; stage_rc(threadIdx.x * 16 + _i * 8192, _R, _C); _Pragma("unroll") for (int _h = 0; _h < 2; ++_h) \
        dst[_h][_i] = ((unsigned)S.a_row(U, _h * HALF + _R) * (unsigned)K + (unsigned)_C) * 2u; } } while (0)
#define PG8_LDA(dst, b, h) do { _Pragma("unroll") for (int m = 0; m < 4; ++m) _Pragma("unroll") for (int k = 0; k < 2; ++k) dst[m][k] = *(const LAS bf16x8*)(lds + PG8_SA(b, h) + aoff + m * 2048 + k * 1024); } while (0)
#define PG8_LDB(dst, b, h) do { _Pragma("unroll") for (int n = 0; n < 2; ++n) _Pragma("unroll") for (int k = 0; k < 2; ++k) dst[n][k] = *(const LAS bf16x8*)(lds + PG8_SB(b, h) + boff + n * 2048 + k * 1024); } while (0)
#define PG8_MMA(ai, bj, At, Bt) do { if ((ai) * HALF + wr * 64 < cur.nv) { __builtin_amdgcn_s_setprio(1); _Pragma("unroll") for (int m = 0; m < 4; ++m) _Pragma("unroll") for (int n = 0; n < 2; ++n) _Pragma("unroll") for (int k = 0; k < 2; ++k) \
        acc[ai][bj][m][n] = __builtin_amdgcn_mfma_f32_16x16x32_bf16(Bt[n][k], At[m][k], acc[ai][bj][m][n], 0, 0, 0); __builtin_amdgcn_s_setprio(0); } } while (0)
#define PG8_WAIT_V(n) asm volatile("s_waitcnt vmcnt(" #n ")" ::: "memory")
#define PG8_WAIT_L(n) asm volatile("s_waitcnt lgkmcnt(" #n ")" ::: "memory")
#define PG8_BAR __builtin_amdgcn_s_barrier()
#define PG8_SCHED __builtin_amdgcn_sched_barrier(0)
    Unit cur, nxt; int ui = 0;
    if (!S.next(0, cur)) return;
    f32x4 acc[2][2][4][2];
#pragma unroll
    for (int a = 0; a < 2; ++a)
#pragma unroll
        for (int b = 0; b < 2; ++b)
#pragma unroll
            for (int m = 0; m < 4; ++m)
#pragma unroll
                for (int n = 0; n < 2; ++n) acc[a][b][m][n] = (f32x4){0.f, 0.f, 0.f, 0.f};
    bf16x8 At[4][2], B0[2][2], B1[2][2];
    const char* Ab = (const char*)g.A;
    const char* cB = (const char*)(g.Bt + S.b_off(cur));
    unsigned vA[2][2], nvA[2][2];
    PG8_VOFFA(vA, cur);
    PG8_STAGEB(PG8_SB(0, 0), cB); PG8_STAGEB(PG8_SB(0, 1), cB + hstep); PG8_STAGE2(PG8_SA(0, 0), Ab, vA[0][0], vA[0][1]); PG8_STAGE2(PG8_SA(0, 1), Ab, vA[1][0], vA[1][1]);
    if (wr == 1) PG8_BAR;
    PG8_WAIT_V(2); PG8_BAR;
    PG8_STAGEB(PG8_SB(1, 0), cB + kstep); PG8_STAGE2(PG8_SA(1, 0), Ab + kstep, vA[0][0], vA[0][1]); PG8_STAGEB(PG8_SB(1, 1), cB + hstep + kstep);
    PG8_WAIT_V(6); PG8_BAR;
    for (;;) {
        const bool has_next = S.next(ui + 1, nxt);
        const char* nB = cB;
#pragma unroll
        for (int h = 0; h < 2; ++h)
#pragma unroll
            for (int i = 0; i < 2; ++i) nvA[h][i] = vA[h][i];
        if (has_next) { nB = (const char*)(g.Bt + S.b_off(nxt)); PG8_VOFFA(nvA, nxt); }
        for (int t = 0; t < nt; t += 2) {
            const bool last = (t == nt - 2);
            const char* a1 = Ab + (size_t)(t + 1) * kstep;
            const char* a2 = last ? Ab : Ab + (size_t)(t + 2) * kstep; const char* b2 = last ? nB : cB + (size_t)(t + 2) * kstep;
            const char* a3 = a2 + kstep; const char* b3 = b2 + kstep;
            if constexpr (Epi::MIDK >= 0) { if (t == Epi::MIDK) E.mid(acc, cur, wr, fr); }
            unsigned o00 = vA[0][0], o01 = vA[0][1], o10 = vA[1][0], o11 = vA[1][1];
            if (last) { asm volatile("" : "+v"(nvA[0][0]), "+v"(nvA[0][1]), "+v"(nvA[1][0]), "+v"(nvA[1][1])); o00 = nvA[0][0]; o01 = nvA[0][1]; o10 = nvA[1][0]; o11 = nvA[1][1]; }
            PG8_LDB(B0, 0, 0); PG8_LDB(B1, 0, 1); PG8_SCHED; PG8_LDA(At, 0, 0); PG8_STAGE2(PG8_SA(1, 1), a1, vA[1][0], vA[1][1]);
            PG8_WAIT_V(8); PG8_WAIT_L(0); PG8_BAR; PG8_MMA(0, 0, At, B0); PG8_MMA(0, 1, At, B1); PG8_BAR; PG8_SCHED;
            PG8_LDA(At, 0, 1); PG8_STAGEB(PG8_SB(0, 0), b2); PG8_STAGEB(PG8_SB(0, 1), b2 + hstep); PG8_STAGE2(PG8_SA(0, 0), a2, o00, o01);
            PG8_WAIT_V(8); PG8_WAIT_L(0); PG8_BAR; PG8_MMA(1, 0, At, B0); PG8_MMA(1, 1, At, B1); PG8_BAR; PG8_SCHED;
            PG8_LDB(B0, 1, 0); PG8_LDB(B1, 1, 1); PG8_SCHED; PG8_LDA(At, 1, 0); PG8_STAGE2(PG8_SA(0, 1), a2, o10, o11);
            PG8_WAIT_V(8); PG8_WAIT_L(0); PG8_BAR; PG8_MMA(0, 0, At, B0); PG8_MMA(0, 1, At, B1); PG8_BAR; PG8_SCHED;
            PG8_LDA(At, 1, 1); PG8_STAGEB(PG8_SB(1, 0), b3); PG8_STAGEB(PG8_SB(1, 1), b3 + hstep); PG8_STAGE2(PG8_SA(1, 0), a3, o00, o01);
            PG8_WAIT_V(8); PG8_WAIT_L(0); PG8_BAR; PG8_MMA(1, 0, At, B0); PG8_MMA(1, 1, At, B1); PG8_BAR; PG8_SCHED;
        }
        if (wr == 0) PG8_BAR;
        E(acc, cur, wr, wc, fr, fq);
        if (!has_next) break;
#pragma unroll
        for (int a = 0; a < 2; ++a)
#pragma unroll
            for (int b = 0; b < 2; ++b)
#pragma unroll
                for (int m = 0; m < 4; ++m)
#pragma unroll
                    for (int n = 0; n < 2; ++n) acc[a][b][m][n] = (f32x4){0.f, 0.f, 0.f, 0.f};
        cur = nxt; cB = nB; ++ui;
#pragma unroll
        for (int h = 0; h < 2; ++h)
#pragma unroll
            for (int i = 0; i < 2; ++i) vA[h][i] = nvA[h][i];
        if (wr == 1) PG8_BAR;
    }
    PG8_WAIT_V(0);
    PG8_BAR;
#undef PG8_SA
#undef PG8_SB
#undef PG8_STAGE2
#undef PG8_STAGEB
#undef PG8_VOFFA
#undef PG8_LDA
#undef PG8_LDB
#undef PG8_MMA
#undef PG8_WAIT_V
#undef PG8_WAIT_L
#undef PG8_BAR
#undef PG8_SCHED
}

__device__ __forceinline__ f32x2 gelu_pk(f32x2 v) {
    const f32x2 av = __builtin_elementwise_abs(v), d = av * 0.2316418882f + 1.0f;
    f32x2 t; t.x = __builtin_amdgcn_rcpf(d.x); t.y = __builtin_amdgcn_rcpf(d.y);
    f32x2 q = t * 0.5307027145f + (-0.7265760135f); q = q * t + 0.7107068705f; q = q * t + (-0.142248368f); q = q * t + 0.127414796f; q = q * t;
    const f32x2 s = (v * v) * (-0.72134752044f);
    f32x2 e; e.x = __builtin_amdgcn_exp2f(s.x); e.y = __builtin_amdgcn_exp2f(s.y);
    const f32x2 m = v * (q * e), r = v - m;
    f32x2 o; o.x = v.x < 0.f ? m.x : r.x; o.y = v.y < 0.f ? m.y : r.y; return o;
}

struct EpiBf16G {   static constexpr int MIDK = -1;
    static constexpr bool PERM = true;
    bf16_t* O; int ldc; int gelu_from; f32x2* STAT; int stat_from; int pad; const float* rowscale;
    __device__ __forceinline__ void operator()(const f32x4 (&acc)[2][2][4][2], const Unit& u, int wr, int wc, int fr, int fq) const {
        const int row0 = u.pm * BM + wr * 64 + fr, col0 = u.pn * BM + wc * 64 + 8 * fq, rl0 = wr * 64 + fr;
        const bool act = u.pn >= gelu_from, st = u.pn >= stat_from;
#pragma unroll
        for (int ai = 0; ai < 2; ++ai)
#pragma unroll
            for (int m = 0; m < 4; ++m) { bf16_t* rowp = O + (size_t)(row0 + ai * HALF + m * 16) * ldc + col0; float s1 = 0.f, s2 = 0.f;
                const bool live = rl0 + ai * HALF + m * 16 < u.nv; const float rsc = rowscale ? rowscale[row0 + ai * HALF + m * 16] : 1.f;
#pragma unroll
                for (int bj = 0; bj < 2; ++bj) { f32x4 v0 = acc[ai][bj][m][0] * rsc, v1 = acc[ai][bj][m][1] * rsc;
                    if (act) { f32x2 a = gelu_pk((f32x2){v0[0], v0[1]}), b = gelu_pk((f32x2){v0[2], v0[3]}), c = gelu_pk((f32x2){v1[0], v1[1]}), d = gelu_pk((f32x2){v1[2], v1[3]});
                        v0 = (f32x4){a.x, a.y, b.x, b.y}; v1 = (f32x4){c.x, c.y, d.x, d.y}; }
                    if (st) { s1 += (v0[0] + v0[1]) + (v0[2] + v0[3]) + (v1[0] + v1[1]) + (v1[2] + v1[3]);
                        s2 += (v0[0] * v0[0] + v0[1] * v0[1]) + (v0[2] * v0[2] + v0[3] * v0[3]) + (v1[0] * v1[0] + v1[1] * v1[1]) + (v1[2] * v1[2] + v1[3] * v1[3]); }
                    u32x4 w; w.x = cvt_pk_bf16(v0[0], v0[1]); w.y = cvt_pk_bf16(v0[2], v0[3]); w.z = cvt_pk_bf16(v1[0], v1[1]); w.w = cvt_pk_bf16(v1[2], v1[3]);
                    if (live) *(u32x4*)(rowp + bj * 32) = w; }
                if (st) { s1 += __shfl_xor(s1, 16); s1 += __shfl_xor(s1, 32); s2 += __shfl_xor(s2, 16); s2 += __shfl_xor(s2, 32);
                    if (fq == 0) STAT[(size_t)(row0 + ai * HALF + m * 16) * 8 + (u.pn - stat_from) * 4 + wc] = (f32x2){s1, s2}; } }
    }
};
struct EpiH {
    static constexpr bool PERM = true;
    static constexpr int MIDK = 8;
    const bf16_t* x; bf16_t* HB; float* SSQ; const LAS f32x2* tab; int pms[4];
    __device__ __forceinline__ int slot(const Unit& u) const { return u.pm == pms[0] ? 0 : (u.pm == pms[1] ? 1 : (u.pm == pms[2] ? 2 : 3)); }
    __device__ __forceinline__ void mid(f32x4 (&acc)[2][2][4][2], const Unit& u, int wr, int fr) const {
        const LAS f32x2* t = tab + slot(u) * 256 + wr * 64 + fr;
#pragma unroll
        for (int ai = 0; ai < 2; ++ai)
#pragma unroll
            for (int m = 0; m < 4; ++m) { const float sc = t[ai * HALF + m * 16].x;
#pragma unroll
                for (int bj = 0; bj < 2; ++bj)
#pragma unroll
                    for (int n = 0; n < 2; ++n) acc[ai][bj][m][n] *= sc; }
    }
    __device__ __forceinline__ void operator()(const f32x4 (&acc)[2][2][4][2], const Unit& u, int wr, int wc, int fr, int fq) const {
        const int row0 = u.pm * BM + wr * 64 + fr, col0 = u.pn * BM + wc * 64 + 8 * fq;
        const LAS f32x2* t = tab + slot(u) * 256 + wr * 64 + fr;
#pragma unroll
        for (int ai = 0; ai < 2; ++ai)
#pragma unroll
            for (int m = 0; m < 4; ++m) { const int row = row0 + ai * HALF + m * 16; const bf16_t* xr = x + (size_t)row * DM + col0; bf16_t* hr = HB + (size_t)row * DM + col0; float s = 0.f;
                const float rg = t[ai * HALF + m * 16].y;
#pragma unroll
                for (int bj = 0; bj < 2; ++bj) { const u32x4 xw = *(const u32x4*)(xr + bj * 32);
                    const f32x4 x0 = (f32x4){__uint_as_float(xw.x << 16), __uint_as_float(xw.x & 0xffff0000u), __uint_as_float(xw.y << 16), __uint_as_float(xw.y & 0xffff0000u)}, x1 = (f32x4){__uint_as_float(xw.z << 16), __uint_as_float(xw.z & 0xffff0000u), __uint_as_float(xw.w << 16), __uint_as_float(xw.w & 0xffff0000u)};
                    const f32x4 v0 = acc[ai][bj][m][0] * rg + x0, v1 = acc[ai][bj][m][1] * rg + x1;
                    s += (v0[0] * v0[0] + v0[1] * v0[1]) + (v0[2] * v0[2] + v0[3] * v0[3]) + (v1[0] * v1[0] + v1[1] * v1[1]) + (v1[2] * v1[2] + v1[3] * v1[3]);
                    u32x4 w; w.x = cvt_pk_bf16(v0[0], v0[1]); w.y = cvt_pk_bf16(v0[2], v0[3]); w.z = cvt_pk_bf16(v1[0], v1[1]); w.w = cvt_pk_bf16(v1[2], v1[3]);
                    *(u32x4*)(hr + bj * 32) = w; }
                s += __shfl_xor(s, 16); s += __shfl_xor(s, 32);
                if (fq == 0) SSQ[(size_t)row * 16 + u.pn * 4 + wc] = s; }
    }
};
}

template <bool GATHER>
struct MoeOrder {
    const volatile LAS int* toff;
    const int* cnt; const int* toklist;
    int nN, nwg, G, c, K, rows_per_e;
    __device__ __forceinline__ bool next(int i, pg8::Unit& u) const {
        const long L = (long)i * G + c; if (L >= nwg) return false;
        const int wgid = pg8::xcd_remap((int)L, nwg);
        const int T = wgid / nN; u.pn = wgid % nN; u.pm = T;
        int e = 0;
        for (int j = 1; j < NEXP; ++j) e += (toff[j] <= T) ? 1 : 0;
        e = __builtin_amdgcn_readfirstlane(e);
        u.e = e; u.pos0 = __builtin_amdgcn_readfirstlane((T - toff[e]) * 256); u.ne = __builtin_amdgcn_readfirstlane(toff[64 + e]); { const int left = u.ne - u.pos0; u.nv = left < 256 ? left : 256; } return true;
    }
    __device__ __forceinline__ size_t b_off(const pg8::Unit& u) const { return ((size_t)u.e * rows_per_e + (size_t)u.pn * 256) * K; }
    __device__ __forceinline__ int a_row(const pg8::Unit& u, int r) const {
        if (!GATHER) return u.pm * 256 + r;
        const int pos = u.pos0 + r;
        return pos < u.ne ? toklist[(size_t)u.e * NTOK + pos] : 0;
    }
};
struct EpiSwiglu {   static constexpr int MIDK = -1;
    static constexpr bool PERM = true;
    bf16_t* HID; const float* rslist;
    __device__ __forceinline__ void operator()(const f32x4 (&acc)[2][2][4][2], const pg8::Unit& u, int wr, int wc, int fr, int fq) const {
        const int r0 = wr * 64 + fr, col0 = u.pn * 128 + wc * 32 + 8 * fq; const int pos0 = u.pos0, n_e = u.ne;
#pragma unroll
        for (int ai = 0; ai < 2; ++ai)
#pragma unroll
            for (int m = 0; m < 4; ++m) { const int r = r0 + ai * 128 + m * 16, pos = pos0 + r;
                const float rs = pos < n_e ? rslist[(size_t)u.e * NTOK + pos] : 0.f;
                float o[8];
#pragma unroll
                for (int n = 0; n < 2; ++n)
#pragma unroll
                    for (int j = 0; j < 4; ++j) { const float gt = acc[ai][0][m][n][j] * rs, up = acc[ai][1][m][n][j] * rs;
                        o[4 * n + j] = gt * __builtin_amdgcn_rcpf(1.f + __builtin_amdgcn_exp2f(-gt * LOG2E)) * up; }
                u32x4 w; w.x = cvt_pk_bf16(o[0], o[1]); w.y = cvt_pk_bf16(o[2], o[3]); w.z = cvt_pk_bf16(o[4], o[5]); w.w = cvt_pk_bf16(o[6], o[7]);
                if (r < u.nv || true) *(u32x4*)(HID + (size_t)(u.pm * 256 + r) * DEXP + col0) = w; }
    }
};

#define XB_TMO      128
#define XB_XCNT(j)  (256  + 64 * (j))
#define XB_XSUB(j)  (1280 + 64 * (j))
#define XB_XGEN(j)  (2304 + 64 * (j))
#define XB_TOP      3328
#define XB_TOPGEN   3392
#define XCD_BAR_WORDS 3456
#define XB_SPIN_CAP (1u << 18)
__device__ __forceinline__ unsigned xb_ld(unsigned* p)              { return __hip_atomic_load(p, __ATOMIC_RELAXED, __HIP_MEMORY_SCOPE_AGENT); }
__device__ __forceinline__ unsigned xb_add(unsigned* p, unsigned v) { return __hip_atomic_fetch_add(p, v, __ATOMIC_RELAXED, __HIP_MEMORY_SCOPE_AGENT); }
__device__ __forceinline__ unsigned xb_xcc_id() { return (unsigned)__builtin_amdgcn_s_getreg((3 << 11) | 20) & 0xFu; }
#define XB_SPIN(cond, bar) do { unsigned _sp = 0; while (cond) { __builtin_amdgcn_s_sleep(1); \
    if ((++_sp & 255u) == 0u) { if (xb_ld(&(bar)[XB_TMO])) break; if (_sp > XB_SPIN_CAP) { atomicAdd(&(bar)[XB_TMO], 1u); break; } } } } while (0)
struct XcdBarrier { unsigned* bar; unsigned x; volatile LAS unsigned* st; };
__device__ __forceinline__ XcdBarrier xcd_barrier_post(unsigned* bar, volatile LAS unsigned* st) {
    XcdBarrier b; b.bar = bar; b.x = xb_xcc_id(); b.st = st;
    if (threadIdx.x == 0) (void)xb_add(&bar[XB_XCNT(b.x)], 1u);
    return b;
}
__device__ __forceinline__ void xcd_barrier_complete(unsigned* bar, unsigned x, unsigned& nloc, unsigned& nx) {
    const unsigned G = gridDim.x * gridDim.y * gridDim.z;
    unsigned sum, cnt, mine, sp = 0u;
    for (;;) {
        sum = 0u; cnt = 0u; mine = 0u;
#pragma unroll
        for (unsigned j = 0; j < 16; ++j) { const unsigned c = xb_ld(&bar[XB_XCNT(j)]); sum += c; cnt += (c > 0u) ? 1u : 0u; mine = (j == x) ? c : mine; }
        if (sum == G) break;
        __builtin_amdgcn_s_sleep(1);
        if ((++sp & 255u) == 0u) { if (xb_ld(&bar[XB_TMO])) break; if (sp > XB_SPIN_CAP) { atomicAdd(&bar[XB_TMO], 1u); break; } }
    }
    nloc = mine > 0u ? mine : 1u; nx = cnt > 0u ? cnt : 1u;
}
struct Frame;
template <int WHICH> __device__ __forceinline__ void convert_rest(Frame& F, int part, int nparts, int lo, int hi);
__device__ __forceinline__ void barrier_background(Frame& F, int bg);
__device__ __forceinline__ void xcd_barrier(const XcdBarrier& b, Frame* Fp = nullptr, int bg = -1) {
    asm volatile("s_waitcnt vmcnt(0)" ::: "memory");
    __syncthreads();
    if (bg >= 0 && threadIdx.x >= 64) barrier_background(*Fp, bg);
    if (threadIdx.x == 0) {
        unsigned* bar = b.bar;
        __builtin_amdgcn_s_waitcnt(0);
        unsigned nloc = b.st[0], nx = b.st[1];
        if (nloc == 0u) { xcd_barrier_complete(bar, b.x, nloc, nx); b.st[0] = nloc; b.st[1] = nx; }
        const unsigned old = xb_add(&bar[XB_XSUB(b.x)], 1u);
        const unsigned gen = old / nloc;
        if (old + 1u == (gen + 1u) * nloc) {
            __builtin_amdgcn_fence(__ATOMIC_RELEASE, "agent");
            asm volatile("s_waitcnt vmcnt(0)" ::: "memory");
            const unsigned og = xb_add(&bar[XB_TOP], 1u);
            const unsigned tg = og / nx;
            if (og + 1u == (tg + 1u) * nx) xb_add(&bar[XB_TOPGEN], 1u);
            else XB_SPIN(xb_ld(&bar[XB_TOPGEN]) == tg, bar);
            __builtin_amdgcn_fence(__ATOMIC_ACQUIRE, "agent");
            xb_add(&bar[XB_XGEN(b.x)], 1u);
            asm volatile("s_waitcnt vmcnt(0)" ::: "memory");
        } else {
            XB_SPIN(xb_ld(&bar[XB_XGEN(b.x)]) == gen, bar);
            __builtin_amdgcn_fence(__ATOMIC_ACQUIRE, "agent");
            asm volatile("s_waitcnt vmcnt(0)" ::: "memory");
        }
    }
    __syncthreads();
}

struct Frame {
    LAS unsigned char* lds;
    volatile LAS unsigned* MISC;
    int tid, lane, wave, vcu, G;
    const float* const* in; float* out; unsigned char* ws;
};
#define LDS_WAIT() asm volatile("s_waitcnt lgkmcnt(0)" ::: "memory")

__device__ __forceinline__ void transpose_tile64(const float* W, int ldw, int k0, int n0, bf16_t* WT, int ldt, int rowbase, const float* kscale, int lane, int hi32 = 32) {
    const float* src = W + (size_t)k0 * ldw + n0 + lane;
    float v[64];
#pragma unroll
    for (int k = 0; k < 64; ++k) v[k] = __builtin_nontemporal_load(src + (size_t)k * ldw);
    if (kscale) {
#pragma unroll
        for (int k = 0; k < 64; ++k) v[k] *= kscale[k0 + k];
    }
    bf16_t* dst = WT + (size_t)(rowbase + (lane & 31) + (lane >> 5) * hi32) * ldt + k0;
#pragma unroll
    for (int c = 0; c < 8; ++c) { u32x4 o; o.x = cvt_pk_bf16(v[8 * c], v[8 * c + 1]); o.y = cvt_pk_bf16(v[8 * c + 2], v[8 * c + 3]); o.z = cvt_pk_bf16(v[8 * c + 4], v[8 * c + 5]); o.w = cvt_pk_bf16(v[8 * c + 6], v[8 * c + 7]);
        *(u32x4*)(dst + 8 * c) = o; }
}

__device__ __forceinline__ void p0_prologue(Frame& F) {
    const int gw = F.vcu * NWAVES + F.wave, NGW = F.G * NWAVES, lane = F.lane;
    unsigned char* ws = F.ws;
    for (int it = gw; it < 16 * 28; it += NGW) { const int kb = it / 28, nb = it % 28; transpose_tile64(F.in[2], NPROJ, 64 * kb, 64 * nb, (bf16_t*)(ws + WS_WIN_T), DM, 64 * nb, F.in[1], lane); }
    const int gt = F.vcu * (NWAVES * 64) + F.tid, NGT = F.G * NWAVES * 64;
    for (int i = gt; i < 8 * 128 * 128; i += NGT) { const int c = i & 127, t = (i >> 7) & 127; ((bf16_t*)(ws + WS_WSP))[i] = c <= t ? f2bf(F.in[4][i]) : (bf16_t)0; }
    for (int i = gt; i < 64 * DM; i += NGT) { const int k = i & (DM - 1), c = i >> 10; float v = 0.f;
        if (c < 4) v = F.in[12][k * 4 + c] * F.in[11][k];
        else if (c < 36) { const int g = (c - 4) >> 3, e = (c - 4) & 7; v = F.in[14][((size_t)g * DM + k) * 8 + e] * F.in[11][k]; }
        ((bf16_t*)(ws + WS_WR_T))[i] = f2bf(v); }
    float* rsx = (float*)(ws + WS_RSX);
    for (int row0 = gw * 8; row0 < NTOK; row0 += NGW * 8) {
        f32x4 v[8][4];
#pragma unroll
        for (int rr = 0; rr < 8; ++rr)
#pragma unroll
            for (int j = 0; j < 4; ++j) v[rr][j] = __builtin_nontemporal_load((const f32x4*)(F.in[0] + (size_t)(row0 + rr) * DM + 256 * j + 4 * lane));
#pragma unroll
        for (int rr = 0; rr < 8; ++rr) {
            float s = 0.f;
#pragma unroll
            for (int j = 0; j < 4; ++j) s += (v[rr][j][0] * v[rr][j][0] + v[rr][j][1] * v[rr][j][1]) + (v[rr][j][2] * v[rr][j][2] + v[rr][j][3] * v[rr][j][3]);
            const float rstd = rsqrtf(wave_sum(s) * (1.f / DM) + RMS_EPS);
            if (lane == 0) rsx[row0 + rr] = rstd;
            bf16_t* xn = (bf16_t*)(ws + WS_XN) + (size_t)(row0 + rr) * DM;
#pragma unroll
            for (int j = 0; j < 4; ++j) { u32x2 o; o.x = cvt_pk_bf16(v[rr][j][0], v[rr][j][1]); o.y = cvt_pk_bf16(v[rr][j][2], v[rr][j][3]);
                *(u32x2*)(xn + 256 * j + 4 * lane) = o; }
        }
    }
}
template <int WHICH>
__device__ __forceinline__ void convert_rest(Frame& F, int part, int nparts, int lo, int hi) {
    unsigned char* ws = F.ws; const int lane = F.lane;
    constexpr int T_OUT = 16 * 16, T_GU = NEXP * 64, T_D = NEXP * 64;
    if (WHICH == 0) {
        for (int it = lo + part; it < 2 * T_GU && it < hi; it += nparts) {
            int r = it; const int up = r >= T_GU; if (up) r -= T_GU; const int e = r / 64, q = r % 64, kb = q / 4, nb = q % 4, n0 = 64 * nb;
            const int rowbase = e * 512 + 256 * (n0 >> 7) + 2 * (n0 & 127) + (up ? 32 : 0);
            transpose_tile64(F.in[up ? 17 : 16] + (size_t)e * DM * DEXP, DEXP, 64 * kb, n0, (bf16_t*)(ws + WS_WGU_T), DM, rowbase, F.in[11], lane, 64); }
    } else if (WHICH == 1) {
        for (int it = part; it < T_OUT; it += nparts) { const int kb = it / 16, nb = it % 16; transpose_tile64(F.in[10], DM, 64 * kb, 64 * nb, (bf16_t*)(ws + WS_WO_T), DM, 64 * nb, 64 * kb < 512 ? F.in[8] : F.in[9] - 512, lane); }
    } else {
        for (int it = part; it < T_D; it += nparts) { const int e = it / 64, q = it % 64, kb = q / 16, nb = q % 16;
            transpose_tile64(F.in[18] + (size_t)e * DEXP * DM, DM, 64 * kb, 64 * nb, (bf16_t*)(ws + WS_WD_T), DEXP, e * DM + 64 * nb, nullptr, lane); }
    }
}

__device__ __forceinline__ void barrier_background(Frame& F, int bg) {
    constexpr int NT = 2 * NEXP * 64, PER = (NT + 2) / 3;
    convert_rest<0>(F, F.vcu * (NWAVES - 1) + (F.wave - 1), F.G * (NWAVES - 1), bg * PER, (bg + 1) * PER);
}

constexpr int P2_K_OFF = 0, P2_KROW = 144, P2_KHEAD = 256 * P2_KROW;
constexpr int P2_V_OFF = 2 * P2_KHEAD, P2_VHEAD = 256 * 128;
constexpr int P2_VN_OFF = 0, P2_VNROW = 1088;
constexpr int P2_EXA_OFF = 139264, P2_EXG_OFF = P2_EXA_OFF + 4096;
static_assert(P2_V_OFF + 2 * P2_VHEAD <= P2_EXA_OFF && 128 * P2_VNROW <= P2_EXA_OFF && P2_EXG_OFF + 4096 <= MISC_OFF, "P2 LDS map");

__device__ __forceinline__ void p2_mix(Frame& F, const int skip) {
    const int tid = F.tid, lane = F.lane, w = F.wave;
    const int r = lane & 31, hh = lane >> 5, g4 = lane >> 4, q4 = (lane & 15) >> 2, p4 = lane & 3;
    const bf16_t* proj = (const bf16_t*)(F.ws + WS_PROJ);
    bf16_t* mixed = (bf16_t*)(F.ws + WS_MIXED);
    const bf16_t* wsp = (const bf16_t*)(F.ws + WS_WSP);
    LAS unsigned char* lds = F.lds;
    float* ssqm = (float*)(F.ws + WS_SSQM);
    const float sink2 = F.in[3][w] * LOG2E;
    const float SC2 = 0.125f * LOG2E;
    for (int unit = F.vcu; unit < NTOK / 128; unit += F.G) {
        const int t0 = unit * 128; const bool first = (unit & 63) == 0;
        {
            u32x4 kv[8], vv[8];
#pragma unroll
            for (int i = 0; i < 8; ++i) { const int pc = tid + 512 * i, key = pc >> 4, sub = pc & 15;
                kv[i] = (u32x4){0u, 0u, 0u, 0u}; vv[i] = (u32x4){0u, 0u, 0u, 0u};
                if (!(first && key < 128)) { const bf16_t* rowp = proj + (size_t)(t0 - 128 + key) * NPROJ; kv[i] = *(const u32x4*)(rowp + C_K + sub * 8); vv[i] = *(const u32x4*)(rowp + C_V + sub * 8); } }
#pragma unroll
            for (int i = 0; i < 8; ++i) { const int pc = tid + 512 * i, key = pc >> 4, sub = pc & 15, kvh = sub >> 3, piece = sub & 7;
                *(LAS u32x4*)(lds + P2_K_OFF + kvh * P2_KHEAD + key * P2_KROW + piece * 16) = kv[i];
                *(LAS u32x4*)(lds + P2_V_OFF + kvh * P2_VHEAD + key * 128 + ((piece ^ (((key >> 1) & 1) << 2)) * 16)) = vv[i]; }
        }
        if (!(skip & 1)) {
            const int kvh = w >> 2;
            const LAS unsigned char* Kl = lds + P2_K_OFF + kvh * P2_KHEAD;
            const LAS unsigned char* Vl = lds + P2_V_OFF + kvh * P2_VHEAD;
            const int vflip = (q4 >> 1) & 1;
            const int vlane = (4 * hh + q4) * 128 + (g4 & 1) * 32 + p4 * 8;
            const int vh0 = vflip * 64, vh1 = (vflip ^ 1) * 64;
            const bf16_t* qbase = proj + (size_t)(t0 + r) * NPROJ + C_Q + 64 * w + 8 * hh;
            bf16x8 qn[4];
#pragma unroll
            for (int s = 0; s < 4; ++s) qn[s] = __builtin_nontemporal_load((const bf16x8*)(qbase + 16 * s));
            __syncthreads();
            for (int qb = 0; qb < 4; ++qb) {
                bf16x8 qf[4];
#pragma unroll
                for (int s = 0; s < 4; ++s) qf[s] = qn[s];
                if (qb < 3) {
#pragma unroll
                    for (int s = 0; s < 4; ++s) qn[s] = __builtin_nontemporal_load((const bf16x8*)(qbase + (size_t)(32 * (qb + 1)) * NPROJ + 16 * s));
                }
                f32x16 sa[5];
#pragma unroll
                for (int cc = 0; cc < 5; ++cc) {
#pragma unroll
                    for (int i = 0; i < 16; ++i) sa[cc][i] = 0.f;
                    const LAS unsigned char* kp = Kl + (32 * (qb + cc) + r) * P2_KROW + 16 * hh;
#pragma unroll
                    for (int s = 0; s < 4; ++s) { const bf16x8 kf = *(const LAS bf16x8*)(kp + 32 * s); sa[cc] = MFMA32(kf, qf[s], sa[cc]); }
                }
                const int q = 32 * qb + r; float mr = -1e30f;
#pragma unroll
                for (int cc = 0; cc < 5; ++cc)
#pragma unroll
                    for (int i = 0; i < 16; ++i) { const int kb = 32 * (qb + cc) + (i & 3) + 8 * (i >> 2) + 4 * hh;
                        if (cc == 0 || cc == 4 || first) { bool ok = true; if (cc == 0) ok = kb >= q + 1; if (cc == 4) ok = kb <= q + 128; if (first) ok = ok && kb >= 128; sa[cc][i] = ok ? sa[cc][i] : -1e30f; }
                        mr = fmaxf(mr, sa[cc][i]); }
                mr = fmaxf(mr, __shfl_xor(mr, 32));
                const float mx = fmaxf(mr * SC2, sink2);
                float sum4[4] = {0.f, 0.f, 0.f, 0.f};
#pragma unroll
                for (int cc = 0; cc < 5; ++cc)
#pragma unroll
                    for (int i = 0; i < 16; ++i) { const float pe = __builtin_amdgcn_exp2f(fmaf(sa[cc][i], SC2, -mx)); sa[cc][i] = pe; sum4[i & 3] += pe; }
                float sum = (sum4[0] + sum4[1]) + (sum4[2] + sum4[3]);
                sum += __shfl_xor(sum, 32);
                const float inv = 1.f / (sum + __builtin_amdgcn_exp2f(sink2 - mx));
                f32x16 o[2];
#pragma unroll
                for (int i = 0; i < 16; ++i) { o[0][i] = 0.f; o[1][i] = 0.f; }
#pragma unroll
                for (int cc = 0; cc < 5; ++cc)
#pragma unroll
                    for (int s2 = 0; s2 < 2; ++s2) {
                        u32x4 pw; pw.x = cvt_pk_bf16(sa[cc][8 * s2 + 0], sa[cc][8 * s2 + 1]); pw.y = cvt_pk_bf16(sa[cc][8 * s2 + 2], sa[cc][8 * s2 + 3]);
                        pw.z = cvt_pk_bf16(sa[cc][8 * s2 + 4], sa[cc][8 * s2 + 5]); pw.w = cvt_pk_bf16(sa[cc][8 * s2 + 6], sa[cc][8 * s2 + 7]);
                        const bf16x8 pf = __builtin_bit_cast(bf16x8, pw);
                        const LAS unsigned char* vp = Vl + (32 * (qb + cc) + 16 * s2) * 128 + vlane;
#pragma unroll
                        for (int db = 0; db < 2; ++db) { const int vh = db ? vh1 : vh0; const s16x4 a0 = vtr(vp + vh), a1 = vtr(vp + 8 * 128 + vh);
                            const bf16x8 vf = (bf16x8){a0[0], a0[1], a0[2], a0[3], a1[0], a1[1], a1[2], a1[3]};
                            o[db] = MFMA32(vf, pf, o[db]); }
                    }
                float ss4[4] = {0.f, 0.f, 0.f, 0.f};
#pragma unroll
                for (int db = 0; db < 2; ++db)
#pragma unroll
                    for (int i = 0; i < 16; ++i) { o[db][i] *= inv; ss4[i & 3] += o[db][i] * o[db][i]; }
                float ss = (ss4[0] + ss4[1]) + (ss4[2] + ss4[3]);
                ss += __shfl_xor(ss, 32);
                if (hh == 0) ssqm[(size_t)(t0 + q) * 16 + w] = ss;
                bf16_t* orow = mixed + (size_t)(t0 + q) * DM + 64 * w + 4 * hh;
#pragma unroll
                for (int db = 0; db < 2; ++db)
#pragma unroll
                    for (int rg = 0; rg < 4; ++rg) { u32x2 ow; ow.x = cvt_pk_bf16(o[db][4 * rg], o[db][4 * rg + 1]); ow.y = cvt_pk_bf16(o[db][4 * rg + 2], o[db][4 * rg + 3]);
                        *(u32x2*)(orow + 32 * db + 8 * rg) = ow; }
            }
        }
        if (!(skip & 2)) {
            u32x4 raw[16];
#pragma unroll
            for (int i = 0; i < 16; ++i) raw[i] = __builtin_nontemporal_load((const u32x4*)(proj + (size_t)(t0 + 16 * w + i) * NPROJ + C_GV + 8 * lane));
            const f32x4 lg0 = *(const f32x4*)(F.in[6] + 8 * lane), lg1 = *(const f32x4*)(F.in[6] + 8 * lane + 4), lb0 = *(const f32x4*)(F.in[7] + 8 * lane), lb1 = *(const f32x4*)(F.in[7] + 8 * lane + 4);
            LAS f32x2* stat = (LAS f32x2*)(lds + P2_EXG_OFF);
            if (tid < 128) { const f32x4* sp = (const f32x4*)((const float*)(F.ws + WS_SSQ) + (size_t)(t0 + tid) * 16); const f32x4 a = sp[0], b = sp[1], c = sp[2], d = sp[3];
                const float s1 = (a[0] + a[2]) + (b[0] + b[2]) + (c[0] + c[2]) + (d[0] + d[2]), s2 = (a[1] + a[3]) + (b[1] + b[3]) + (c[1] + c[3]) + (d[1] + d[3]);
                const float mu = s1 * (1.f / 512), var = fmaxf(s2 * (1.f / 512) - mu * mu, 0.f); stat[tid] = (f32x2){mu, rsqrtf(var + LN_EPS)}; }
            __syncthreads();
#pragma unroll
            for (int i = 0; i < 16; ++i) { const int tok = 16 * w + i; const f32x2 st = stat[tok]; const float mu = st.x, rstd = st.y;
                float v[8];
                v[0] = __uint_as_float(raw[i].x << 16); v[1] = __uint_as_float(raw[i].x & 0xffff0000u); v[2] = __uint_as_float(raw[i].y << 16); v[3] = __uint_as_float(raw[i].y & 0xffff0000u);
                v[4] = __uint_as_float(raw[i].z << 16); v[5] = __uint_as_float(raw[i].z & 0xffff0000u); v[6] = __uint_as_float(raw[i].w << 16); v[7] = __uint_as_float(raw[i].w & 0xffff0000u);
#pragma unroll
                for (int j = 0; j < 8; ++j) v[j] = (v[j] - mu) * rstd;
                u32x4 ow; ow.x = cvt_pk_bf16(v[0] * lg0[0] + lb0[0], v[1] * lg0[1] + lb0[1]); ow.y = cvt_pk_bf16(v[2] * lg0[2] + lb0[2], v[3] * lg0[3] + lb0[3]);
                ow.z = cvt_pk_bf16(v[4] * lg1[0] + lb1[0], v[5] * lg1[1] + lb1[1]); ow.w = cvt_pk_bf16(v[6] * lg1[2] + lb1[2], v[7] * lg1[3] + lb1[3]);
                *(LAS u32x4*)(lds + P2_VN_OFF + tok * P2_VNROW + lane * 16) = ow; }
        }
        if (!(skip & 4)) {
            const LAS unsigned char* vnl = lds + P2_VN_OFF + (8 * hh + q4) * P2_VNROW + (64 * w + 16 * (g4 & 1) + 4 * p4) * 2;
            const bf16_t* wh = wsp + (size_t)w * 128 * 128 + (size_t)r * 128 + 8 * hh;
            const bf16_t* ub = proj + (size_t)(t0 + r) * NPROJ + C_GU + 64 * w + 4 * hh;
            bf16x8 wf[8]; u32x2 uu[8];
#pragma unroll
            for (int s = 0; s < 2; ++s) wf[s] = *(const bf16x8*)(wh + 16 * s);
#pragma unroll
            for (int j = 0; j < 8; ++j) uu[j] = *(const u32x2*)(ub + 32 * (j >> 2) + 8 * (j & 3));
            __syncthreads();
#pragma unroll
            for (int tb = 0; tb < 4; ++tb) {
                f32x16 acc[2];
#pragma unroll
                for (int i = 0; i < 16; ++i) { acc[0][i] = 0.f; acc[1][i] = 0.f; }
#pragma unroll
                for (int s = 0; s < 2 * tb + 2; ++s) {
#pragma unroll
                    for (int db = 0; db < 2; ++db) { const LAS unsigned char* vp = vnl + (16 * s) * P2_VNROW + db * 64;
                        const s16x4 a0 = vtr(vp), a1 = vtr(vp + 4 * P2_VNROW);
                        const bf16x8 af = (bf16x8){a0[0], a0[1], a0[2], a0[3], a1[0], a1[1], a1[2], a1[3]};
                        acc[db] = MFMA32(af, wf[s], acc[db]); }
                }
                const int t = 32 * tb + r; const float bs = F.in[5][w * 128 + t];
                float ss = 0.f;
#pragma unroll
                for (int db = 0; db < 2; ++db)
#pragma unroll
                    for (int rg = 0; rg < 4; ++rg) { const u32x2 u2 = uu[4 * db + rg];
                        const float u0 = __uint_as_float(u2.x << 16), u1 = __uint_as_float(u2.x & 0xffff0000u), u2f = __uint_as_float(u2.y << 16), u3 = __uint_as_float(u2.y & 0xffff0000u);
                        float a = u0 * (acc[db][4 * rg] + bs), b = u1 * (acc[db][4 * rg + 1] + bs), c = u2f * (acc[db][4 * rg + 2] + bs), d = u3 * (acc[db][4 * rg + 3] + bs);
                        acc[db][4 * rg] = a; acc[db][4 * rg + 1] = b; acc[db][4 * rg + 2] = c; acc[db][4 * rg + 3] = d; ss += (a * a + b * b) + (c * c + d * d); }
                if (tb < 3) {
#pragma unroll
                    for (int s = 0; s < 2 * tb + 4; ++s) wf[s] = *(const bf16x8*)(wh + (size_t)(32 * (tb + 1)) * 128 + 16 * s);
#pragma unroll
                    for (int j = 0; j < 8; ++j) uu[j] = *(const u32x2*)(ub + (size_t)(32 * (tb + 1)) * NPROJ + 32 * (j >> 2) + 8 * (j & 3));
                }
                ss += __shfl_xor(ss, 32);
                if (hh == 0) ssqm[(size_t)(t0 + t) * 16 + 8 + w] = ss;
                bf16_t* orow = mixed + (size_t)(t0 + t) * DM + 512 + 64 * w + 4 * hh;
#pragma unroll
                for (int db = 0; db < 2; ++db)
#pragma unroll
                    for (int rg = 0; rg < 4; ++rg) { u32x2 ow; ow.x = cvt_pk_bf16(acc[db][4 * rg], acc[db][4 * rg + 1]); ow.y = cvt_pk_bf16(acc[db][4 * rg + 2], acc[db][4 * rg + 3]);
                        *(u32x2*)(orow + 32 * db + 8 * rg) = ow; }
            }
        }
        __syncthreads();
    }
}

constexpr int P4_WROW = 2064;
constexpr int P4_W_OFF = 0, P4_LG_OFF = 48 * P4_WROW, P4_CNT_OFF = P4_LG_OFF + 8 * 16 * 48 * 4, P4_BASE_OFF = P4_CNT_OFF + 128;
static_assert(P4_BASE_OFF + 128 <= MISC_OFF, "P4 LDS map");
__device__ __forceinline__ void p4_router(Frame& F) {
    const int lane = F.lane, w = F.wave, tid = F.tid;
    const bf16_t* hb = (const bf16_t*)(F.ws + WS_HB);
    const bf16_t* wr_t = (const bf16_t*)(F.ws + WS_WR_T);
    const float* ssq = (const float*)(F.ws + WS_SSQ);
    int* cntg = (int*)(F.ws + WS_CTL) + CW_CNT;
    int* tl = (int*)(F.ws + WS_TOKLIST); float* rl = (float*)(F.ws + WS_RSLIST);
    LAS unsigned char* lds = F.lds;
    LAS float* lg = (LAS float*)(lds + P4_LG_OFF) + w * 16 * 48;
    LAS int* cl = (LAS int*)(lds + P4_CNT_OFF); LAS int* bl = (LAS int*)(lds + P4_BASE_OFF);
#pragma unroll
    for (int i = 0; i < 12; ++i) { const int pc = tid + 512 * i, row = pc >> 7, ch = pc & 127; *(LAS u32x4*)(lds + P4_W_OFF + row * P4_WROW + ch * 16) = *(const u32x4*)(wr_t + (size_t)row * DM + ch * 8); }
    for (int blk = F.vcu; blk < NTOK / 128; blk += F.G) {
        const int tok0 = blk * 128 + 16 * w;
        if (tid < 32) cl[tid] = 0;
        const bf16_t* ap = hb + (size_t)(tok0 + (lane & 15)) * DM + 8 * (lane >> 4);
        bf16x8 af[32];
#pragma unroll
        for (int s = 0; s < 32; ++s) af[s] = *(const bf16x8*)(ap + 32 * s);
        const f32x4 sq0 = *(const f32x4*)(ssq + (size_t)(tok0 + (lane & 15)) * 16), sq1 = *(const f32x4*)(ssq + (size_t)(tok0 + (lane & 15)) * 16 + 4),
                    sq2 = *(const f32x4*)(ssq + (size_t)(tok0 + (lane & 15)) * 16 + 8), sq3 = *(const f32x4*)(ssq + (size_t)(tok0 + (lane & 15)) * 16 + 12);
        __syncthreads();
        f32x4 acc[3];
#pragma unroll
        for (int c = 0; c < 3; ++c) acc[c] = (f32x4){0.f, 0.f, 0.f, 0.f};
        const LAS unsigned char* bp = lds + P4_W_OFF + (lane & 15) * P4_WROW + 16 * (lane >> 4);
#pragma unroll
        for (int s = 0; s < 32; ++s) {
#pragma unroll
            for (int c = 0; c < 3; ++c) { const bf16x8 b = *(const LAS bf16x8*)(bp + c * 16 * P4_WROW + 64 * s); acc[c] = MFMA16(af[s], b, acc[c]); }
        }
#pragma unroll
        for (int c = 0; c < 3; ++c)
#pragma unroll
            for (int i = 0; i < 4; ++i) lg[(4 * (lane >> 4) + i) * 48 + 16 * c + (lane & 15)] = acc[c][i];
        LDS_WAIT();
        int e1 = 0, e2 = 0, l1 = 0, l2 = 0; float w1 = 0.f, w2 = 0.f, rstd = 0.f;
        if (lane < 16) {
            float s = 0.f;
#pragma unroll
            for (int i = 0; i < 4; ++i) s += sq0[i];
#pragma unroll
            for (int i = 0; i < 4; ++i) s += sq1[i];
#pragma unroll
            for (int i = 0; i < 4; ++i) s += sq2[i];
#pragma unroll
            for (int i = 0; i < 4; ++i) s += sq3[i];
            rstd = rsqrtf(s * (1.f / DM) + RMS_EPS);
            const LAS float* L = lg + lane * 48;
            float gl[4]; int gi = 0;
#pragma unroll
            for (int j = 0; j < 4; ++j) gl[j] = L[j] * rstd + F.in[13][j];
            float gm = gl[0];
#pragma unroll
            for (int j = 1; j < 4; ++j) if (gl[j] > gm) { gm = gl[j]; gi = j; }
            float den = 0.f;
#pragma unroll
            for (int j = 0; j < 4; ++j) den += __expf(gl[j] - gm);
            const float gw = 1.f / den;
            float el[8];
#pragma unroll
            for (int j = 0; j < 8; ++j) el[j] = L[4 + gi * 8 + j] * rstd + F.in[15][gi * 8 + j];
            int i1 = 0; float v1 = el[0];
#pragma unroll
            for (int j = 1; j < 8; ++j) if (el[j] > v1) { v1 = el[j]; i1 = j; }
            int i2 = 0; float v2 = -INFINITY;
#pragma unroll
            for (int j = 0; j < 8; ++j) if (j != i1 && el[j] > v2) { v2 = el[j]; i2 = j; }
            const float a1 = 1.f / (1.f + __expf(v2 - v1));
            w1 = gw * a1; w2 = gw * (1.f - a1); e1 = gi * 8 + i1; e2 = gi * 8 + i2;
            l1 = atomicAdd((int*)(cl + e1), 1); l2 = atomicAdd((int*)(cl + e2), 1);
        }
        __syncthreads();
        if (tid < 32) bl[tid] = atomicAdd(cntg + tid, (int)cl[tid]);
        __syncthreads();
        if (lane < 16) {
            const int tok = tok0 + lane; const int p1 = bl[e1] + l1, p2 = bl[e2] + l2;
            tl[(size_t)e1 * NTOK + p1] = tok; rl[(size_t)e1 * NTOK + p1] = rstd;
            tl[(size_t)e2 * NTOK + p2] = tok; rl[(size_t)e2 * NTOK + p2] = rstd;
            ((int4*)(F.ws + WS_TOKREC))[tok] = make_int4(e1, p1, e2, p2);
            ((float2*)(F.ws + WS_TOKW))[tok] = make_float2(w1, w2);
        }
        __syncthreads();
    }
}

__device__ __forceinline__ int moe_offsets(Frame& F) {
    const int* cnt = (const int*)(F.ws + WS_CTL) + CW_CNT;
    if (F.tid == 0) { int o = 0; for (int e = 0; e < NEXP; ++e) { const int n = __hip_atomic_load(cnt + e, __ATOMIC_RELAXED, __HIP_MEMORY_SCOPE_AGENT); F.MISC[16 + e] = (unsigned)o; F.MISC[16 + 64 + e] = (unsigned)n; o += (n + 255) >> 8; } F.MISC[16 + NEXP] = (unsigned)o; }
    __syncthreads();
    return __builtin_amdgcn_readfirstlane((int)F.MISC[16 + NEXP]);
}

__device__ __forceinline__ void p7_final(Frame& F) {
    const int lane = F.lane; const int gw = F.vcu * NWAVES + F.wave, NGW = F.G * NWAVES;
    const volatile LAS int* toff = (const volatile LAS int*)(F.MISC + 16);
    const float* gf = F.in[19];
    const f32x4 g0a = *(const f32x4*)(gf + 8 * lane), g0b = *(const f32x4*)(gf + 8 * lane + 4), g1a = *(const f32x4*)(gf + 512 + 8 * lane), g1b = *(const f32x4*)(gf + 512 + 8 * lane + 4);
    const bf16_t* HBp = (const bf16_t*)(F.ws + WS_HB); const bf16_t* Yp = (const bf16_t*)(F.ws + WS_Y);
    for (int tok0 = gw * 4; tok0 < NTOK; tok0 += NGW * 4) {
        int4 rec[4]; float2 wt[4];
#pragma unroll
        for (int t = 0; t < 4; ++t) { rec[t] = ((const int4*)(F.ws + WS_TOKREC))[tok0 + t]; wt[t] = ((const float2*)(F.ws + WS_TOKW))[tok0 + t]; }
        u32x4 ra[4][2], rb[4][2], rc[4][2];
#pragma unroll
        for (int t = 0; t < 4; ++t) {
            const int s1 = toff[rec[t].x] * 256 + rec[t].y, s2 = toff[rec[t].z] * 256 + rec[t].w;
            const bf16_t* hb = HBp + (size_t)(tok0 + t) * DM + 8 * lane; const bf16_t* y1 = Yp + (size_t)s1 * DM + 8 * lane; const bf16_t* y2 = Yp + (size_t)s2 * DM + 8 * lane;
#pragma unroll
            for (int j = 0; j < 2; ++j) { ra[t][j] = __builtin_nontemporal_load((const u32x4*)(hb + 512 * j)); rb[t][j] = __builtin_nontemporal_load((const u32x4*)(y1 + 512 * j)); rc[t][j] = __builtin_nontemporal_load((const u32x4*)(y2 + 512 * j)); }
        }
#pragma unroll
        for (int t = 0; t < 4; ++t) {
            float z[16]; float ss = 0.f;
#pragma unroll
            for (int j = 0; j < 2; ++j)
#pragma unroll
                for (int q = 0; q < 4; ++q) {
                    const float lo = __uint_as_float(ra[t][j][q] << 16) + wt[t].x * __uint_as_float(rb[t][j][q] << 16) + wt[t].y * __uint_as_float(rc[t][j][q] << 16);
                    const float hi = __uint_as_float(ra[t][j][q] & 0xffff0000u) + wt[t].x * __uint_as_float(rb[t][j][q] & 0xffff0000u) + wt[t].y * __uint_as_float(rc[t][j][q] & 0xffff0000u);
                    z[8 * j + 2 * q] = lo; z[8 * j + 2 * q + 1] = hi; ss += lo * lo + hi * hi; }
            const float rstd = rsqrtf(wave_sum(ss) * (1.f / DM) + RMS_EPS);
            float* o = F.out + (size_t)(tok0 + t) * DM;
            __builtin_nontemporal_store((f32x4){z[0] * rstd * g0a[0], z[1] * rstd * g0a[1], z[2] * rstd * g0a[2], z[3] * rstd * g0a[3]}, (f32x4*)(o + 8 * lane));
            __builtin_nontemporal_store((f32x4){z[4] * rstd * g0b[0], z[5] * rstd * g0b[1], z[6] * rstd * g0b[2], z[7] * rstd * g0b[3]}, (f32x4*)(o + 8 * lane + 4));
            __builtin_nontemporal_store((f32x4){z[8] * rstd * g1a[0], z[9] * rstd * g1a[1], z[10] * rstd * g1a[2], z[11] * rstd * g1a[3]}, (f32x4*)(o + 512 + 8 * lane));
            __builtin_nontemporal_store((f32x4){z[12] * rstd * g1b[0], z[13] * rstd * g1b[1], z[14] * rstd * g1b[2], z[15] * rstd * g1b[3]}, (f32x4*)(o + 512 + 8 * lane + 4));
        }
    }
}

struct Args { const float* in[20]; float* out; unsigned char* ws; int ph_lo, ph_hi, li, pad; };
constexpr int N_PHASES = 8;
__global__ void __launch_bounds__(NWAVES * 64, 2) mk_fwd(Args args) {
    extern __shared__ __attribute__((aligned(16))) unsigned char lds_raw[];
    Frame F;
    F.lds = (LAS unsigned char*)lds_raw;
    F.MISC = (volatile LAS unsigned*)(F.lds + MISC_OFF);
    F.tid = threadIdx.x; F.lane = F.tid & 63; F.wave = __builtin_amdgcn_readfirstlane(F.tid >> 6);
    F.G = gridDim.x; { const int bx = blockIdx.x; F.vcu = (F.G % 8 == 0) ? (bx % 8) * (F.G / 8) + bx / 8 : bx; }
    F.in = args.in; F.out = args.out; F.ws = args.ws;
    unsigned char* ws = args.ws;
    for (int u = F.tid; u < 256; u += NWAVES * 64) F.MISC[u] = 0u;
    __syncthreads();
    const int lo = args.ph_lo, hi = args.ph_hi;
    XcdBarrier bar; bar.bar = (unsigned*)(ws + WS_CTL) + CW_BAR + args.li * XCD_BAR_WORDS; bar.x = 0; bar.st = nullptr;
    if (hi - lo > 1) bar = xcd_barrier_post((unsigned*)(ws + WS_CTL) + CW_BAR + args.li * XCD_BAR_WORDS, F.MISC + 8);
#define IN(k) (lo <= (k) && (k) < hi)
#define SEAM(k) do { if (IN(k) && IN((k) + 1)) xcd_barrier(bar, &F, (k) < 3 ? (k) : -1); } while (0)
    if (IN(0)) { p0_prologue(F); SEAM(0); }
    if (IN(1)) {
        pg8::Gemm g{(const bf16_t*)(ws + WS_XN), (const bf16_t*)(ws + WS_WIN_T), DM, 0}; pg8::StaticOrder S; S.init(NTOK, NPROJ, DM, F.G, (int)blockIdx.x);
        pg8::EpiBf16G E{(bf16_t*)(ws + WS_PROJ), NPROJ, 3, (f32x2*)(ws + WS_SSQ), 5, 0, (const float*)(ws + WS_RSX)};
        pg8::gemm_phase<pg8::EpiBf16G, pg8::StaticOrder>(F.lds, g, S, E);
        {
            const int nu = (NTOK / 256) * (NPROJ / 256), full = nu % F.G;
            if (full == 0) convert_rest<1>(F, (int)blockIdx.x * NWAVES + F.wave, F.G * NWAVES, 0, 1 << 30);
            else if ((int)blockIdx.x >= full) convert_rest<1>(F, ((int)blockIdx.x - full) * NWAVES + F.wave, (F.G - full) * NWAVES, 0, 1 << 30);
        }
        SEAM(1);
    }
    if (IN(2)) { p2_mix(F, args.pad); SEAM(2); }
    if (IN(3)) {
        pg8::Gemm g{(const bf16_t*)(ws + WS_MIXED), (const bf16_t*)(ws + WS_WO_T), DM, 0}; pg8::StaticOrder S; S.init(NTOK, DM, DM, F.G, (int)blockIdx.x);
        pg8::EpiH E{(const bf16_t*)(ws + WS_XN), (bf16_t*)(ws + WS_HB), (float*)(ws + WS_SSQ), (const LAS f32x2*)(F.lds + RING_BYTES), {-1, -1, -1, -1}};
        {
            LAS f32x2* tab = (LAS f32x2*)(F.lds + RING_BYTES); pg8::Unit uu;
            for (int i = 0; i < 4 && S.next(i, uu); ++i) { E.pms[i] = uu.pm;
                if (F.tid < 256) { const f32x4* sp = (const f32x4*)((const float*)(ws + WS_SSQM) + (size_t)(uu.pm * 256 + F.tid) * 16); const f32x4 a = sp[0], b = sp[1], c = sp[2], d = sp[3];
                    const float sa = ((a[0] + a[1]) + (a[2] + a[3])) + ((b[0] + b[1]) + (b[2] + b[3])), sg = ((c[0] + c[1]) + (c[2] + c[3])) + ((d[0] + d[1]) + (d[2] + d[3]));
                    const float ra = rsqrtf(sa * (1.f / 512) + RMS_EPS), rg = rsqrtf(sg * (1.f / 512) + RMS_EPS); tab[i * 256 + F.tid] = (f32x2){ra / rg, rg}; } }
            __syncthreads();
        }
        pg8::gemm_phase<pg8::EpiH, pg8::StaticOrder>(F.lds, g, S, E);
        SEAM(3);
    }
    if (IN(4)) { p4_router(F); SEAM(4); }
    if (IN(5) || IN(6) || IN(7)) {
        const int ntiles = moe_offsets(F);
        const volatile LAS int* toff = (const volatile LAS int*)(F.MISC + 16);
        const int* cnt = (const int*)(ws + WS_CTL) + CW_CNT;
        if (IN(5)) {
            pg8::Gemm g{(const bf16_t*)(ws + WS_HB), (const bf16_t*)(ws + WS_WGU_T), DM, 0};
            MoeOrder<true> S{toff, cnt, (const int*)(ws + WS_TOKLIST), 2, ntiles * 2, F.G, (int)blockIdx.x, DM, 512};
            EpiSwiglu E{(bf16_t*)(ws + WS_HID), (const float*)(ws + WS_RSLIST)};
            pg8::gemm_phase<EpiSwiglu, MoeOrder<true>>(F.lds, g, S, E);
            {
                const int nu = ntiles * 2, full = nu % F.G;
                if (full == 0) convert_rest<2>(F, (int)blockIdx.x * NWAVES + F.wave, F.G * NWAVES, 0, 1 << 30);
                else if ((int)blockIdx.x >= full) convert_rest<2>(F, ((int)blockIdx.x - full) * NWAVES + F.wave, (F.G - full) * NWAVES, 0, 1 << 30);
            }
            SEAM(5);
        }
        if (IN(6)) {
            pg8::Gemm g{(const bf16_t*)(ws + WS_HID), (const bf16_t*)(ws + WS_WD_T), DEXP, 0};
            MoeOrder<false> S{toff, cnt, (const int*)(ws + WS_TOKLIST), 4, ntiles * 4, F.G, (int)blockIdx.x, DEXP, DM};
            pg8::EpiBf16G E{(bf16_t*)(ws + WS_Y), DM, 1000, nullptr, 1000, 0, nullptr};
            pg8::gemm_phase<pg8::EpiBf16G, MoeOrder<false>>(F.lds, g, S, E);
            SEAM(6);
        }
        if (IN(7)) p7_final(F);
    }
#undef IN
#undef SEAM
}
extern "C" void kernel_launch(void* const* d_in, const int* in_sizes, int n_in, void* d_out, int out_size, void* d_ws, size_t ws_size, hipStream_t stream) {
    static int grid = 0;
    if (grid == 0) {
        if (n_in != 20 || in_sizes[0] != NTOK * DM || out_size != NTOK * DM || ws_size < WS_END) {
            fprintf(stderr, "kernel_launch: unexpected shapes (n_in %d, in0 %d, out %d, ws %zu)\n", n_in, n_in > 0 ? in_sizes[0] : -1, out_size, ws_size); grid = -1; return; }
        int dev = 0, cus = 0, per_cu = 0;
        if (hipGetDevice(&dev) != hipSuccess || hipDeviceGetAttribute(&cus, hipDeviceAttributeMultiprocessorCount, dev) != hipSuccess) { fprintf(stderr, "kernel_launch: device query failed\n"); grid = -1; return; }
        if (hipFuncSetAttribute((const void*)mk_fwd, hipFuncAttributeMaxDynamicSharedMemorySize, LDS_BYTES) != hipSuccess) { fprintf(stderr, "kernel_launch: hipFuncSetAttribute(%d B LDS) failed\n", LDS_BYTES); grid = -1; return; }
        if (hipOccupancyMaxActiveBlocksPerMultiprocessor(&per_cu, (const void*)mk_fwd, NWAVES * 64, LDS_BYTES) != hipSuccess || per_cu < 1)
            fprintf(stderr, "kernel_launch: note: occupancy query reports %d workgroups per CU\n", per_cu);
        (void)hipGetLastError();
        grid = cus;
    }
    if (grid < 0) return;
    Params p{};
    for (int i = 0; i < 20; ++i) p.in[i] = (const float*)d_in[i];
    p.out = (float*)d_out; p.ws = (unsigned char*)d_ws;
    unsigned char* ws = p.ws;
    (void)hipMemsetAsync(ws + WS_CTL, 0, CTL_ZERO_BYTES, stream);
    const int* cnt = (const int*)(ws + WS_CTL) + CW_CNT;
    Args a{};
    for (int i = 0; i < 20; ++i) a.in[i] = (const float*)d_in[i];
    a.out = (float*)d_out; a.ws = ws;
#ifndef REP_PH
#define REP_PH -1
#endif
    constexpr int rp = REP_PH;
    int li = 0;
#ifdef CUM_PH
    { a.ph_lo = 0; a.ph_hi = CUM_PH; a.li = li++; hipLaunchKernelGGL(mk_fwd, dim3(grid), dim3(NWAVES * 64), LDS_BYTES, stream, a);
      (void)hipMemsetAsync(ws + WS_CTL + CW_CNT * 4, 0, NEXP * 4, stream); }
#endif
    if (rp < 0) { a.ph_lo = 0; a.ph_hi = N_PHASES; a.li = li++; hipLaunchKernelGGL(mk_fwd, dim3(grid), dim3(NWAVES * 64), LDS_BYTES, stream, a); }
    else {
        a.ph_lo = 0; a.ph_hi = rp + 1; a.li = li++; hipLaunchKernelGGL(mk_fwd, dim3(grid), dim3(NWAVES * 64), LDS_BYTES, stream, a);
        if (rp == 4) (void)hipMemsetAsync(ws + WS_CTL + CW_CNT * 4, 0, NEXP * 4, stream);
#ifdef REP_P2
        a.pad = REP_P2;
#endif
#ifdef REP_GRID
        a.ph_lo = rp; a.ph_hi = rp + 1; a.li = li++; hipLaunchKernelGGL(mk_fwd, dim3(REP_GRID), dim3(NWAVES * 64), LDS_BYTES, stream, a);
#else
        a.ph_lo = rp; a.ph_hi = rp + 1; a.li = li++; hipLaunchKernelGGL(mk_fwd, dim3(grid), dim3(NWAVES * 64), LDS_BYTES, stream, a);
#endif
        a.pad = 0;
        if (rp + 1 < N_PHASES) { a.ph_lo = rp + 1; a.ph_hi = N_PHASES; a.li = li++; hipLaunchKernelGGL(mk_fwd, dim3(grid), dim3(NWAVES * 64), LDS_BYTES, stream, a); }
    }
    (void)p; (void)cnt;
}
```

```cpp
#include <hip/hip_runtime.h>
#include <cstdio>
#include <cstdint>
#include <cmath>

constexpr int BATCH = 4, SEQ = 8192, DM = 1024, NTOK = BATCH * SEQ;
constexpr int NPROJ = 1792;
constexpr int C_Q = 0, C_K = 512, C_V = 640, C_GU = 768, C_GV = 1280;
constexpr int NEXP = 32, DEXP = 256, NGRP = 4, EPG = 8;
constexpr int SLOT_CAP = 2 * NTOK + NEXP * 256;
constexpr float RMS_EPS = 1e-6f, LN_EPS = 1e-5f;

typedef unsigned short bf16_t;
__device__ __forceinline__ float bf2f(bf16_t v) { return __uint_as_float((unsigned)v << 16); }
__device__ __forceinline__ bf16_t f2bf(float f) { unsigned u = __float_as_uint(f); return (bf16_t)((u + 0x7fffu + ((u >> 16) & 1u)) >> 16); }

constexpr size_t MiB = 1u << 20;
constexpr size_t WS_CTL = 0, CTL_ZERO_BYTES = 1 * MiB;
constexpr size_t WS_TOKLIST = 58 * MiB;
constexpr size_t WS_RSLIST = 62 * MiB;
constexpr size_t WS_TOKREC = 66 * MiB;
constexpr size_t WS_TOKW = 67 * MiB;
constexpr size_t WS_SSQ = 68 * MiB;
constexpr size_t WS_XN = 72 * MiB;
constexpr size_t WS_PROJ = 136 * MiB;
constexpr size_t WS_MIXED = 248 * MiB;
constexpr size_t WS_HB = 312 * MiB;
constexpr size_t WS_HID = 376 * MiB;
constexpr size_t WS_Y = 72 * MiB;
constexpr size_t WS_AF = 412 * MiB;
constexpr size_t WS_VN = 72 * MiB;
constexpr size_t WS_HF = 376 * MiB;
constexpr size_t WS_END = 512 * MiB;
constexpr int CW_CNT = 64;

struct Params {
    const float* in[20];
    float* out;
    unsigned char* ws;
};

__device__ __forceinline__ float wave_sum(float v) {
#pragma unroll
    for (int o = 1; o < 64; o <<= 1) v += __shfl_xor(v, o);
    return v;
}
__device__ __forceinline__ float gelu_exact(float v) { return 0.5f * v * (1.0f + erff(v * 0.70710678118654752f)); }

#define LAS __attribute__((address_space(3)))
#define GAS __attribute__((address_space(1)))
typedef short bf16x8 __attribute__((ext_vector_type(8)));
typedef short s16x4 __attribute__((ext_vector_type(4)));
typedef float f32x4 __attribute__((ext_vector_type(4)));
typedef float f32x16 __attribute__((ext_vector_type(16)));
typedef float f32x2 __attribute__((ext_vector_type(2)));
typedef unsigned u32x4 __attribute__((ext_vector_type(4)));
typedef unsigned u32x2 __attribute__((ext_vector_type(2)));
typedef GAS unsigned gu32;

constexpr size_t WS_WIN_T = 2 * MiB;
constexpr size_t WS_WO_T = 6 * MiB;
constexpr size_t WS_WSP = 8 * MiB;
constexpr size_t WS_WR_T = 8 * MiB + 512 * 1024;
constexpr size_t WS_SSQM = 70 * MiB;
constexpr size_t WS_RSX = 9 * MiB;
constexpr size_t WS_WGU_T = 10 * MiB;
constexpr size_t WS_WD_T = 42 * MiB;
constexpr int CW_TMO = 0;
constexpr int CW_BAR = 4096;

constexpr int NWAVES = 8;
constexpr int RING_BYTES = 131072;
constexpr int LDS_BYTES = 163840;
constexpr int MISC_OFF = 163840 - 1024;
constexpr float LOG2E = 1.4426950408889634f;

__device__ __forceinline__ unsigned cvt_pk_bf16(float lo, float hi) { unsigned r; asm volatile("v_cvt_pk_bf16_f32 %0, %1, %2" : "=v"(r) : "v"(lo), "v"(hi)); return r; }
#define MFMA32(a, b, c) __builtin_amdgcn_mfma_f32_32x32x16_bf16((a), (b), (c), 0, 0, 0)
#define MFMA16(a, b, c) __builtin_amdgcn_mfma_f32_16x16x32_bf16((a), (b), (c), 0, 0, 0)
typedef short v4i16_t __attribute__((ext_vector_type(4)));
__device__ __forceinline__ s16x4 vtr(const LAS unsigned char* p) { return __builtin_bit_cast(s16x4, __builtin_amdgcn_ds_read_tr16_b64_v4i16((LAS v4i16_t*)p)); }

namespace pg8 {
constexpr int BM = 256, BK = 64, HALF = 128, HTB = HALF * BK * 2, STAGE_BYTES = 8 * HTB, NXCD = 8, WGM = 8;
__host__ __device__ __forceinline__ int lds_byte(int r, int c) { const int st = (r >> 4) * 2 + (c >> 5), rr = r & 15, cc = c & 31, ob = rr * 64 + cc * 2; return st * 1024 + (ob ^ (((ob >> 9) & 1) << 5)); }
__host__ __device__ __forceinline__ void stage_rc(int b, int& R, int& C) { const int st = b / 1024, sb = b % 1024, swz = sb ^ (((sb >> 9) & 1) << 5); R = (st >> 1) * 16 + swz / 64; C = (st & 1) * 32 + (swz % 64) / 2; }
__host__ __device__ __forceinline__ int perm32(int rho) { const int n = rho >> 4, i = rho & 15; return 8 * (i >> 2) + 4 * n + (i & 3); }

struct Unit { int pm, pn, e, pos0, ne, nv; };
struct Gemm { const bf16_t* A; const bf16_t* Bt; int K; int pad; };

__device__ __forceinline__ int xcd_remap(int L, int nwg) { const int q = nwg / NXCD, r = nwg % NXCD, xcd = L % NXCD, off = L / NXCD; return (xcd < r ? xcd * (q + 1) : r * (q + 1) + (xcd - r) * q) + off; }

struct StaticOrder {
    int nM, nN, nwg, G, c, K;
    __device__ void init(int M, int N, int K_, int G_, int c_) { nM = M / BM; nN = N / BM; nwg = nM * nN; G = G_; c = c_; K = K_; }
    __device__ __forceinline__ bool next(int i, Unit& u) const {
        const long L = (long)i * G + c; if (L >= nwg) return false;
        const int wgid = xcd_remap((int)L, nwg);
        const int nig = WGM * nN, gid = wgid / nig, fm = gid * WGM, gsz = (nM - fm) < WGM ? (nM - fm) : WGM;
        u.pm = fm + ((wgid % nig) % gsz); u.pn = (wgid % nig) / gsz; u.e = 0; u.pos0 = 0; u.ne = 0; u.nv = BM; return true;
    }
    __device__ __forceinline__ size_t b_off(const Unit& u) const { return (size_t)u.pn * BM * K; }
    __device__ __forceinline__ int a_row(const Unit& u, int r) const { return u.pm * BM + r; }
};

template <class Epi, class Sched>
__device__ __forceinline__ void gemm_phase(LAS unsigned char* lds, const Gemm g, const Sched& S, const Epi& E) {
    const int tid = threadIdx.x, wid = __builtin_amdgcn_readfirstlane(tid >> 6), lane = tid & 63, wr = wid >> 2, wc = wid & 3, fr = lane & 15, fq = lane >> 4;
    const int K = g.K, nt = K / BK;
    unsigned voffB[2];
#pragma unroll
    for (int i = 0; i < 2; ++i) { int R, C; stage_rc(tid * 16 + i * 8192, R, C); const int Rb = Epi::PERM ? ((R >> 5) * 64 + perm32(R & 31)) : R;
        voffB[i] = (unsigned)(Rb * K + C) * 2u; }
    const size_t kstep = (size_t)(BK * 2);
    const size_t hstep = (size_t)(Epi::PERM ? 32 : HALF) * K * 2;
    const unsigned ldsw = (unsigned)wid * 1024u;
    const int aoff = lds_byte(wr * 64 + fr, fq * 8), boff = lds_byte(wc * 32 + fr, fq * 8);
#define PG8_SA(b, h) (((b) * 2 + (h)) * HTB)
#define PG8_SB(b, h) ((4 + (b) * 2 + (h)) * HTB)
#define PG8_STAGE2(bufoff, gbase, v0, v1) do { \
        __builtin_amdgcn_global_load_lds((const unsigned*)((const char*)(gbase) + (v0)), (LAS unsigned*)(lds + (bufoff) + ldsw), 16, 0, 0); \
        __builtin_amdgcn_global_load_lds((const unsigned*)((const char*)(gbase) + (v1)), (LAS unsigned*)(lds + (bufoff) + ldsw + 8192), 16, 0, 0); } while (0)
#define PG8_STAGEB(bufoff, gbase) PG8_STAGE2(bufoff, gbase, voffB[0], voffB[1])
#define PG8_VOFFA(dst, U) do { _Pragma("unroll") for (int _i = 0; _i < 2; ++_i) { int _R, _C; stage_rc(threadIdx.x * 16 + _i * 8192, _R, _C); _Pragma("unroll") for (int _h = 0; _h < 2; ++_h) \
        dst[_h][_i] = ((unsigned)S.a_row(U, _h * HALF + _R) * (unsigned)K + (unsigned)_C) * 2u; } } while (0)
#define PG8_LDA(dst, b, h) do { _Pragma("unroll") for (int m = 0; m < 4; ++m) _Pragma("unroll") for (int k = 0; k < 2; ++k) dst[m][k] = *(const LAS bf16x8*)(lds + PG8_SA(b, h) + aoff + m * 2048 + k * 1024); } while (0)
#define PG8_LDB(dst, b, h) do { _Pragma("unroll") for (int n = 0; n < 2; ++n) _Pragma("unroll") for (int k = 0; k < 2; ++k) dst[n][k] = *(const LAS bf16x8*)(lds + PG8_SB(b, h) + boff + n * 2048 + k * 1024); } while (0)
#define PG8_MMA(ai, bj, At, Bt) do { if ((ai) * HALF + wr * 64 < cur.nv) { __builtin_amdgcn_s_setprio(1); _Pragma("unroll") for (int m = 0; m < 4; ++m) _Pragma("unroll") for (int n = 0; n < 2; ++n) _Pragma("unroll") for (int k = 0; k < 2; ++k) \
        acc[ai][bj][m][n] = __builtin_amdgcn_mfma_f32_16x16x32_bf16(Bt[n][k], At[m][k], acc[ai][bj][m][n], 0, 0, 0); __builtin_amdgcn_s_setprio(0); } } while (0)
#define PG8_WAIT_V(n) asm volatile("s_waitcnt vmcnt(" #n ")" ::: "memory")
#define PG8_WAIT_L(n) asm volatile("s_waitcnt lgkmcnt(" #n ")" ::: "memory")
#define PG8_BAR __builtin_amdgcn_s_barrier()
#define PG8_SCHED __builtin_amdgcn_sched_barrier(0)
    Unit cur, nxt; int ui = 0;
    if (!S.next(0, cur)) return;
    f32x4 acc[2][2][4][2];
#pragma unroll
    for (int a = 0; a < 2; ++a)
#pragma unroll
        for (int b = 0; b < 2; ++b)
#pragma unroll
            for (int m = 0; m < 4; ++m)
#pragma unroll
                for (int n = 0; n < 2; ++n) acc[a][b][m][n] = (f32x4){0.f, 0.f, 0.f, 0.f};
    bf16x8 At[4][2], B0[2][2], B1[2][2];
    const char* Ab = (const char*)g.A;
    const char* cB = (const char*)(g.Bt + S.b_off(cur));
    unsigned vA[2][2], nvA[2][2];
    PG8_VOFFA(vA, cur);
    PG8_STAGEB(PG8_SB(0, 0), cB); PG8_STAGEB(PG8_SB(0, 1), cB + hstep); PG8_STAGE2(PG8_SA(0, 0), Ab, vA[0][0], vA[0][1]); PG8_STAGE2(PG8_SA(0, 1), Ab, vA[1][0], vA[1][1]);
    if (wr == 1) PG8_BAR;
    PG8_WAIT_V(2); PG8_BAR;
    PG8_STAGEB(PG8_SB(1, 0), cB + kstep); PG8_STAGE2(PG8_SA(1, 0), Ab + kstep, vA[0][0], vA[0][1]); PG8_STAGEB(PG8_SB(1, 1), cB + hstep + kstep);
    PG8_WAIT_V(6); PG8_BAR;
    for (;;) {
        const bool has_next = S.next(ui + 1, nxt);
        const char* nB = cB;
#pragma unroll
        for (int h = 0; h < 2; ++h)
#pragma unroll
            for (int i = 0; i < 2; ++i) nvA[h][i] = vA[h][i];
        if (has_next) { nB = (const char*)(g.Bt + S.b_off(nxt)); PG8_VOFFA(nvA, nxt); }
        for (int t = 0; t < nt; t += 2) {
            const bool last = (t == nt - 2);
            const char* a1 = Ab + (size_t)(t + 1) * kstep;
            const char* a2 = last ? Ab : Ab + (size_t)(t + 2) * kstep; const char* b2 = last ? nB : cB + (size_t)(t + 2) * kstep;
            const char* a3 = a2 + kstep; const char* b3 = b2 + kstep;
            if constexpr (Epi::MIDK >= 0) { if (t == Epi::MIDK) E.mid(acc, cur, wr, fr); }
            unsigned o00 = vA[0][0], o01 = vA[0][1], o10 = vA[1][0], o11 = vA[1][1];
            if (last) { asm volatile("" : "+v"(nvA[0][0]), "+v"(nvA[0][1]), "+v"(nvA[1][0]), "+v"(nvA[1][1])); o00 = nvA[0][0]; o01 = nvA[0][1]; o10 = nvA[1][0]; o11 = nvA[1][1]; }
            PG8_LDB(B0, 0, 0); PG8_LDB(B1, 0, 1); PG8_SCHED; PG8_LDA(At, 0, 0); PG8_STAGE2(PG8_SA(1, 1), a1, vA[1][0], vA[1][1]);
            PG8_WAIT_V(8); PG8_WAIT_L(0); PG8_BAR; PG8_MMA(0, 0, At, B0); PG8_MMA(0, 1, At, B1); PG8_BAR; PG8_SCHED;
            PG8_LDA(At, 0, 1); PG8_STAGEB(PG8_SB(0, 0), b2); PG8_STAGEB(PG8_SB(0, 1), b2 + hstep); PG8_STAGE2(PG8_SA(0, 0), a2, o00, o01);
            PG8_WAIT_V(8); PG8_WAIT_L(0); PG8_BAR; PG8_MMA(1, 0, At, B0); PG8_MMA(1, 1, At, B1); PG8_BAR; PG8_SCHED;
            PG8_LDB(B0, 1, 0); PG8_LDB(B1, 1, 1); PG8_SCHED; PG8_LDA(At, 1, 0); PG8_STAGE2(PG8_SA(0, 1), a2, o10, o11);
            PG8_WAIT_V(8); PG8_WAIT_L(0); PG8_BAR; PG8_MMA(0, 0, At, B0); PG8_MMA(0, 1, At, B1); PG8_BAR; PG8_SCHED;
            PG8_LDA(At, 1, 1); PG8_STAGEB(PG8_SB(1, 0), b3); PG8_STAGEB(PG8_SB(1, 1), b3 + hstep); PG8_STAGE2(PG8_SA(1, 0), a3, o00, o01);
            PG8_WAIT_V(8); PG8_WAIT_L(0); PG8_BAR; PG8_MMA(1, 0, At, B0); PG8_MMA(1, 1, At, B1); PG8_BAR; PG8_SCHED;
        }
        if (wr == 0) PG8_BAR;
        E(acc, cur, wr, wc, fr, fq);
        if (!has_next) break;
#pragma unroll
        for (int a = 0; a < 2; ++a)
#pragma unroll
            for (int b = 0; b < 2; ++b)
#pragma unroll
                for (int m = 0; m < 4; ++m)
#pragma unroll
                    for (int n = 0; n < 2; ++n) acc[a][b][m][n] = (f32x4){0.f, 0.f, 0.f, 0.f};
        cur = nxt; cB = nB; ++ui;
#pragma unroll
        for (int h = 0; h < 2; ++h)
#pragma unroll
            for (int i = 0; i < 2; ++i) vA[h][i] = nvA[h][i];
        if (wr == 1) PG8_BAR;
    }
    PG8_WAIT_V(0);
    PG8_BAR;
#undef PG8_SA
#undef PG8_SB
#undef PG8_STAGE2
#undef PG8_STAGEB
#undef PG8_VOFFA
#undef PG8_LDA
#undef PG8_LDB
#undef PG8_MMA
#undef PG8_WAIT_V
#undef PG8_WAIT_L
#undef PG8_BAR
#undef PG8_SCHED
}

__device__ __forceinline__ f32x2 gelu_pk(f32x2 v) {
    const f32x2 av = __builtin_elementwise_abs(v), d = av * 0.2316418882f + 1.0f;
    f32x2 t; t.x = __builtin_amdgcn_rcpf(d.x); t.y = __builtin_amdgcn_rcpf(d.y);
    f32x2 q = t * 0.5307027145f + (-0.7265760135f); q = q * t + 0.7107068705f; q = q * t + (-0.142248368f); q = q * t + 0.127414796f; q = q * t;
    const f32x2 s = (v * v) * (-0.72134752044f);
    f32x2 e; e.x = __builtin_amdgcn_exp2f(s.x); e.y = __builtin_amdgcn_exp2f(s.y);
    const f32x2 m = v * (q * e), r = v - m;
    f32x2 o; o.x = v.x < 0.f ? m.x : r.x; o.y = v.y < 0.f ? m.y : r.y; return o;
}

struct EpiBf16G {   static constexpr int MIDK = -1;
    static constexpr bool PERM = true;
    bf16_t* O; int ldc; int gelu_from; f32x2* STAT; int stat_from; int pad; const float* rowscale;
    __device__ __forceinline__ void operator()(const f32x4 (&acc)[2][2][4][2], const Unit& u, int wr, int wc, int fr, int fq) const {
        const int row0 = u.pm * BM + wr * 64 + fr, col0 = u.pn * BM + wc * 64 + 8 * fq, rl0 = wr * 64 + fr;
        const bool act = u.pn >= gelu_from, st = u.pn >= stat_from;
#pragma unroll
        for (int ai = 0; ai < 2; ++ai)
#pragma unroll
            for (int m = 0; m < 4; ++m) { bf16_t* rowp = O + (size_t)(row0 + ai * HALF + m * 16) * ldc + col0; float s1 = 0.f, s2 = 0.f;
                const bool live = rl0 + ai * HALF + m * 16 < u.nv; const float rsc = rowscale ? rowscale[row0 + ai * HALF + m * 16] : 1.f;
#pragma unroll
                for (int bj = 0; bj < 2; ++bj) { f32x4 v0 = acc[ai][bj][m][0] * rsc, v1 = acc[ai][bj][m][1] * rsc;
                    if (act) { f32x2 a = gelu_pk((f32x2){v0[0], v0[1]}), b = gelu_pk((f32x2){v0[2], v0[3]}), c = gelu_pk((f32x2){v1[0], v1[1]}), d = gelu_pk((f32x2){v1[2], v1[3]});
                        v0 = (f32x4){a.x, a.y, b.x, b.y}; v1 = (f32x4){c.x, c.y, d.x, d.y}; }
                    if (st) { s1 += (v0[0] + v0[1]) + (v0[2] + v0[3]) + (v1[0] + v1[1]) + (v1[2] + v1[3]);
                        s2 += (v0[0] * v0[0] + v0[1] * v0[1]) + (v0[2] * v0[2] + v0[3] * v0[3]) + (v1[0] * v1[0] + v1[1] * v1[1]) + (v1[2] * v1[2] + v1[3] * v1[3]); }
                    u32x4 w; w.x = cvt_pk_bf16(v0[0], v0[1]); w.y = cvt_pk_bf16(v0[2], v0[3]); w.z = cvt_pk_bf16(v1[0], v1[1]); w.w = cvt_pk_bf16(v1[2], v1[3]);
                    if (live) *(u32x4*)(rowp + bj * 32) = w; }
                if (st) { s1 += __shfl_xor(s1, 16); s1 += __shfl_xor(s1, 32); s2 += __shfl_xor(s2, 16); s2 += __shfl_xor(s2, 32);
                    if (fq == 0) STAT[(size_t)(row0 + ai * HALF + m * 16) * 8 + (u.pn - stat_from) * 4 + wc] = (f32x2){s1, s2}; } }
    }
};
struct EpiH {
    static constexpr bool PERM = true;
    static constexpr int MIDK = 8;
    const bf16_t* x; bf16_t* HB; float* SSQ; const LAS f32x2* tab; int pms[4];
    __device__ __forceinline__ int slot(const Unit& u) const { return u.pm == pms[0] ? 0 : (u.pm == pms[1] ? 1 : (u.pm == pms[2] ? 2 : 3)); }
    __device__ __forceinline__ void mid(f32x4 (&acc)[2][2][4][2], const Unit& u, int wr, int fr) const {
        const LAS f32x2* t = tab + slot(u) * 256 + wr * 64 + fr;
#pragma unroll
        for (int ai = 0; ai < 2; ++ai)
#pragma unroll
            for (int m = 0; m < 4; ++m) { const float sc = t[ai * HALF + m * 16].x;
#pragma unroll
                for (int bj = 0; bj < 2; ++bj)
#pragma unroll
                    for (int n = 0; n < 2; ++n) acc[ai][bj][m][n] *= sc; }
    }
    __device__ __forceinline__ void operator()(const f32x4 (&acc)[2][2][4][2], const Unit& u, int wr, int wc, int fr, int fq) const {
        const int row0 = u.pm * BM + wr * 64 + fr, col0 = u.pn * BM + wc * 64 + 8 * fq;
        const LAS f32x2* t = tab + slot(u) * 256 + wr * 64 + fr;
#pragma unroll
        for (int ai = 0; ai < 2; ++ai)
#pragma unroll
            for (int m = 0; m < 4; ++m) { const int row = row0 + ai * HALF + m * 16; const bf16_t* xr = x + (size_t)row * DM + col0; bf16_t* hr = HB + (size_t)row * DM + col0; float s = 0.f;
                const float rg = t[ai * HALF + m * 16].y;
#pragma unroll
                for (int bj = 0; bj < 2; ++bj) { const u32x4 xw = *(const u32x4*)(xr + bj * 32);
                    const f32x4 x0 = (f32x4){__uint_as_float(xw.x << 16), __uint_as_float(xw.x & 0xffff0000u), __uint_as_float(xw.y << 16), __uint_as_float(xw.y & 0xffff0000u)}, x1 = (f32x4){__uint_as_float(xw.z << 16), __uint_as_float(xw.z & 0xffff0000u), __uint_as_float(xw.w << 16), __uint_as_float(xw.w & 0xffff0000u)};
                    const f32x4 v0 = acc[ai][bj][m][0] * rg + x0, v1 = acc[ai][bj][m][1] * rg + x1;
                    s += (v0[0] * v0[0] + v0[1] * v0[1]) + (v0[2] * v0[2] + v0[3] * v0[3]) + (v1[0] * v1[0] + v1[1] * v1[1]) + (v1[2] * v1[2] + v1[3] * v1[3]);
                    u32x4 w; w.x = cvt_pk_bf16(v0[0], v0[1]); w.y = cvt_pk_bf16(v0[2], v0[3]); w.z = cvt_pk_bf16(v1[0], v1[1]); w.w = cvt_pk_bf16(v1[2], v1[3]);
                    *(u32x4*)(hr + bj * 32) = w; }
                s += __shfl_xor(s, 16); s += __shfl_xor(s, 32);
                if (fq == 0) SSQ[(size_t)row * 16 + u.pn * 4 + wc] = s; }
    }
};
}

template <bool GATHER>
struct MoeOrder {
    const volatile LAS int* toff;
    const int* cnt; const int* toklist;
    int nN, nwg, G, c, K, rows_per_e;
    __device__ __forceinline__ bool next(int i, pg8::Unit& u) const {
        const long L = (long)i * G + c; if (L >= nwg) return false;
        const int wgid = pg8::xcd_remap((int)L, nwg);
        const int T = wgid / nN; u.pn = wgid % nN; u.pm = T;
        int e = 0;
        for (int j = 1; j < NEXP; ++j) e += (toff[j] <= T) ? 1 : 0;
        e = __builtin_amdgcn_readfirstlane(e);
        u.e = e; u.pos0 = __builtin_amdgcn_readfirstlane((T - toff[e]) * 256); u.ne = __builtin_amdgcn_readfirstlane(toff[64 + e]); { const int left = u.ne - u.pos0; u.nv = left < 256 ? left : 256; } return true;
    }
    __device__ __forceinline__ size_t b_off(const pg8::Unit& u) const { return ((size_t)u.e * rows_per_e + (size_t)u.pn * 256) * K; }
    __device__ __forceinline__ int a_row(const pg8::Unit& u, int r) const {
        if (!GATHER) return u.pm * 256 + r;
        const int pos = u.pos0 + r;
        return pos < u.ne ? toklist[(size_t)u.e * NTOK + pos] : 0;
    }
};
struct EpiSwiglu {   static constexpr int MIDK = -1;
    static constexpr bool PERM = true;
    bf16_t* HID; const float* rslist;
    __device__ __forceinline__ void operator()(const f32x4 (&acc)[2][2][4][2], const pg8::Unit& u, int wr, int wc, int fr, int fq) const {
        const int r0 = wr * 64 + fr, col0 = u.pn * 128 + wc * 32 + 8 * fq; const int pos0 = u.pos0, n_e = u.ne;
#pragma unroll
        for (int ai = 0; ai < 2; ++ai)
#pragma unroll
            for (int m = 0; m < 4; ++m) { const int r = r0 + ai * 128 + m * 16, pos = pos0 + r;
                const float rs = pos < n_e ? rslist[(size_t)u.e * NTOK + pos] : 0.f;
                float o[8];
#pragma unroll
                for (int n = 0; n < 2; ++n)
#pragma unroll
                    for (int j = 0; j < 4; ++j) { const float gt = acc[ai][0][m][n][j] * rs, up = acc[ai][1][m][n][j] * rs;
                        o[4 * n + j] = gt * __builtin_amdgcn_rcpf(1.f + __builtin_amdgcn_exp2f(-gt * LOG2E)) * up; }
                u32x4 w; w.x = cvt_pk_bf16(o[0], o[1]); w.y = cvt_pk_bf16(o[2], o[3]); w.z = cvt_pk_bf16(o[4], o[5]); w.w = cvt_pk_bf16(o[6], o[7]);
                if (r < u.nv || true) *(u32x4*)(HID + (size_t)(u.pm * 256 + r) * DEXP + col0) = w; }
    }
};

#define XB_TMO      128
#define XB_XCNT(j)  (256  + 64 * (j))
#define XB_XSUB(j)  (1280 + 64 * (j))
#define XB_XGEN(j)  (2304 + 64 * (j))
#define XB_TOP      3328
#define XB_TOPGEN   3392
#define XCD_BAR_WORDS 3456
#define XB_SPIN_CAP (1u << 18)
__device__ __forceinline__ unsigned xb_ld(unsigned* p)              { return __hip_atomic_load(p, __ATOMIC_RELAXED, __HIP_MEMORY_SCOPE_AGENT); }
__device__ __forceinline__ unsigned xb_add(unsigned* p, unsigned v) { return __hip_atomic_fetch_add(p, v, __ATOMIC_RELAXED, __HIP_MEMORY_SCOPE_AGENT); }
__device__ __forceinline__ unsigned xb_xcc_id() { return (unsigned)__builtin_amdgcn_s_getreg((3 << 11) | 20) & 0xFu; }
#define XB_SPIN(cond, bar) do { unsigned _sp = 0; while (cond) { __builtin_amdgcn_s_sleep(1); \
    if ((++_sp & 255u) == 0u) { if (xb_ld(&(bar)[XB_TMO])) break; if (_sp > XB_SPIN_CAP) { atomicAdd(&(bar)[XB_TMO], 1u); break; } } } } while (0)
struct XcdBarrier { unsigned* bar; unsigned x; volatile LAS unsigned* st; };
__device__ __forceinline__ XcdBarrier xcd_barrier_post(unsigned* bar, volatile LAS unsigned* st) {
    XcdBarrier b; b.bar = bar; b.x = xb_xcc_id(); b.st = st;
    if (threadIdx.x == 0) (void)xb_add(&bar[XB_XCNT(b.x)], 1u);
    return b;
}
__device__ __forceinline__ void xcd_barrier_complete(unsigned* bar, unsigned x, unsigned& nloc, unsigned& nx) {
    const unsigned G = gridDim.x * gridDim.y * gridDim.z;
    unsigned sum, cnt, mine, sp = 0u;
    for (;;) {
        sum = 0u; cnt = 0u; mine = 0u;
#pragma unroll
        for (unsigned j = 0; j < 16; ++j) { const unsigned c = xb_ld(&bar[XB_XCNT(j)]); sum += c; cnt += (c > 0u) ? 1u : 0u; mine = (j == x) ? c : mine; }
        if (sum == G) break;
        __builtin_amdgcn_s_sleep(1);
        if ((++sp & 255u) == 0u) { if (xb_ld(&bar[XB_TMO])) break; if (sp > XB_SPIN_CAP) { atomicAdd(&bar[XB_TMO], 1u); break; } }
    }
    nloc = mine > 0u ? mine : 1u; nx = cnt > 0u ? cnt : 1u;
}
struct Frame;
template <int WHICH> __device__ __forceinline__ void convert_rest(Frame& F, int part, int nparts, int lo, int hi);
__device__ __forceinline__ void barrier_background(Frame& F, int bg);
__device__ __forceinline__ void xcd_barrier(const XcdBarrier& b, Frame* Fp = nullptr, int bg = -1) {
    asm volatile("s_waitcnt vmcnt(0)" ::: "memory");
    __syncthreads();
    if (bg >= 0 && threadIdx.x >= 64) barrier_background(*Fp, bg);
    if (threadIdx.x == 0) {
        unsigned* bar = b.bar;
        __builtin_amdgcn_s_waitcnt(0);
        unsigned nloc = b.st[0], nx = b.st[1];
        if (nloc == 0u) { xcd_barrier_complete(bar, b.x, nloc, nx); b.st[0] = nloc; b.st[1] = nx; }
        const unsigned old = xb_add(&bar[XB_XSUB(b.x)], 1u);
        const unsigned gen = old / nloc;
        if (old + 1u == (gen + 1u) * nloc) {
            __builtin_amdgcn_fence(__ATOMIC_RELEASE, "agent");
            asm volatile("s_waitcnt vmcnt(0)" ::: "memory");
            const unsigned og = xb_add(&bar[XB_TOP], 1u);
            const unsigned tg = og / nx;
            if (og + 1u == (tg + 1u) * nx) xb_add(&bar[XB_TOPGEN], 1u);
            else XB_SPIN(xb_ld(&bar[XB_TOPGEN]) == tg, bar);
            __builtin_amdgcn_fence(__ATOMIC_ACQUIRE, "agent");
            xb_add(&bar[XB_XGEN(b.x)], 1u);
            asm volatile("s_waitcnt vmcnt(0)" ::: "memory");
        } else {
            XB_SPIN(xb_ld(&bar[XB_XGEN(b.x)]) == gen, bar);
            __builtin_amdgcn_fence(__ATOMIC_ACQUIRE, "agent");
            asm volatile("s_waitcnt vmcnt(0)" ::: "memory");
        }
    }
    __syncthreads();
}

struct Frame {
    LAS unsigned char* lds;
    volatile LAS unsigned* MISC;
    int tid, lane, wave, vcu, G;
    const float* const* in; float* out; unsigned char* ws;
};
#define LDS_WAIT() asm volatile("s_waitcnt lgkmcnt(0)" ::: "memory")

__device__ __forceinline__ void transpose_tile64(const float* W, int ldw, int k0, int n0, bf16_t* WT, int ldt, int rowbase, const float* kscale, int lane, int hi32 = 32) {
    const float* src = W + (size_t)k0 * ldw + n0 + lane;
    float v[64];
#pragma unroll
    for (int k = 0; k < 64; ++k) v[k] = __builtin_nontemporal_load(src + (size_t)k * ldw);
    if (kscale) {
#pragma unroll
        for (int k = 0; k < 64; ++k) v[k] *= kscale[k0 + k];
    }
    bf16_t* dst = WT + (size_t)(rowbase + (lane & 31) + (lane >> 5) * hi32) * ldt + k0;
#pragma unroll
    for (int c = 0; c < 8; ++c) { u32x4 o; o.x = cvt_pk_bf16(v[8 * c], v[8 * c + 1]); o.y = cvt_pk_bf16(v[8 * c + 2], v[8 * c + 3]); o.z = cvt_pk_bf16(v[8 * c + 4], v[8 * c + 5]); o.w = cvt_pk_bf16(v[8 * c + 6], v[8 * c + 7]);
        *(u32x4*)(dst + 8 * c) = o; }
}

__device__ __forceinline__ void p0_prologue(Frame& F) {
    const int gw = F.vcu * NWAVES + F.wave, NGW = F.G * NWAVES, lane = F.lane;
    unsigned char* ws = F.ws;
    for (int it = gw; it < 16 * 28; it += NGW) { const int kb = it / 28, nb = it % 28; transpose_tile64(F.in[2], NPROJ, 64 * kb, 64 * nb, (bf16_t*)(ws + WS_WIN_T), DM, 64 * nb, F.in[1], lane); }
    const int gt = F.vcu * (NWAVES * 64) + F.tid, NGT = F.G * NWAVES * 64;
    for (int i = gt; i < 8 * 128 * 128; i += NGT) { const int c = i & 127, t = (i >> 7) & 127; ((bf16_t*)(ws + WS_WSP))[i] = c <= t ? f2bf(F.in[4][i]) : (bf16_t)0; }
    for (int i = gt; i < 64 * DM; i += NGT) { const int k = i & (DM - 1), c = i >> 10; float v = 0.f;
        if (c < 4) v = F.in[12][k * 4 + c] * F.in[11][k];
        else if (c < 36) { const int g = (c - 4) >> 3, e = (c - 4) & 7; v = F.in[14][((size_t)g * DM + k) * 8 + e] * F.in[11][k]; }
        ((bf16_t*)(ws + WS_WR_T))[i] = f2bf(v); }
    float* rsx = (float*)(ws + WS_RSX);
    for (int row0 = gw * 8; row0 < NTOK; row0 += NGW * 8) {
        f32x4 v[8][4];
#pragma unroll
        for (int rr = 0; rr < 8; ++rr)
#pragma unroll
            for (int j = 0; j < 4; ++j) v[rr][j] = __builtin_nontemporal_load((const f32x4*)(F.in[0] + (size_t)(row0 + rr) * DM + 256 * j + 4 * lane));
#pragma unroll
        for (int rr = 0; rr < 8; ++rr) {
            float s = 0.f;
#pragma unroll
            for (int j = 0; j < 4; ++j) s += (v[rr][j][0] * v[rr][j][0] + v[rr][j][1] * v[rr][j][1]) + (v[rr][j][2] * v[rr][j][2] + v[rr][j][3] * v[rr][j][3]);
            const float rstd = rsqrtf(wave_sum(s) * (1.f / DM) + RMS_EPS);
            if (lane == 0) rsx[row0 + rr] = rstd;
            bf16_t* xn = (bf16_t*)(ws + WS_XN) + (size_t)(row0 + rr) * DM;
#pragma unroll
            for (int j = 0; j < 4; ++j) { u32x2 o; o.x = cvt_pk_bf16(v[rr][j][0], v[rr][j][1]); o.y = cvt_pk_bf16(v[rr][j][2], v[rr][j][3]);
                *(u32x2*)(xn + 256 * j + 4 * lane) = o; }
        }
    }
}
template <int WHICH>
__device__ __forceinline__ void convert_rest(Frame& F, int part, int nparts, int lo, int hi) {
    unsigned char* ws = F.ws; const int lane = F.lane;
    constexpr int T_OUT = 16 * 16, T_GU = NEXP * 64, T_D = NEXP * 64;
    if (WHICH == 0) {
        for (int it = lo + part; it < 2 * T_GU && it < hi; it += nparts) {
            int r = it; const int up = r >= T_GU; if (up) r -= T_GU; const int e = r / 64, q = r % 64, kb = q / 4, nb = q % 4, n0 = 64 * nb;
            const int rowbase = e * 512 + 256 * (n0 >> 7) + 2 * (n0 & 127) + (up ? 32 : 0);
            transpose_tile64(F.in[up ? 17 : 16] + (size_t)e * DM * DEXP, DEXP, 64 * kb, n0, (bf16_t*)(ws + WS_WGU_T), DM, rowbase, F.in[11], lane, 64); }
    } else if (WHICH == 1) {
        for (int it = part; it < T_OUT; it += nparts) { const int kb = it / 16, nb = it % 16; transpose_tile64(F.in[10], DM, 64 * kb, 64 * nb, (bf16_t*)(ws + WS_WO_T), DM, 64 * nb, 64 * kb < 512 ? F.in[8] : F.in[9] - 512, lane); }
    } else {
        for (int it = part; it < T_D; it += nparts) { const int e = it / 64, q = it % 64, kb = q / 16, nb = q % 16;
            transpose_tile64(F.in[18] + (size_t)e * DEXP * DM, DM, 64 * kb, 64 * nb, (bf16_t*)(ws + WS_WD_T), DEXP, e * DM + 64 * nb, nullptr, lane); }
    }
}

__device__ __forceinline__ void barrier_background(Frame& F, int bg) {
    constexpr int NT = 2 * NEXP * 64, PER = (NT + 2) / 3;
    convert_rest<0>(F, F.vcu * (NWAVES - 1) + (F.wave - 1), F.G * (NWAVES - 1), bg * PER, (bg + 1) * PER);
}

constexpr int P2_K_OFF = 0, P2_KROW = 144, P2_KHEAD = 256 * P2_KROW;
constexpr int P2_V_OFF = 2 * P2_KHEAD, P2_VHEAD = 256 * 128;
constexpr int P2_VN_OFF = 0, P2_VNROW = 1088;
constexpr int P2_EXA_OFF = 139264, P2_EXG_OFF = P2_EXA_OFF + 4096;
static_assert(P2_V_OFF + 2 * P2_VHEAD <= P2_EXA_OFF && 128 * P2_VNROW <= P2_EXA_OFF && P2_EXG_OFF + 4096 <= MISC_OFF, "P2 LDS map");

__device__ __forceinline__ void p2_mix(Frame& F, const int skip) {
    const int tid = F.tid, lane = F.lane, w = F.wave;
    const int r = lane & 31, hh = lane >> 5, g4 = lane >> 4, q4 = (lane & 15) >> 2, p4 = lane & 3;
    const bf16_t* proj = (const bf16_t*)(F.ws + WS_PROJ);
    bf16_t* mixed = (bf16_t*)(F.ws + WS_MIXED);
    const bf16_t* wsp = (const bf16_t*)(F.ws + WS_WSP);
    LAS unsigned char* lds = F.lds;
    float* ssqm = (float*)(F.ws + WS_SSQM);
    const float sink2 = F.in[3][w] * LOG2E;
    const float SC2 = 0.125f * LOG2E;
    for (int unit = F.vcu; unit < NTOK / 128; unit += F.G) {
        const int t0 = unit * 128; const bool first = (unit & 63) == 0;
        {
            u32x4 kv[8], vv[8];
#pragma unroll
            for (int i = 0; i < 8; ++i) { const int pc = tid + 512 * i, key = pc >> 4, sub = pc & 15;
                kv[i] = (u32x4){0u, 0u, 0u, 0u}; vv[i] = (u32x4){0u, 0u, 0u, 0u};
                if (!(first && key < 128)) { const bf16_t* rowp = proj + (size_t)(t0 - 128 + key) * NPROJ; kv[i] = *(const u32x4*)(rowp + C_K + sub * 8); vv[i] = *(const u32x4*)(rowp + C_V + sub * 8); } }
#pragma unroll
            for (int i = 0; i < 8; ++i) { const int pc = tid + 512 * i, key = pc >> 4, sub = pc & 15, kvh = sub >> 3, piece = sub & 7;
                *(LAS u32x4*)(lds + P2_K_OFF + kvh * P2_KHEAD + key * P2_KROW + piece * 16) = kv[i];
                *(LAS u32x4*)(lds + P2_V_OFF + kvh * P2_VHEAD + key * 128 + ((piece ^ (((key >> 1) & 1) << 2)) * 16)) = vv[i]; }
        }
        if (!(skip & 1)) {
            const int kvh = w >> 2;
            const LAS unsigned char* Kl = lds + P2_K_OFF + kvh * P2_KHEAD;
            const LAS unsigned char* Vl = lds + P2_V_OFF + kvh * P2_VHEAD;
            const int vflip = (q4 >> 1) & 1;
            const int vlane = (4 * hh + q4) * 128 + (g4 & 1) * 32 + p4 * 8;
            const int vh0 = vflip * 64, vh1 = (vflip ^ 1) * 64;
            const bf16_t* qbase = proj + (size_t)(t0 + r) * NPROJ + C_Q + 64 * w + 8 * hh;
            bf16x8 qn[4];
#pragma unroll
            for (int s = 0; s < 4; ++s) qn[s] = __builtin_nontemporal_load((const bf16x8*)(qbase + 16 * s));
            __syncthreads();
            for (int qb = 0; qb < 4; ++qb) {
                bf16x8 qf[4];
#pragma unroll
                for (int s = 0; s < 4; ++s) qf[s] = qn[s];
                if (qb < 3) {
#pragma unroll
                    for (int s = 0; s < 4; ++s) qn[s] = __builtin_nontemporal_load((const bf16x8*)(qbase + (size_t)(32 * (qb + 1)) * NPROJ + 16 * s));
                }
                f32x16 sa[5];
#pragma unroll
                for (int cc = 0; cc < 5; ++cc) {
#pragma unroll
                    for (int i = 0; i < 16; ++i) sa[cc][i] = 0.f;
                    const LAS unsigned char* kp = Kl + (32 * (qb + cc) + r) * P2_KROW + 16 * hh;
#pragma unroll
                    for (int s = 0; s < 4; ++s) { const bf16x8 kf = *(const LAS bf16x8*)(kp + 32 * s); sa[cc] = MFMA32(kf, qf[s], sa[cc]); }
                }
                const int q = 32 * qb + r; float mr = -1e30f;
#pragma unroll
                for (int cc = 0; cc < 5; ++cc)
#pragma unroll
                    for (int i = 0; i < 16; ++i) { const int kb = 32 * (qb + cc) + (i & 3) + 8 * (i >> 2) + 4 * hh;
                        if (cc == 0 || cc == 4 || first) { bool ok = true; if (cc == 0) ok = kb >= q + 1; if (cc == 4) ok = kb <= q + 128; if (first) ok = ok && kb >= 128; sa[cc][i] = ok ? sa[cc][i] : -1e30f; }
                        mr = fmaxf(mr, sa[cc][i]); }
                mr = fmaxf(mr, __shfl_xor(mr, 32));
                const float mx = fmaxf(mr * SC2, sink2);
                float sum4[4] = {0.f, 0.f, 0.f, 0.f};
#pragma unroll
                for (int cc = 0; cc < 5; ++cc)
#pragma unroll
                    for (int i = 0; i < 16; ++i) { const float pe = __builtin_amdgcn_exp2f(fmaf(sa[cc][i], SC2, -mx)); sa[cc][i] = pe; sum4[i & 3] += pe; }
                float sum = (sum4[0] + sum4[1]) + (sum4[2] + sum4[3]);
                sum += __shfl_xor(sum, 32);
                const float inv = 1.f / (sum + __builtin_amdgcn_exp2f(sink2 - mx));
                f32x16 o[2];
#pragma unroll
                for (int i = 0; i < 16; ++i) { o[0][i] = 0.f; o[1][i] = 0.f; }
#pragma unroll
                for (int cc = 0; cc < 5; ++cc)
#pragma unroll
                    for (int s2 = 0; s2 < 2; ++s2) {
                        u32x4 pw; pw.x = cvt_pk_bf16(sa[cc][8 * s2 + 0], sa[cc][8 * s2 + 1]); pw.y = cvt_pk_bf16(sa[cc][8 * s2 + 2], sa[cc][8 * s2 + 3]);
                        pw.z = cvt_pk_bf16(sa[cc][8 * s2 + 4], sa[cc][8 * s2 + 5]); pw.w = cvt_pk_bf16(sa[cc][8 * s2 + 6], sa[cc][8 * s2 + 7]);
                        const bf16x8 pf = __builtin_bit_cast(bf16x8, pw);
                        const LAS unsigned char* vp = Vl + (32 * (qb + cc) + 16 * s2) * 128 + vlane;
#pragma unroll
                        for (int db = 0; db < 2; ++db) { const int vh = db ? vh1 : vh0; const s16x4 a0 = vtr(vp + vh), a1 = vtr(vp + 8 * 128 + vh);
                            const bf16x8 vf = (bf16x8){a0[0], a0[1], a0[2], a0[3], a1[0], a1[1], a1[2], a1[3]};
                            o[db] = MFMA32(vf, pf, o[db]); }
                    }
                float ss4[4] = {0.f, 0.f, 0.f, 0.f};
#pragma unroll
                for (int db = 0; db < 2; ++db)
#pragma unroll
                    for (int i = 0; i < 16; ++i) { o[db][i] *= inv; ss4[i & 3] += o[db][i] * o[db][i]; }
                float ss = (ss4[0] + ss4[1]) + (ss4[2] + ss4[3]);
                ss += __shfl_xor(ss, 32);
                if (hh == 0) ssqm[(size_t)(t0 + q) * 16 + w] = ss;
                bf16_t* orow = mixed + (size_t)(t0 + q) * DM + 64 * w + 4 * hh;
#pragma unroll
                for (int db = 0; db < 2; ++db)
#pragma unroll
                    for (int rg = 0; rg < 4; ++rg) { u32x2 ow; ow.x = cvt_pk_bf16(o[db][4 * rg], o[db][4 * rg + 1]); ow.y = cvt_pk_bf16(o[db][4 * rg + 2], o[db][4 * rg + 3]);
                        *(u32x2*)(orow + 32 * db + 8 * rg) = ow; }
            }
        }
        if (!(skip & 2)) {
            u32x4 raw[16];
#pragma unroll
            for (int i = 0; i < 16; ++i) raw[i] = __builtin_nontemporal_load((const u32x4*)(proj + (size_t)(t0 + 16 * w + i) * NPROJ + C_GV + 8 * lane));
            const f32x4 lg0 = *(const f32x4*)(F.in[6] + 8 * lane), lg1 = *(const f32x4*)(F.in[6] + 8 * lane + 4), lb0 = *(const f32x4*)(F.in[7] + 8 * lane), lb1 = *(const f32x4*)(F.in[7] + 8 * lane + 4);
            LAS f32x2* stat = (LAS f32x2*)(lds + P2_EXG_OFF);
            if (tid < 128) { const f32x4* sp = (const f32x4*)((const float*)(F.ws + WS_SSQ) + (size_t)(t0 + tid) * 16); const f32x4 a = sp[0], b = sp[1], c = sp[2], d = sp[3];
                const float s1 = (a[0] + a[2]) + (b[0] + b[2]) + (c[0] + c[2]) + (d[0] + d[2]), s2 = (a[1] + a[3]) + (b[1] + b[3]) + (c[1] + c[3]) + (d[1] + d[3]);
                const float mu = s1 * (1.f / 512), var = fmaxf(s2 * (1.f / 512) - mu * mu, 0.f); stat[tid] = (f32x2){mu, rsqrtf(var + LN_EPS)}; }
            __syncthreads();
#pragma unroll
            for (int i = 0; i < 16; ++i) { const int tok = 16 * w + i; const f32x2 st = stat[tok]; const float mu = st.x, rstd = st.y;
                float v[8];
                v[0] = __uint_as_float(raw[i].x << 16); v[1] = __uint_as_float(raw[i].x & 0xffff0000u); v[2] = __uint_as_float(raw[i].y << 16); v[3] = __uint_as_float(raw[i].y & 0xffff0000u);
                v[4] = __uint_as_float(raw[i].z << 16); v[5] = __uint_as_float(raw[i].z & 0xffff0000u); v[6] = __uint_as_float(raw[i].w << 16); v[7] = __uint_as_float(raw[i].w & 0xffff0000u);
#pragma unroll
                for (int j = 0; j < 8; ++j) v[j] = (v[j] - mu) * rstd;
                u32x4 ow; ow.x = cvt_pk_bf16(v[0] * lg0[0] + lb0[0], v[1] * lg0[1] + lb0[1]); ow.y = cvt_pk_bf16(v[2] * lg0[2] + lb0[2], v[3] * lg0[3] + lb0[3]);
                ow.z = cvt_pk_bf16(v[4] * lg1[0] + lb1[0], v[5] * lg1[1] + lb1[1]); ow.w = cvt_pk_bf16(v[6] * lg1[2] + lb1[2], v[7] * lg1[3] + lb1[3]);
                *(LAS u32x4*)(lds + P2_VN_OFF + tok * P2_VNROW + lane * 16) = ow; }
        }
        if (!(skip & 4)) {
            const LAS unsigned char* vnl = lds + P2_VN_OFF + (8 * hh + q4) * P2_VNROW + (64 * w + 16 * (g4 & 1) + 4 * p4) * 2;
            const bf16_t* wh = wsp + (size_t)w * 128 * 128 + (size_t)r * 128 + 8 * hh;
            const bf16_t* ub = proj + (size_t)(t0 + r) * NPROJ + C_GU + 64 * w + 4 * hh;
            bf16x8 wf[8]; u32x2 uu[8];
#pragma unroll
            for (int s = 0; s < 2; ++s) wf[s] = *(const bf16x8*)(wh + 16 * s);
#pragma unroll
            for (int j = 0; j < 8; ++j) uu[j] = *(const u32x2*)(ub + 32 * (j >> 2) + 8 * (j & 3));
            __syncthreads();
#pragma unroll
            for (int tb = 0; tb < 4; ++tb) {
                f32x16 acc[2];
#pragma unroll
                for (int i = 0; i < 16; ++i) { acc[0][i] = 0.f; acc[1][i] = 0.f; }
#pragma unroll
                for (int s = 0; s < 2 * tb + 2; ++s) {
#pragma unroll
                    for (int db = 0; db < 2; ++db) { const LAS unsigned char* vp = vnl + (16 * s) * P2_VNROW + db * 64;
                        const s16x4 a0 = vtr(vp), a1 = vtr(vp + 4 * P2_VNROW);
                        const bf16x8 af = (bf16x8){a0[0], a0[1], a0[2], a0[3], a1[0], a1[1], a1[2], a1[3]};
                        acc[db] = MFMA32(af, wf[s], acc[db]); }
                }
                const int t = 32 * tb + r; const float bs = F.in[5][w * 128 + t];
                float ss = 0.f;
#pragma unroll
                for (int db = 0; db < 2; ++db)
#pragma unroll
                    for (int rg = 0; rg < 4; ++rg) { const u32x2 u2 = uu[4 * db + rg];
                        const float u0 = __uint_as_float(u2.x << 16), u1 = __uint_as_float(u2.x & 0xffff0000u), u2f = __uint_as_float(u2.y << 16), u3 = __uint_as_float(u2.y & 0xffff0000u);
                        float a = u0 * (acc[db][4 * rg] + bs), b = u1 * (acc[db][4 * rg + 1] + bs), c = u2f * (acc[db][4 * rg + 2] + bs), d = u3 * (acc[db][4 * rg + 3] + bs);
                        acc[db][4 * rg] = a; acc[db][4 * rg + 1] = b; acc[db][4 * rg + 2] = c; acc[db][4 * rg + 3] = d; ss += (a * a + b * b) + (c * c + d * d); }
                if (tb < 3) {
#pragma unroll
                    for (int s = 0; s < 2 * tb + 4; ++s) wf[s] = *(const bf16x8*)(wh + (size_t)(32 * (tb + 1)) * 128 + 16 * s);
#pragma unroll
                    for (int j = 0; j < 8; ++j) uu[j] = *(const u32x2*)(ub + (size_t)(32 * (tb + 1)) * NPROJ + 32 * (j >> 2) + 8 * (j & 3));
                }
                ss += __shfl_xor(ss, 32);
                if (hh == 0) ssqm[(size_t)(t0 + t) * 16 + 8 + w] = ss;
                bf16_t* orow = mixed + (size_t)(t0 + t) * DM + 512 + 64 * w + 4 * hh;
#pragma unroll
                for (int db = 0; db < 2; ++db)
#pragma unroll
                    for (int rg = 0; rg < 4; ++rg) { u32x2 ow; ow.x = cvt_pk_bf16(acc[db][4 * rg], acc[db][4 * rg + 1]); ow.y = cvt_pk_bf16(acc[db][4 * rg + 2], acc[db][4 * rg + 3]);
                        *(u32x2*)(orow + 32 * db + 8 * rg) = ow; }
            }
        }
        __syncthreads();
    }
}

constexpr int P4_WROW = 2064;
constexpr int P4_W_OFF = 0, P4_LG_OFF = 48 * P4_WROW, P4_CNT_OFF = P4_LG_OFF + 8 * 16 * 48 * 4, P4_BASE_OFF = P4_CNT_OFF + 128;
static_assert(P4_BASE_OFF + 128 <= MISC_OFF, "P4 LDS map");
__device__ __forceinline__ void p4_router(Frame& F) {
    const int lane = F.lane, w = F.wave, tid = F.tid;
    const bf16_t* hb = (const bf16_t*)(F.ws + WS_HB);
    const bf16_t* wr_t = (const bf16_t*)(F.ws + WS_WR_T);
    const float* ssq = (const float*)(F.ws + WS_SSQ);
    int* cntg = (int*)(F.ws + WS_CTL) + CW_CNT;
    int* tl = (int*)(F.ws + WS_TOKLIST); float* rl = (float*)(F.ws + WS_RSLIST);
    LAS unsigned char* lds = F.lds;
    LAS float* lg = (LAS float*)(lds + P4_LG_OFF) + w * 16 * 48;
    LAS int* cl = (LAS int*)(lds + P4_CNT_OFF); LAS int* bl = (LAS int*)(lds + P4_BASE_OFF);
    bool wimg = false;
    for (int blk = F.vcu; blk < NTOK / 128; blk += F.G) {
        const int tok0 = blk * 128 + 16 * w;
        if (tid < 32) cl[tid] = 0;
        const bf16_t* ap = hb + (size_t)(tok0 + (lane & 15)) * DM + 8 * (lane >> 4);
        bf16x8 af[32];
#pragma unroll
        for (int s = 0; s < 32; ++s) af[s] = *(const bf16x8*)(ap + 32 * s);
        const f32x4 sq0 = *(const f32x4*)(ssq + (size_t)(tok0 + (lane & 15)) * 16), sq1 = *(const f32x4*)(ssq + (size_t)(tok0 + (lane & 15)) * 16 + 4),
                    sq2 = *(const f32x4*)(ssq + (size_t)(tok0 + (lane & 15)) * 16 + 8), sq3 = *(const f32x4*)(ssq + (size_t)(tok0 + (lane & 15)) * 16 + 12);
        if (!wimg) { wimg = true;
#pragma unroll
            for (int i = 0; i < 12; ++i) { const int pc = tid + 512 * i, row = pc >> 7, ch = pc & 127; *(LAS u32x4*)(lds + P4_W_OFF + row * P4_WROW + ch * 16) = *(const u32x4*)(wr_t + (size_t)row * DM + ch * 8); } }
        __syncthreads();
        f32x4 acc[3];
#pragma unroll
        for (int c = 0; c < 3; ++c) acc[c] = (f32x4){0.f, 0.f, 0.f, 0.f};
        const LAS unsigned char* bp = lds + P4_W_OFF + (lane & 15) * P4_WROW + 16 * (lane >> 4);
#pragma unroll
        for (int s = 0; s < 32; ++s) {
#pragma unroll
            for (int c = 0; c < 3; ++c) { const bf16x8 b = *(const LAS bf16x8*)(bp + c * 16 * P4_WROW + 64 * s); acc[c] = MFMA16(af[s], b, acc[c]); }
        }
#pragma unroll
        for (int c = 0; c < 3; ++c)
#pragma unroll
            for (int i = 0; i < 4; ++i) lg[(4 * (lane >> 4) + i) * 48 + 16 * c + (lane & 15)] = acc[c][i];
        LDS_WAIT();
        int e1 = 0, e2 = 0, l1 = 0, l2 = 0; float w1 = 0.f, w2 = 0.f, rstd = 0.f;
        if (lane < 16) {
            float s = 0.f;
#pragma unroll
            for (int i = 0; i < 4; ++i) s += sq0[i];
#pragma unroll
            for (int i = 0; i < 4; ++i) s += sq1[i];
#pragma unroll
            for (int i = 0; i < 4; ++i) s += sq2[i];
#pragma unroll
            for (int i = 0; i < 4; ++i) s += sq3[i];
            rstd = rsqrtf(s * (1.f / DM) + RMS_EPS);
            const LAS float* L = lg + lane * 48;
            float gl[4]; int gi = 0;
#pragma unroll
            for (int j = 0; j < 4; ++j) gl[j] = L[j] * rstd + F.in[13][j];
            float gm = gl[0];
#pragma unroll
            for (int j = 1; j < 4; ++j) if (gl[j] > gm) { gm = gl[j]; gi = j; }
            float den = 0.f;
#pragma unroll
            for (int j = 0; j < 4; ++j) den += __expf(gl[j] - gm);
            const float gw = 1.f / den;
            float el[8];
#pragma unroll
            for (int j = 0; j < 8; ++j) el[j] = L[4 + gi * 8 + j] * rstd + F.in[15][gi * 8 + j];
            int i1 = 0; float v1 = el[0];
#pragma unroll
            for (int j = 1; j < 8; ++j) if (el[j] > v1) { v1 = el[j]; i1 = j; }
            int i2 = 0; float v2 = -INFINITY;
#pragma unroll
            for (int j = 0; j < 8; ++j) if (j != i1 && el[j] > v2) { v2 = el[j]; i2 = j; }
            const float a1 = 1.f / (1.f + __expf(v2 - v1));
            w1 = gw * a1; w2 = gw * (1.f - a1); e1 = gi * 8 + i1; e2 = gi * 8 + i2;
            l1 = atomicAdd((int*)(cl + e1), 1); l2 = atomicAdd((int*)(cl + e2), 1);
        }
        __syncthreads();
        if (tid < 32) bl[tid] = atomicAdd(cntg + tid, (int)cl[tid]);
        __syncthreads();
        if (lane < 16) {
            const int tok = tok0 + lane; const int p1 = bl[e1] + l1, p2 = bl[e2] + l2;
            tl[(size_t)e1 * NTOK + p1] = tok; rl[(size_t)e1 * NTOK + p1] = rstd;
            tl[(size_t)e2 * NTOK + p2] = tok; rl[(size_t)e2 * NTOK + p2] = rstd;
            ((int4*)(F.ws + WS_TOKREC))[tok] = make_int4(e1, p1, e2, p2);
            ((float2*)(F.ws + WS_TOKW))[tok] = make_float2(w1, w2);
        }
        __syncthreads();
    }
}

__device__ __forceinline__ int moe_offsets(Frame& F) {
    const int* cnt = (const int*)(F.ws + WS_CTL) + CW_CNT;
    if (F.tid == 0) { int o = 0; for (int e = 0; e < NEXP; ++e) { const int n = __hip_atomic_load(cnt + e, __ATOMIC_RELAXED, __HIP_MEMORY_SCOPE_AGENT); F.MISC[16 + e] = (unsigned)o; F.MISC[16 + 64 + e] = (unsigned)n; o += (n + 255) >> 8; } F.MISC[16 + NEXP] = (unsigned)o; }
    __syncthreads();
    return __builtin_amdgcn_readfirstlane((int)F.MISC[16 + NEXP]);
}

__device__ __forceinline__ void p7_final(Frame& F) {
    const int lane = F.lane; const int gw = F.vcu * NWAVES + F.wave, NGW = F.G * NWAVES;
    const volatile LAS int* toff = (const volatile LAS int*)(F.MISC + 16);
    const float* gf = F.in[19];
    const f32x4 g0a = *(const f32x4*)(gf + 8 * lane), g0b = *(const f32x4*)(gf + 8 * lane + 4), g1a = *(const f32x4*)(gf + 512 + 8 * lane), g1b = *(const f32x4*)(gf + 512 + 8 * lane + 4);
    const bf16_t* HBp = (const bf16_t*)(F.ws + WS_HB); const bf16_t* Yp = (const bf16_t*)(F.ws + WS_Y);
    for (int tok0 = gw * 4; tok0 < NTOK; tok0 += NGW * 4) {
        int4 rec[4]; float2 wt[4];
#pragma unroll
        for (int t = 0; t < 4; ++t) { rec[t] = ((const int4*)(F.ws + WS_TOKREC))[tok0 + t]; wt[t] = ((const float2*)(F.ws + WS_TOKW))[tok0 + t]; }
        u32x4 ra[4][2], rb[4][2], rc[4][2];
#pragma unroll
        for (int t = 0; t < 4; ++t) {
            const int s1 = toff[rec[t].x] * 256 + rec[t].y, s2 = toff[rec[t].z] * 256 + rec[t].w;
            const bf16_t* hb = HBp + (size_t)(tok0 + t) * DM + 8 * lane; const bf16_t* y1 = Yp + (size_t)s1 * DM + 8 * lane; const bf16_t* y2 = Yp + (size_t)s2 * DM + 8 * lane;
#pragma unroll
            for (int j = 0; j < 2; ++j) { ra[t][j] = __builtin_nontemporal_load((const u32x4*)(hb + 512 * j)); rb[t][j] = __builtin_nontemporal_load((const u32x4*)(y1 + 512 * j)); rc[t][j] = __builtin_nontemporal_load((const u32x4*)(y2 + 512 * j)); }
        }
#pragma unroll
        for (int t = 0; t < 4; ++t) {
            float z[16]; float ss = 0.f;
#pragma unroll
            for (int j = 0; j < 2; ++j)
#pragma unroll
                for (int q = 0; q < 4; ++q) {
                    const float lo = __uint_as_float(ra[t][j][q] << 16) + wt[t].x * __uint_as_float(rb[t][j][q] << 16) + wt[t].y * __uint_as_float(rc[t][j][q] << 16);
                    const float hi = __uint_as_float(ra[t][j][q] & 0xffff0000u) + wt[t].x * __uint_as_float(rb[t][j][q] & 0xffff0000u) + wt[t].y * __uint_as_float(rc[t][j][q] & 0xffff0000u);
                    z[8 * j + 2 * q] = lo; z[8 * j + 2 * q + 1] = hi; ss += lo * lo + hi * hi; }
            const float rstd = rsqrtf(wave_sum(ss) * (1.f / DM) + RMS_EPS);
            float* o = F.out + (size_t)(tok0 + t) * DM;
            __builtin_nontemporal_store((f32x4){z[0] * rstd * g0a[0], z[1] * rstd * g0a[1], z[2] * rstd * g0a[2], z[3] * rstd * g0a[3]}, (f32x4*)(o + 8 * lane));
            __builtin_nontemporal_store((f32x4){z[4] * rstd * g0b[0], z[5] * rstd * g0b[1], z[6] * rstd * g0b[2], z[7] * rstd * g0b[3]}, (f32x4*)(o + 8 * lane + 4));
            __builtin_nontemporal_store((f32x4){z[8] * rstd * g1a[0], z[9] * rstd * g1a[1], z[10] * rstd * g1a[2], z[11] * rstd * g1a[3]}, (f32x4*)(o + 512 + 8 * lane));
            __builtin_nontemporal_store((f32x4){z[12] * rstd * g1b[0], z[13] * rstd * g1b[1], z[14] * rstd * g1b[2], z[15] * rstd * g1b[3]}, (f32x4*)(o + 512 + 8 * lane + 4));
        }
    }
}

struct Args { const float* in[20]; float* out; unsigned char* ws; int ph_lo, ph_hi, li, pad; };
constexpr int N_PHASES = 8;
__global__ void __launch_bounds__(NWAVES * 64, 2) mk_fwd(Args args) {
    extern __shared__ __attribute__((aligned(16))) unsigned char lds_raw[];
    Frame F;
    F.lds = (LAS unsigned char*)lds_raw;
    F.MISC = (volatile LAS unsigned*)(F.lds + MISC_OFF);
    F.tid = threadIdx.x; F.lane = F.tid & 63; F.wave = __builtin_amdgcn_readfirstlane(F.tid >> 6);
    F.G = gridDim.x; { const int bx = blockIdx.x; F.vcu = (F.G % 8 == 0) ? (bx % 8) * (F.G / 8) + bx / 8 : bx; }
    F.in = args.in; F.out = args.out; F.ws = args.ws;
    unsigned char* ws = args.ws;
    for (int u = F.tid; u < 256; u += NWAVES * 64) F.MISC[u] = 0u;
    __syncthreads();
    const int lo = args.ph_lo, hi = args.ph_hi;
    XcdBarrier bar; bar.bar = (unsigned*)(ws + WS_CTL) + CW_BAR + args.li * XCD_BAR_WORDS; bar.x = 0; bar.st = nullptr;
    if (hi - lo > 1) bar = xcd_barrier_post((unsigned*)(ws + WS_CTL) + CW_BAR + args.li * XCD_BAR_WORDS, F.MISC + 8);
#define IN(k) (lo <= (k) && (k) < hi)
#define SEAM(k) do { if (IN(k) && IN((k) + 1)) xcd_barrier(bar, &F, (k) < 3 ? (k) : -1); } while (0)
    if (IN(0)) { p0_prologue(F); SEAM(0); }
    if (IN(1)) {
        pg8::Gemm g{(const bf16_t*)(ws + WS_XN), (const bf16_t*)(ws + WS_WIN_T), DM, 0}; pg8::StaticOrder S; S.init(NTOK, NPROJ, DM, F.G, (int)blockIdx.x);
        pg8::EpiBf16G E{(bf16_t*)(ws + WS_PROJ), NPROJ, 3, (f32x2*)(ws + WS_SSQ), 5, 0, (const float*)(ws + WS_RSX)};
        pg8::gemm_phase<pg8::EpiBf16G, pg8::StaticOrder>(F.lds, g, S, E);
        {
            const int nu = (NTOK / 256) * (NPROJ / 256), full = nu % F.G;
            if (full == 0) convert_rest<1>(F, (int)blockIdx.x * NWAVES + F.wave, F.G * NWAVES, 0, 1 << 30);
            else if ((int)blockIdx.x >= full) convert_rest<1>(F, ((int)blockIdx.x - full) * NWAVES + F.wave, (F.G - full) * NWAVES, 0, 1 << 30);
        }
        SEAM(1);
    }
    if (IN(2)) { p2_mix(F, args.pad); SEAM(2); }
    if (IN(3)) {
        pg8::Gemm g{(const bf16_t*)(ws + WS_MIXED), (const bf16_t*)(ws + WS_WO_T), DM, 0}; pg8::StaticOrder S; S.init(NTOK, DM, DM, F.G, (int)blockIdx.x);
        pg8::EpiH E{(const bf16_t*)(ws + WS_XN), (bf16_t*)(ws + WS_HB), (float*)(ws + WS_SSQ), (const LAS f32x2*)(F.lds + RING_BYTES), {-1, -1, -1, -1}};
        {
            LAS f32x2* tab = (LAS f32x2*)(F.lds + RING_BYTES); pg8::Unit uu;
            for (int i = 0; i < 4 && S.next(i, uu); ++i) { E.pms[i] = uu.pm;
                if (F.tid < 256) { const f32x4* sp = (const f32x4*)((const float*)(ws + WS_SSQM) + (size_t)(uu.pm * 256 + F.tid) * 16); const f32x4 a = sp[0], b = sp[1], c = sp[2], d = sp[3];
                    const float sa = ((a[0] + a[1]) + (a[2] + a[3])) + ((b[0] + b[1]) + (b[2] + b[3])), sg = ((c[0] + c[1]) + (c[2] + c[3])) + ((d[0] + d[1]) + (d[2] + d[3]));
                    const float ra = rsqrtf(sa * (1.f / 512) + RMS_EPS), rg = rsqrtf(sg * (1.f / 512) + RMS_EPS); tab[i * 256 + F.tid] = (f32x2){ra / rg, rg}; } }
            __syncthreads();
        }
        pg8::gemm_phase<pg8::EpiH, pg8::StaticOrder>(F.lds, g, S, E);
        SEAM(3);
    }
    if (IN(4)) { p4_router(F); SEAM(4); }
    if (IN(5) || IN(6) || IN(7)) {
        const int ntiles = moe_offsets(F);
        const volatile LAS int* toff = (const volatile LAS int*)(F.MISC + 16);
        const int* cnt = (const int*)(ws + WS_CTL) + CW_CNT;
        if (IN(5)) {
            pg8::Gemm g{(const bf16_t*)(ws + WS_HB), (const bf16_t*)(ws + WS_WGU_T), DM, 0};
            MoeOrder<true> S{toff, cnt, (const int*)(ws + WS_TOKLIST), 2, ntiles * 2, F.G, (int)blockIdx.x, DM, 512};
            EpiSwiglu E{(bf16_t*)(ws + WS_HID), (const float*)(ws + WS_RSLIST)};
            pg8::gemm_phase<EpiSwiglu, MoeOrder<true>>(F.lds, g, S, E);
            {
                const int nu = ntiles * 2, full = nu % F.G;
                if (full == 0) convert_rest<2>(F, (int)blockIdx.x * NWAVES + F.wave, F.G * NWAVES, 0, 1 << 30);
                else if ((int)blockIdx.x >= full) convert_rest<2>(F, ((int)blockIdx.x - full) * NWAVES + F.wave, (F.G - full) * NWAVES, 0, 1 << 30);
            }
            SEAM(5);
        }
        if (IN(6)) {
            pg8::Gemm g{(const bf16_t*)(ws + WS_HID), (const bf16_t*)(ws + WS_WD_T), DEXP, 0};
            MoeOrder<false> S{toff, cnt, (const int*)(ws + WS_TOKLIST), 4, ntiles * 4, F.G, (int)blockIdx.x, DEXP, DM};
            pg8::EpiBf16G E{(bf16_t*)(ws + WS_Y), DM, 1000, nullptr, 1000, 0, nullptr};
            pg8::gemm_phase<pg8::EpiBf16G, MoeOrder<false>>(F.lds, g, S, E);
            SEAM(6);
        }
        if (IN(7)) p7_final(F);
    }
#undef IN
#undef SEAM
}
extern "C" void kernel_launch(void* const* d_in, const int* in_sizes, int n_in, void* d_out, int out_size, void* d_ws, size_t ws_size, hipStream_t stream) {
    static int grid = 0;
    if (grid == 0) {
        if (n_in != 20 || in_sizes[0] != NTOK * DM || out_size != NTOK * DM || ws_size < WS_END) {
            fprintf(stderr, "kernel_launch: unexpected shapes (n_in %d, in0 %d, out %d, ws %zu)\n", n_in, n_in > 0 ? in_sizes[0] : -1, out_size, ws_size); grid = -1; return; }
        int dev = 0, cus = 0, per_cu = 0;
        if (hipGetDevice(&dev) != hipSuccess || hipDeviceGetAttribute(&cus, hipDeviceAttributeMultiprocessorCount, dev) != hipSuccess) { fprintf(stderr, "kernel_launch: device query failed\n"); grid = -1; return; }
        if (hipFuncSetAttribute((const void*)mk_fwd, hipFuncAttributeMaxDynamicSharedMemorySize, LDS_BYTES) != hipSuccess) { fprintf(stderr, "kernel_launch: hipFuncSetAttribute(%d B LDS) failed\n", LDS_BYTES); grid = -1; return; }
        if (hipOccupancyMaxActiveBlocksPerMultiprocessor(&per_cu, (const void*)mk_fwd, NWAVES * 64, LDS_BYTES) != hipSuccess || per_cu < 1)
            fprintf(stderr, "kernel_launch: note: occupancy query reports %d workgroups per CU\n", per_cu);
        (void)hipGetLastError();
        grid = cus;
    }
    if (grid < 0) return;
    Params p{};
    for (int i = 0; i < 20; ++i) p.in[i] = (const float*)d_in[i];
    p.out = (float*)d_out; p.ws = (unsigned char*)d_ws;
    unsigned char* ws = p.ws;
    (void)hipMemsetAsync(ws + WS_CTL, 0, CTL_ZERO_BYTES, stream);
    const int* cnt = (const int*)(ws + WS_CTL) + CW_CNT;
    Args a{};
    for (int i = 0; i < 20; ++i) a.in[i] = (const float*)d_in[i];
    a.out = (float*)d_out; a.ws = ws;
#ifndef REP_PH
#define REP_PH -1
#endif
    constexpr int rp = REP_PH;
    int li = 0;
#ifdef CUM_PH
    { a.ph_lo = 0; a.ph_hi = CUM_PH; a.li = li++; hipLaunchKernelGGL(mk_fwd, dim3(grid), dim3(NWAVES * 64), LDS_BYTES, stream, a);
      (void)hipMemsetAsync(ws + WS_CTL + CW_CNT * 4, 0, NEXP * 4, stream); }
#endif
    if (rp < 0) { a.ph_lo = 0; a.ph_hi = N_PHASES; a.li = li++; hipLaunchKernelGGL(mk_fwd, dim3(grid), dim3(NWAVES * 64), LDS_BYTES, stream, a); }
    else {
        a.ph_lo = 0; a.ph_hi = rp + 1; a.li = li++; hipLaunchKernelGGL(mk_fwd, dim3(grid), dim3(NWAVES * 64), LDS_BYTES, stream, a);
        if (rp == 4) (void)hipMemsetAsync(ws + WS_CTL + CW_CNT * 4, 0, NEXP * 4, stream);
#ifdef REP_P2
        a.pad = REP_P2;
#endif
#ifdef REP_GRID
        a.ph_lo = rp; a.ph_hi = rp + 1; a.li = li++; hipLaunchKernelGGL(mk_fwd, dim3(REP_GRID), dim3(NWAVES * 64), LDS_BYTES, stream, a);
#else
        a.ph_lo = rp; a.ph_hi = rp + 1; a.li = li++; hipLaunchKernelGGL(mk_fwd, dim3(grid), dim3(NWAVES * 64), LDS_BYTES, stream, a);
#endif
        a.pad = 0;
        if (rp + 1 < N_PHASES) { a.ph_lo = rp + 1; a.ph_hi = N_PHASES; a.li = li++; hipLaunchKernelGGL(mk_fwd, dim3(grid), dim3(NWAVES * 64), LDS_BYTES, stream, a); }
    }
    (void)p; (void)cnt;
}
```

```cpp
#include <hip/hip_runtime.h>
#include <cstdio>
#include <cstdint>
#include <cmath>

constexpr int BATCH = 4, SEQ = 8192, DM = 1024, NTOK = BATCH * SEQ;
constexpr int NPROJ = 1792;
constexpr int C_Q = 0, C_K = 512, C_V = 640, C_GU = 768, C_GV = 1280;
constexpr int NEXP = 32, DEXP = 256, NGRP = 4, EPG = 8;
constexpr int SLOT_CAP = 2 * NTOK + NEXP * 256;
constexpr float RMS_EPS = 1e-6f, LN_EPS = 1e-5f;

typedef unsigned short bf16_t;
__device__ __forceinline__ float bf2f(bf16_t v) { return __uint_as_float((unsigned)v << 16); }
__device__ __forceinline__ bf16_t f2bf(float f) { unsigned u = __float_as_uint(f); return (bf16_t)((u + 0x7fffu + ((u >> 16) & 1u)) >> 16); }

constexpr size_t MiB = 1u << 20;
constexpr size_t WS_CTL = 0, CTL_ZERO_BYTES = 1 * MiB;
constexpr size_t WS_TOKLIST = 58 * MiB;
constexpr size_t WS_RSLIST = 62 * MiB;
constexpr size_t WS_TOKREC = 66 * MiB;
constexpr size_t WS_TOKW = 67 * MiB;
constexpr size_t WS_SSQ = 68 * MiB;
constexpr size_t WS_XN = 72 * MiB;
constexpr size_t WS_PROJ = 136 * MiB;
constexpr size_t WS_MIXED = 248 * MiB;
constexpr size_t WS_HB = 312 * MiB;
constexpr size_t WS_HID = 376 * MiB;
constexpr size_t WS_Y = 72 * MiB;
constexpr size_t WS_AF = 412 * MiB;
constexpr size_t WS_VN = 72 * MiB;
constexpr size_t WS_HF = 376 * MiB;
constexpr size_t WS_END = 512 * MiB;
constexpr int CW_CNT = 64;

struct Params {
    const float* in[20];
    float* out;
    unsigned char* ws;
};

__device__ __forceinline__ float wave_sum(float v) {
#pragma unroll
    for (int o = 1; o < 64; o <<= 1) v += __shfl_xor(v, o);
    return v;
}
__device__ __forceinline__ float gelu_exact(float v) { return 0.5f * v * (1.0f + erff(v * 0.70710678118654752f)); }

#define LAS __attribute__((address_space(3)))
#define GAS __attribute__((address_space(1)))
typedef short bf16x8 __attribute__((ext_vector_type(8)));
typedef short s16x4 __attribute__((ext_vector_type(4)));
typedef float f32x4 __attribute__((ext_vector_type(4)));
typedef float f32x16 __attribute__((ext_vector_type(16)));
typedef float f32x2 __attribute__((ext_vector_type(2)));
typedef unsigned u32x4 __attribute__((ext_vector_type(4)));
typedef unsigned u32x2 __attribute__((ext_vector_type(2)));
typedef GAS unsigned gu32;

constexpr size_t WS_WIN_T = 2 * MiB;
constexpr size_t WS_WO_T = 6 * MiB;
constexpr size_t WS_WSP = 8 * MiB;
constexpr size_t WS_WR_T = 8 * MiB + 512 * 1024;
constexpr size_t WS_SSQM = 70 * MiB;
constexpr size_t WS_RSX = 9 * MiB;
constexpr size_t WS_WGU_T = 10 * MiB;
constexpr size_t WS_WD_T = 42 * MiB;
constexpr int CW_TMO = 0;
constexpr int CW_BAR = 4096;

constexpr int NWAVES = 8;
constexpr int RING_BYTES = 131072;
constexpr int LDS_BYTES = 163840;
constexpr int MISC_OFF = 163840 - 1024;
constexpr float LOG2E = 1.4426950408889634f;

__device__ __forceinline__ unsigned cvt_pk_bf16(float lo, float hi) { unsigned r; asm volatile("v_cvt_pk_bf16_f32 %0, %1, %2" : "=v"(r) : "v"(lo), "v"(hi)); return r; }
#define MFMA32(a, b, c) __builtin_amdgcn_mfma_f32_32x32x16_bf16((a), (b), (c), 0, 0, 0)
#define MFMA16(a, b, c) __builtin_amdgcn_mfma_f32_16x16x32_bf16((a), (b), (c), 0, 0, 0)
typedef short v4i16_t __attribute__((ext_vector_type(4)));
__device__ __forceinline__ s16x4 vtr(const LAS unsigned char* p) { return __builtin_bit_cast(s16x4, __builtin_amdgcn_ds_read_tr16_b64_v4i16((LAS v4i16_t*)p)); }

namespace pg8 {
constexpr int BM = 256, BK = 64, HALF = 128, HTB = HALF * BK * 2, STAGE_BYTES = 8 * HTB, NXCD = 8, WGM = 8;
__host__ __device__ __forceinline__ int lds_byte(int r, int c) { const int st = (r >> 4) * 2 + (c >> 5), rr = r & 15, cc = c & 31, ob = rr * 64 + cc * 2; return st * 1024 + (ob ^ (((ob >> 9) & 1) << 5)); }
__host__ __device__ __forceinline__ void stage_rc(int b, int& R, int& C) { const int st = b / 1024, sb = b % 1024, swz = sb ^ (((sb >> 9) & 1) << 5); R = (st >> 1) * 16 + swz / 64; C = (st & 1) * 32 + (swz % 64) / 2; }
__host__ __device__ __forceinline__ int perm32(int rho) { const int n = rho >> 4, i = rho & 15; return 8 * (i >> 2) + 4 * n + (i & 3); }

struct Unit { int pm, pn, e, pos0, ne, nv; };
struct Gemm { const bf16_t* A; const bf16_t* Bt; int K; int pad; };

__device__ __forceinline__ int xcd_remap(int L, int nwg) { const int q = nwg / NXCD, r = nwg % NXCD, xcd = L % NXCD, off = L / NXCD; return (xcd < r ? xcd * (q + 1) : r * (q + 1) + (xcd - r) * q) + off; }

struct StaticOrder {
    int nM, nN, nwg, G, c, K;
    __device__ void init(int M, int N, int K_, int G_, int c_) { nM = M / BM; nN = N / BM; nwg = nM * nN; G = G_; c = c_; K = K_; }
    __device__ __forceinline__ bool next(int i, Unit& u) const {
        const long L = (long)i * G + c; if (L >= nwg) return false;
        const int wgid = xcd_remap((int)L, nwg);
        const int nig = WGM * nN, gid = wgid / nig, fm = gid * WGM, gsz = (nM - fm) < WGM ? (nM - fm) : WGM;
        u.pm = fm + ((wgid % nig) % gsz); u.pn = (wgid % nig) / gsz; u.e = 0; u.pos0 = 0; u.ne = 0; u.nv = BM; return true;
    }
    __device__ __forceinline__ size_t b_off(const Unit& u) const { return (size_t)u.pn * BM * K; }
    __device__ __forceinline__ int a_row(const Unit& u, int r) const { return u.pm * BM + r; }
};

template <class Epi, class Sched>
__device__ __forceinline__ void gemm_phase(LAS unsigned char* lds, const Gemm g, const Sched& S, const Epi& E) {
    const int tid = threadIdx.x, wid = __builtin_amdgcn_readfirstlane(tid >> 6), lane = tid & 63, wr = wid >> 2, wc = wid & 3, fr = lane & 15, fq = lane >> 4;
    const int K = g.K, nt = K / BK;
    unsigned voffB[2];
#pragma unroll
    for (int i = 0; i < 2; ++i) { int R, C; stage_rc(tid * 16 + i * 8192, R, C); const int Rb = Epi::PERM ? ((R >> 5) * 64 + perm32(R & 31)) : R;
        voffB[i] = (unsigned)(Rb * K + C) * 2u; }
    const size_t kstep = (size_t)(BK * 2);
    const size_t hstep = (size_t)(Epi::PERM ? 32 : HALF) * K * 2;
    const unsigned ldsw = (unsigned)wid * 1024u;
    const int aoff = lds_byte(wr * 64 + fr, fq * 8), boff = lds_byte(wc * 32 + fr, fq * 8);
#define PG8_SA(b, h) (((b) * 2 + (h)) * HTB)
#define PG8_SB(b, h) ((4 + (b) * 2 + (h)) * HTB)
#define PG8_STAGE2(bufoff, gbase, v0, v1) do { \
        __builtin_amdgcn_global_load_lds((const unsigned*)((const char*)(gbase) + (v0)), (LAS unsigned*)(lds + (bufoff) + ldsw), 16, 0, 0); \
        __builtin_amdgcn_global_load_lds((const unsigned*)((const char*)(gbase) + (v1)), (LAS unsigned*)(lds + (bufoff) + ldsw + 8192), 16, 0, 0); } while (0)
#define PG8_STAGEB(bufoff, gbase) PG8_STAGE2(bufoff, gbase, voffB[0], voffB[1])
#define PG8_VOFFA(dst, U) do { _Pragma("unroll") for (int _i = 0; _i < 2; ++_i) { int _R, _C; stage_rc(threadIdx.x * 16 + _i * 8192, _R, _C); _Pragma("unroll") for (int _h = 0; _h < 2; ++_h) \
        dst[_h][_i] = ((unsigned)S.a_row(U, _h * HALF + _R) * (unsigned)K + (unsigned)_C) * 2u; } } while (0)
#define PG8_LDA(dst, b, h) do { _Pragma("unroll") for (int m = 0; m < 4; ++m) _Pragma("unroll") for (int k = 0; k < 2; ++k) dst[m][k] = *(const LAS bf16x8*)(lds + PG8_SA(b, h) + aoff + m * 2048 + k * 1024); } while (0)
#define PG8_LDB(dst, b, h) do { _Pragma("unroll") for (int n = 0; n < 2; ++n) _Pragma("unroll") for (int k = 0; k < 2; ++k) dst[n][k] = *(const LAS bf16x8*)(lds + PG8_SB(b, h) + boff + n * 2048 + k * 1024); } while (0)
#define PG8_MMA(ai, bj, At, Bt) do { if ((ai) * HALF + wr * 64 < cur.nv) { __builtin_amdgcn_s_setprio(1); _Pragma("unroll") for (int m = 0; m < 4; ++m) _Pragma("unroll") for (int n = 0; n < 2; ++n) _Pragma("unroll") for (int k = 0; k < 2; ++k) \
        acc[ai][bj][m][n] = __builtin_amdgcn_mfma_f32_16x16x32_bf16(Bt[n][k], At[m][k], acc[ai][bj][m][n], 0, 0, 0); __builtin_amdgcn_s_setprio(0); } } while (0)
#define PG8_WAIT_V(n) asm volatile("s_waitcnt vmcnt(" #n ")" ::: "memory")
#define PG8_WAIT_L(n) asm volatile("s_waitcnt lgkmcnt(" #n ")" ::: "memory")
#define PG8_BAR __builtin_amdgcn_s_barrier()
#define PG8_SCHED __builtin_amdgcn_sched_barrier(0)
    Unit cur, nxt; int ui = 0;
    if (!S.next(0, cur)) return;
    f32x4 acc[2][2][4][2];
#pragma unroll
    for (int a = 0; a < 2; ++a)
#pragma unroll
        for (int b = 0; b < 2; ++b)
#pragma unroll
            for (int m = 0; m < 4; ++m)
#pragma unroll
                for (int n = 0; n < 2; ++n) acc[a][b][m][n] = (f32x4){0.f, 0.f, 0.f, 0.f};
    bf16x8 At[4][2], B0[2][2], B1[2][2];
    const char* Ab = (const char*)g.A;
    const char* cB = (const char*)(g.Bt + S.b_off(cur));
    unsigned vA[2][2], nvA[2][2];
    PG8_VOFFA(vA, cur);
    PG8_STAGEB(PG8_SB(0, 0), cB); PG8_STAGEB(PG8_SB(0, 1), cB + hstep); PG8_STAGE2(PG8_SA(0, 0), Ab, vA[0][0], vA[0][1]); PG8_STAGE2(PG8_SA(0, 1), Ab, vA[1][0], vA[1][1]);
    if (wr == 1) PG8_BAR;
    PG8_WAIT_V(2); PG8_BAR;
    PG8_STAGEB(PG8_SB(1, 0), cB + kstep); PG8_STAGE2(PG8_SA(1, 0), Ab + kstep, vA[0][0], vA[0][1]); PG8_STAGEB(PG8_SB(1, 1), cB + hstep + kstep);
    PG8_WAIT_V(6); PG8_BAR;
    for (;;) {
        const bool has_next = S.next(ui + 1, nxt);
        const char* nB = cB;
#pragma unroll
        for (int h = 0; h < 2; ++h)
#pragma unroll
            for (int i = 0; i < 2; ++i) nvA[h][i] = vA[h][i];
        if (has_next) { nB = (const char*)(g.Bt + S.b_off(nxt)); PG8_VOFFA(nvA, nxt); }
        for (int t = 0; t < nt; t += 2) {
            const bool last = (t == nt - 2);
            const char* a1 = Ab + (size_t)(t + 1) * kstep;
            const char* a2 = last ? Ab : Ab + (size_t)(t + 2) * kstep; const char* b2 = last ? nB : cB + (size_t)(t + 2) * kstep;
            const char* a3 = a2 + kstep; const char* b3 = b2 + kstep;
            if constexpr (Epi::MIDK >= 0) { if (t == Epi::MIDK) E.mid(acc, cur, wr, fr); }
            unsigned o00 = vA[0][0], o01 = vA[0][1], o10 = vA[1][0], o11 = vA[1][1];
            if (last) { asm volatile("" : "+v"(nvA[0][0]), "+v"(nvA[0][1]), "+v"(nvA[1][0]), "+v"(nvA[1][1])); o00 = nvA[0][0]; o01 = nvA[0][1]; o10 = nvA[1][0]; o11 = nvA[1][1]; }
            PG8_LDB(B0, 0, 0); PG8_LDB(B1, 0, 1); PG8_SCHED; PG8_LDA(At, 0, 0); PG8_STAGE2(PG8_SA(1, 1), a1, vA[1][0], vA[1][1]);
            PG8_WAIT_V(8); PG8_WAIT_L(0); PG8_BAR; PG8_MMA(0, 0, At, B0); PG8_MMA(0, 1, At, B1); PG8_BAR; PG8_SCHED;
            PG8_LDA(At, 0, 1); PG8_STAGEB(PG8_SB(0, 0), b2); PG8_STAGEB(PG8_SB(0, 1), b2 + hstep); PG8_STAGE2(PG8_SA(0, 0), a2, o00, o01);
            PG8_WAIT_V(8); PG8_WAIT_L(0); PG8_BAR; PG8_MMA(1, 0, At, B0); PG8_MMA(1, 1, At, B1); PG8_BAR; PG8_SCHED;
            PG8_LDB(B0, 1, 0); PG8_LDB(B1, 1, 1); PG8_SCHED; PG8_LDA(At, 1, 0); PG8_STAGE2(PG8_SA(0, 1), a2, o10, o11);
            PG8_WAIT_V(8); PG8_WAIT_L(0); PG8_BAR; PG8_MMA(0, 0, At, B0); PG8_MMA(0, 1, At, B1); PG8_BAR; PG8_SCHED;
            PG8_LDA(At, 1, 1); PG8_STAGEB(PG8_SB(1, 0), b3); PG8_STAGEB(PG8_SB(1, 1), b3 + hstep); PG8_STAGE2(PG8_SA(1, 0), a3, o00, o01);
            PG8_WAIT_V(8); PG8_WAIT_L(0); PG8_BAR; PG8_MMA(1, 0, At, B0); PG8_MMA(1, 1, At, B1); PG8_BAR; PG8_SCHED;
        }
        if (wr == 0) PG8_BAR;
        E(acc, cur, wr, wc, fr, fq);
        if (!has_next) break;
#pragma unroll
        for (int a = 0; a < 2; ++a)
#pragma unroll
            for (int b = 0; b < 2; ++b)
#pragma unroll
                for (int m = 0; m < 4; ++m)
#pragma unroll
                    for (int n = 0; n < 2; ++n) acc[a][b][m][n] = (f32x4){0.f, 0.f, 0.f, 0.f};
        cur = nxt; cB = nB; ++ui;
#pragma unroll
        for (int h = 0; h < 2; ++h)
#pragma unroll
            for (int i = 0; i < 2; ++i) vA[h][i] = nvA[h][i];
        if (wr == 1) PG8_BAR;
    }
    PG8_WAIT_V(0);
    PG8_BAR;
#undef PG8_SA
#undef PG8_SB
#undef PG8_STAGE2
#undef PG8_STAGEB
#undef PG8_VOFFA
#undef PG8_LDA
#undef PG8_LDB
#undef PG8_MMA
#undef PG8_WAIT_V
#undef PG8_WAIT_L
#undef PG8_BAR
#undef PG8_SCHED
}

__device__ __forceinline__ f32x2 gelu_pk(f32x2 v) {
    const f32x2 av = __builtin_elementwise_abs(v), d = av * 0.2316418882f + 1.0f;
    f32x2 t; t.x = __builtin_amdgcn_rcpf(d.x); t.y = __builtin_amdgcn_rcpf(d.y);
    f32x2 q = t * 0.5307027145f + (-0.7265760135f); q = q * t + 0.7107068705f; q = q * t + (-0.142248368f); q = q * t + 0.127414796f; q = q * t;
    const f32x2 s = (v * v) * (-0.72134752044f);
    f32x2 e; e.x = __builtin_amdgcn_exp2f(s.x); e.y = __builtin_amdgcn_exp2f(s.y);
    const f32x2 m = v * (q * e), r = v - m;
    f32x2 o; o.x = v.x < 0.f ? m.x : r.x; o.y = v.y < 0.f ? m.y : r.y; return o;
}

struct EpiBf16G {   static constexpr int MIDK = -1;
    static constexpr bool PERM = true;
    bf16_t* O; int ldc; int gelu_from; f32x2* STAT; int stat_from; int pad; const float* rowscale;
    __device__ __forceinline__ void operator()(const f32x4 (&acc)[2][2][4][2], const Unit& u, int wr, int wc, int fr, int fq) const {
        const int row0 = u.pm * BM + wr * 64 + fr, col0 = u.pn * BM + wc * 64 + 8 * fq, rl0 = wr * 64 + fr;
        const bool act = u.pn >= gelu_from, st = u.pn >= stat_from;
#pragma unroll
        for (int ai = 0; ai < 2; ++ai)
#pragma unroll
            for (int m = 0; m < 4; ++m) { bf16_t* rowp = O + (size_t)(row0 + ai * HALF + m * 16) * ldc + col0; float s1 = 0.f, s2 = 0.f;
                const bool live = rl0 + ai * HALF + m * 16 < u.nv; const float rsc = rowscale ? rowscale[row0 + ai * HALF + m * 16] : 1.f;
#pragma unroll
                for (int bj = 0; bj < 2; ++bj) { f32x4 v0 = acc[ai][bj][m][0] * rsc, v1 = acc[ai][bj][m][1] * rsc;
                    if (act) { f32x2 a = gelu_pk((f32x2){v0[0], v0[1]}), b = gelu_pk((f32x2){v0[2], v0[3]}), c = gelu_pk((f32x2){v1[0], v1[1]}), d = gelu_pk((f32x2){v1[2], v1[3]});
                        v0 = (f32x4){a.x, a.y, b.x, b.y}; v1 = (f32x4){c.x, c.y, d.x, d.y}; }
                    if (st) { s1 += (v0[0] + v0[1]) + (v0[2] + v0[3]) + (v1[0] + v1[1]) + (v1[2] + v1[3]);
                        s2 += (v0[0] * v0[0] + v0[1] * v0[1]) + (v0[2] * v0[2] + v0[3] * v0[3]) + (v1[0] * v1[0] + v1[1] * v1[1]) + (v1[2] * v1[2] + v1[3] * v1[3]); }
                    u32x4 w; w.x = cvt_pk_bf16(v0[0], v0[1]); w.y = cvt_pk_bf16(v0[2], v0[3]); w.z = cvt_pk_bf16(v1[0], v1[1]); w.w = cvt_pk_bf16(v1[2], v1[3]);
                    if (live) *(u32x4*)(rowp + bj * 32) = w; }
                if (st) { s1 += __shfl_xor(s1, 16); s1 += __shfl_xor(s1, 32); s2 += __shfl_xor(s2, 16); s2 += __shfl_xor(s2, 32);
                    if (fq == 0) STAT[(size_t)(row0 + ai * HALF + m * 16) * 8 + (u.pn - stat_from) * 4 + wc] = (f32x2){s1, s2}; } }
    }
};
struct EpiH {
    static constexpr bool PERM = true;
    static constexpr int MIDK = 8;
    const bf16_t* x; bf16_t* HB; float* SSQ; const LAS f32x2* tab; int pms[4];
    __device__ __forceinline__ int slot(const Unit& u) const { return u.pm == pms[0] ? 0 : (u.pm == pms[1] ? 1 : (u.pm == pms[2] ? 2 : 3)); }
    __device__ __forceinline__ void mid(f32x4 (&acc)[2][2][4][2], const Unit& u, int wr, int fr) const {
        const LAS f32x2* t = tab + slot(u) * 256 + wr * 64 + fr;
#pragma unroll
        for (int ai = 0; ai < 2; ++ai)
#pragma unroll
            for (int m = 0; m < 4; ++m) { const float sc = t[ai * HALF + m * 16].x;
#pragma unroll
                for (int bj = 0; bj < 2; ++bj)
#pragma unroll
                    for (int n = 0; n < 2; ++n) acc[ai][bj][m][n] *= sc; }
    }
    __device__ __forceinline__ void operator()(const f32x4 (&acc)[2][2][4][2], const Unit& u, int wr, int wc, int fr, int fq) const {
        const int row0 = u.pm * BM + wr * 64 + fr, col0 = u.pn * BM + wc * 64 + 8 * fq;
        const LAS f32x2* t = tab + slot(u) * 256 + wr * 64 + fr;
        u32x4 xw[2][4][2];
#pragma unroll
        for (int ai = 0; ai < 2; ++ai)
#pragma unroll
            for (int m = 0; m < 4; ++m)
#pragma unroll
                for (int bj = 0; bj < 2; ++bj) xw[ai][m][bj] = *(const u32x4*)(x + (size_t)(row0 + ai * HALF + m * 16) * DM + col0 + bj * 32);
#pragma unroll
        for (int ai = 0; ai < 2; ++ai)
#pragma unroll
            for (int m = 0; m < 4; ++m) { const int row = row0 + ai * HALF + m * 16; bf16_t* hr = HB + (size_t)row * DM + col0; float s = 0.f;
                const float rg = t[ai * HALF + m * 16].y;
#pragma unroll
                for (int bj = 0; bj < 2; ++bj) { const u32x4 w4 = xw[ai][m][bj];
                    const f32x4 x0 = (f32x4){__uint_as_float(w4.x << 16), __uint_as_float(w4.x & 0xffff0000u), __uint_as_float(w4.y << 16), __uint_as_float(w4.y & 0xffff0000u)}, x1 = (f32x4){__uint_as_float(w4.z << 16), __uint_as_float(w4.z & 0xffff0000u), __uint_as_float(w4.w << 16), __uint_as_float(w4.w & 0xffff0000u)};
                    const f32x4 v0 = acc[ai][bj][m][0] * rg + x0, v1 = acc[ai][bj][m][1] * rg + x1;
                    s += (v0[0] * v0[0] + v0[1] * v0[1]) + (v0[2] * v0[2] + v0[3] * v0[3]) + (v1[0] * v1[0] + v1[1] * v1[1]) + (v1[2] * v1[2] + v1[3] * v1[3]);
                    u32x4 w; w.x = cvt_pk_bf16(v0[0], v0[1]); w.y = cvt_pk_bf16(v0[2], v0[3]); w.z = cvt_pk_bf16(v1[0], v1[1]); w.w = cvt_pk_bf16(v1[2], v1[3]);
                    *(u32x4*)(hr + bj * 32) = w; }
                s += __shfl_xor(s, 16); s += __shfl_xor(s, 32);
                if (fq == 0) SSQ[(size_t)row * 16 + u.pn * 4 + wc] = s; }
    }
};
}

template <bool GATHER>
struct MoeOrder {
    const volatile LAS int* toff;
    const int* cnt; const int* toklist;
    int nN, nwg, G, c, K, rows_per_e;
    __device__ __forceinline__ bool next(int i, pg8::Unit& u) const {
        const long L = (long)i * G + c; if (L >= nwg) return false;
        const int wgid = pg8::xcd_remap((int)L, nwg);
        const int T = wgid / nN; u.pn = wgid % nN; u.pm = T;
        int e = 0;
        for (int j = 1; j < NEXP; ++j) e += (toff[j] <= T) ? 1 : 0;
        e = __builtin_amdgcn_readfirstlane(e);
        u.e = e; u.pos0 = __builtin_amdgcn_readfirstlane((T - toff[e]) * 256); u.ne = __builtin_amdgcn_readfirstlane(toff[64 + e]); { const int left = u.ne - u.pos0; u.nv = left < 256 ? left : 256; } return true;
    }
    __device__ __forceinline__ size_t b_off(const pg8::Unit& u) const { return ((size_t)u.e * rows_per_e + (size_t)u.pn * 256) * K; }
    __device__ __forceinline__ int a_row(const pg8::Unit& u, int r) const {
        if (!GATHER) return u.pm * 256 + r;
        const int pos = u.pos0 + r;
        return pos < u.ne ? toklist[(size_t)u.e * NTOK + pos] : 0;
    }
};
struct EpiSwiglu {   static constexpr int MIDK = -1;
    static constexpr bool PERM = true;
    bf16_t* HID; const float* rslist;
    __device__ __forceinline__ void operator()(const f32x4 (&acc)[2][2][4][2], const pg8::Unit& u, int wr, int wc, int fr, int fq) const {
        const int r0 = wr * 64 + fr, col0 = u.pn * 128 + wc * 32 + 8 * fq; const int pos0 = u.pos0, n_e = u.ne;
#pragma unroll
        for (int ai = 0; ai < 2; ++ai)
#pragma unroll
            for (int m = 0; m < 4; ++m) { const int r = r0 + ai * 128 + m * 16, pos = pos0 + r;
                const float rs = pos < n_e ? rslist[(size_t)u.e * NTOK + pos] : 0.f;
                float o[8];
#pragma unroll
                for (int n = 0; n < 2; ++n)
#pragma unroll
                    for (int j = 0; j < 4; ++j) { const float gt = acc[ai][0][m][n][j] * rs, up = acc[ai][1][m][n][j] * rs;
                        o[4 * n + j] = gt * __builtin_amdgcn_rcpf(1.f + __builtin_amdgcn_exp2f(-gt * LOG2E)) * up; }
                u32x4 w; w.x = cvt_pk_bf16(o[0], o[1]); w.y = cvt_pk_bf16(o[2], o[3]); w.z = cvt_pk_bf16(o[4], o[5]); w.w = cvt_pk_bf16(o[6], o[7]);
                if (r < u.nv || true) *(u32x4*)(HID + (size_t)(u.pm * 256 + r) * DEXP + col0) = w; }
    }
};

#define XB_TMO      128
#define XB_XCNT(j)  (256  + 64 * (j))
#define XB_XSUB(j)  (1280 + 64 * (j))
#define XB_XGEN(j)  (2304 + 64 * (j))
#define XB_TOP      3328
#define XB_TOPGEN   3392
#define XCD_BAR_WORDS 3456
#define XB_SPIN_CAP (1u << 18)
__device__ __forceinline__ unsigned xb_ld(unsigned* p)              { return __hip_atomic_load(p, __ATOMIC_RELAXED, __HIP_MEMORY_SCOPE_AGENT); }
__device__ __forceinline__ unsigned xb_add(unsigned* p, unsigned v) { return __hip_atomic_fetch_add(p, v, __ATOMIC_RELAXED, __HIP_MEMORY_SCOPE_AGENT); }
__device__ __forceinline__ unsigned xb_xcc_id() { return (unsigned)__builtin_amdgcn_s_getreg((3 << 11) | 20) & 0xFu; }
#define XB_SPIN(cond, bar) do { unsigned _sp = 0; while (cond) { __builtin_amdgcn_s_sleep(1); \
    if ((++_sp & 255u) == 0u) { if (xb_ld(&(bar)[XB_TMO])) break; if (_sp > XB_SPIN_CAP) { atomicAdd(&(bar)[XB_TMO], 1u); break; } } } } while (0)
struct XcdBarrier { unsigned* bar; unsigned x; volatile LAS unsigned* st; };
__device__ __forceinline__ XcdBarrier xcd_barrier_post(unsigned* bar, volatile LAS unsigned* st) {
    XcdBarrier b; b.bar = bar; b.x = xb_xcc_id(); b.st = st;
    if (threadIdx.x == 0) (void)xb_add(&bar[XB_XCNT(b.x)], 1u);
    return b;
}
__device__ __forceinline__ void xcd_barrier_complete(unsigned* bar, unsigned x, unsigned& nloc, unsigned& nx) {
    const unsigned G = gridDim.x * gridDim.y * gridDim.z;
    unsigned sum, cnt, mine, sp = 0u;
    for (;;) {
        sum = 0u; cnt = 0u; mine = 0u;
#pragma unroll
        for (unsigned j = 0; j < 16; ++j) { const unsigned c = xb_ld(&bar[XB_XCNT(j)]); sum += c; cnt += (c > 0u) ? 1u : 0u; mine = (j == x) ? c : mine; }
        if (sum == G) break;
        __builtin_amdgcn_s_sleep(1);
        if ((++sp & 255u) == 0u) { if (xb_ld(&bar[XB_TMO])) break; if (sp > XB_SPIN_CAP) { atomicAdd(&bar[XB_TMO], 1u); break; } }
    }
    nloc = mine > 0u ? mine : 1u; nx = cnt > 0u ? cnt : 1u;
}
struct Frame;
template <int WHICH> __device__ __forceinline__ void convert_rest(Frame& F, int part, int nparts, int lo, int hi);
__device__ __forceinline__ void barrier_background(Frame& F, int bg);
__device__ __forceinline__ void xcd_barrier(const XcdBarrier& b, Frame* Fp = nullptr, int bg = -1) {
    asm volatile("s_waitcnt vmcnt(0)" ::: "memory");
    __syncthreads();
    if (bg >= 0 && threadIdx.x >= 64) barrier_background(*Fp, bg);
    if (threadIdx.x == 0) {
        unsigned* bar = b.bar;
        __builtin_amdgcn_s_waitcnt(0);
        unsigned nloc = b.st[0], nx = b.st[1];
        if (nloc == 0u) { xcd_barrier_complete(bar, b.x, nloc, nx); b.st[0] = nloc; b.st[1] = nx; }
        const unsigned old = xb_add(&bar[XB_XSUB(b.x)], 1u);
        const unsigned gen = old / nloc;
        if (old + 1u == (gen + 1u) * nloc) {
            __builtin_amdgcn_fence(__ATOMIC_RELEASE, "agent");
            asm volatile("s_waitcnt vmcnt(0)" ::: "memory");
            const unsigned og = xb_add(&bar[XB_TOP], 1u);
            const unsigned tg = og / nx;
            if (og + 1u == (tg + 1u) * nx) xb_add(&bar[XB_TOPGEN], 1u);
            else XB_SPIN(xb_ld(&bar[XB_TOPGEN]) == tg, bar);
            __builtin_amdgcn_fence(__ATOMIC_ACQUIRE, "agent");
            xb_add(&bar[XB_XGEN(b.x)], 1u);
            asm volatile("s_waitcnt vmcnt(0)" ::: "memory");
        } else {
            XB_SPIN(xb_ld(&bar[XB_XGEN(b.x)]) == gen, bar);
            __builtin_amdgcn_fence(__ATOMIC_ACQUIRE, "agent");
            asm volatile("s_waitcnt vmcnt(0)" ::: "memory");
        }
    }
    __syncthreads();
}

struct Frame {
    LAS unsigned char* lds;
    volatile LAS unsigned* MISC;
    int tid, lane, wave, vcu, G;
    const float* const* in; float* out; unsigned char* ws;
};
#define LDS_WAIT() asm volatile("s_waitcnt lgkmcnt(0)" ::: "memory")

__device__ __forceinline__ void transpose_tile64(const float* W, int ldw, int k0, int n0, bf16_t* WT, int ldt, int rowbase, const float* kscale, int lane, int hi32 = 32) {
    const float* src = W + (size_t)k0 * ldw + n0 + lane;
    float v[64];
#pragma unroll
    for (int k = 0; k < 64; ++k) v[k] = __builtin_nontemporal_load(src + (size_t)k * ldw);
    if (kscale) {
#pragma unroll
        for (int k = 0; k < 64; ++k) v[k] *= kscale[k0 + k];
    }
    bf16_t* dst = WT + (size_t)(rowbase + (lane & 31) + (lane >> 5) * hi32) * ldt + k0;
#pragma unroll
    for (int c = 0; c < 8; ++c) { u32x4 o; o.x = cvt_pk_bf16(v[8 * c], v[8 * c + 1]); o.y = cvt_pk_bf16(v[8 * c + 2], v[8 * c + 3]); o.z = cvt_pk_bf16(v[8 * c + 4], v[8 * c + 5]); o.w = cvt_pk_bf16(v[8 * c + 6], v[8 * c + 7]);
        *(u32x4*)(dst + 8 * c) = o; }
}

__device__ __forceinline__ void p0_prologue(Frame& F) {
    const int gw = F.vcu * NWAVES + F.wave, NGW = F.G * NWAVES, lane = F.lane;
    unsigned char* ws = F.ws;
    for (int it = gw; it < 16 * 28; it += NGW) { const int kb = it / 28, nb = it % 28; transpose_tile64(F.in[2], NPROJ, 64 * kb, 64 * nb, (bf16_t*)(ws + WS_WIN_T), DM, 64 * nb, F.in[1], lane); }
    const int gt = F.vcu * (NWAVES * 64) + F.tid, NGT = F.G * NWAVES * 64;
    for (int i = gt; i < 8 * 128 * 128; i += NGT) { const int c = i & 127, t = (i >> 7) & 127; ((bf16_t*)(ws + WS_WSP))[i] = c <= t ? f2bf(F.in[4][i]) : (bf16_t)0; }
    for (int i = gt; i < 64 * DM; i += NGT) { const int k = i & (DM - 1), c = i >> 10; float v = 0.f;
        if (c < 4) v = F.in[12][k * 4 + c] * F.in[11][k];
        else if (c < 36) { const int g = (c - 4) >> 3, e = (c - 4) & 7; v = F.in[14][((size_t)g * DM + k) * 8 + e] * F.in[11][k]; }
        ((bf16_t*)(ws + WS_WR_T))[i] = f2bf(v); }
    float* rsx = (float*)(ws + WS_RSX);
    for (int row0 = gw * 8; row0 < NTOK; row0 += NGW * 8) {
        f32x4 v[8][4];
#pragma unroll
        for (int rr = 0; rr < 8; ++rr)
#pragma unroll
            for (int j = 0; j < 4; ++j) v[rr][j] = __builtin_nontemporal_load((const f32x4*)(F.in[0] + (size_t)(row0 + rr) * DM + 256 * j + 4 * lane));
#pragma unroll
        for (int rr = 0; rr < 8; ++rr) {
            float s = 0.f;
#pragma unroll
            for (int j = 0; j < 4; ++j) s += (v[rr][j][0] * v[rr][j][0] + v[rr][j][1] * v[rr][j][1]) + (v[rr][j][2] * v[rr][j][2] + v[rr][j][3] * v[rr][j][3]);
            const float rstd = rsqrtf(wave_sum(s) * (1.f / DM) + RMS_EPS);
            if (lane == 0) rsx[row0 + rr] = rstd;
            bf16_t* xn = (bf16_t*)(ws + WS_XN) + (size_t)(row0 + rr) * DM;
#pragma unroll
            for (int j = 0; j < 4; ++j) { u32x2 o; o.x = cvt_pk_bf16(v[rr][j][0], v[rr][j][1]); o.y = cvt_pk_bf16(v[rr][j][2], v[rr][j][3]);
                *(u32x2*)(xn + 256 * j + 4 * lane) = o; }
        }
    }
}
template <int WHICH>
__device__ __forceinline__ void convert_rest(Frame& F, int part, int nparts, int lo, int hi) {
    unsigned char* ws = F.ws; const int lane = F.lane;
    constexpr int T_OUT = 16 * 16, T_GU = NEXP * 64, T_D = NEXP * 64;
    if (WHICH == 0) {
        for (int it = lo + part; it < 2 * T_GU && it < hi; it += nparts) {
            int r = it; const int up = r >= T_GU; if (up) r -= T_GU; const int e = r / 64, q = r % 64, kb = q / 4, nb = q % 4, n0 = 64 * nb;
            const int rowbase = e * 512 + 256 * (n0 >> 7) + 2 * (n0 & 127) + (up ? 32 : 0);
            transpose_tile64(F.in[up ? 17 : 16] + (size_t)e * DM * DEXP, DEXP, 64 * kb, n0, (bf16_t*)(ws + WS_WGU_T), DM, rowbase, F.in[11], lane, 64); }
    } else if (WHICH == 1) {
        for (int it = part; it < T_OUT; it += nparts) { const int kb = it / 16, nb = it % 16; transpose_tile64(F.in[10], DM, 64 * kb, 64 * nb, (bf16_t*)(ws + WS_WO_T), DM, 64 * nb, 64 * kb < 512 ? F.in[8] : F.in[9] - 512, lane); }
    } else {
        for (int it = part; it < T_D; it += nparts) { const int e = it / 64, q = it % 64, kb = q / 16, nb = q % 16;
            transpose_tile64(F.in[18] + (size_t)e * DEXP * DM, DM, 64 * kb, 64 * nb, (bf16_t*)(ws + WS_WD_T), DEXP, e * DM + 64 * nb, nullptr, lane); }
    }
}

__device__ __forceinline__ void barrier_background(Frame& F, int bg) {
    constexpr int NT = 2 * NEXP * 64, PER = (NT + 2) / 3;
    convert_rest<0>(F, F.vcu * (NWAVES - 1) + (F.wave - 1), F.G * (NWAVES - 1), bg * PER, (bg + 1) * PER);
}

constexpr int P2_K_OFF = 0, P2_KROW = 144, P2_KHEAD = 256 * P2_KROW;
constexpr int P2_V_OFF = 2 * P2_KHEAD, P2_VHEAD = 256 * 128;
constexpr int P2_VN_OFF = 0, P2_VNROW = 1088;
constexpr int P2_EXA_OFF = 139264, P2_EXG_OFF = P2_EXA_OFF + 4096;
static_assert(P2_V_OFF + 2 * P2_VHEAD <= P2_EXA_OFF && 128 * P2_VNROW <= P2_EXA_OFF && P2_EXG_OFF + 4096 <= MISC_OFF, "P2 LDS map");

__device__ __forceinline__ void p2_mix(Frame& F, const int skip) {
    const int tid = F.tid, lane = F.lane, w = F.wave;
    const int r = lane & 31, hh = lane >> 5, g4 = lane >> 4, q4 = (lane & 15) >> 2, p4 = lane & 3;
    const bf16_t* proj = (const bf16_t*)(F.ws + WS_PROJ);
    bf16_t* mixed = (bf16_t*)(F.ws + WS_MIXED);
    const bf16_t* wsp = (const bf16_t*)(F.ws + WS_WSP);
    LAS unsigned char* lds = F.lds;
    float* ssqm = (float*)(F.ws + WS_SSQM);
    const float sink2 = F.in[3][w] * LOG2E;
    const float SC2 = 0.125f * LOG2E;
    for (int unit = F.vcu; unit < NTOK / 128; unit += F.G) {
        const int t0 = unit * 128; const bool first = (unit & 63) == 0;
        {
            u32x4 kv[8], vv[8];
#pragma unroll
            for (int i = 0; i < 8; ++i) { const int pc = tid + 512 * i, key = pc >> 4, sub = pc & 15;
                kv[i] = (u32x4){0u, 0u, 0u, 0u}; vv[i] = (u32x4){0u, 0u, 0u, 0u};
                if (!(first && key < 128)) { const bf16_t* rowp = proj + (size_t)(t0 - 128 + key) * NPROJ; kv[i] = *(const u32x4*)(rowp + C_K + sub * 8); vv[i] = *(const u32x4*)(rowp + C_V + sub * 8); } }
#pragma unroll
            for (int i = 0; i < 8; ++i) { const int pc = tid + 512 * i, key = pc >> 4, sub = pc & 15, kvh = sub >> 3, piece = sub & 7;
                *(LAS u32x4*)(lds + P2_K_OFF + kvh * P2_KHEAD + key * P2_KROW + piece * 16) = kv[i];
                *(LAS u32x4*)(lds + P2_V_OFF + kvh * P2_VHEAD + key * 128 + ((piece ^ (((key >> 1) & 1) << 2)) * 16)) = vv[i]; }
        }
        if (!(skip & 1)) {
            const int kvh = w >> 2;
            const LAS unsigned char* Kl = lds + P2_K_OFF + kvh * P2_KHEAD;
            const LAS unsigned char* Vl = lds + P2_V_OFF + kvh * P2_VHEAD;
            const int vflip = (q4 >> 1) & 1;
            const int vlane = (4 * hh + q4) * 128 + (g4 & 1) * 32 + p4 * 8;
            const int vh0 = vflip * 64, vh1 = (vflip ^ 1) * 64;
            const bf16_t* qbase = proj + (size_t)(t0 + r) * NPROJ + C_Q + 64 * w + 8 * hh;
            bf16x8 qn[4];
#pragma unroll
            for (int s = 0; s < 4; ++s) qn[s] = __builtin_nontemporal_load((const bf16x8*)(qbase + 16 * s));
            __syncthreads();
            for (int qb = 0; qb < 4; ++qb) {
                bf16x8 qf[4];
#pragma unroll
                for (int s = 0; s < 4; ++s) qf[s] = qn[s];
                if (qb < 3) {
#pragma unroll
                    for (int s = 0; s < 4; ++s) qn[s] = __builtin_nontemporal_load((const bf16x8*)(qbase + (size_t)(32 * (qb + 1)) * NPROJ + 16 * s));
                }
                f32x16 sa[5];
#pragma unroll
                for (int cc = 0; cc < 5; ++cc) {
#pragma unroll
                    for (int i = 0; i < 16; ++i) sa[cc][i] = 0.f;
                    const LAS unsigned char* kp = Kl + (32 * (qb + cc) + r) * P2_KROW + 16 * hh;
#pragma unroll
                    for (int s = 0; s < 4; ++s) { const bf16x8 kf = *(const LAS bf16x8*)(kp + 32 * s); sa[cc] = MFMA32(kf, qf[s], sa[cc]); }
                }
                const int q = 32 * qb + r; float mr = -1e30f;
#pragma unroll
                for (int cc = 0; cc < 5; ++cc)
#pragma unroll
                    for (int i = 0; i < 16; ++i) { const int kb = 32 * (qb + cc) + (i & 3) + 8 * (i >> 2) + 4 * hh;
                        if (cc == 0 || cc == 4 || first) { bool ok = true; if (cc == 0) ok = kb >= q + 1; if (cc == 4) ok = kb <= q + 128; if (first) ok = ok && kb >= 128; sa[cc][i] = ok ? sa[cc][i] : -1e30f; }
                        mr = fmaxf(mr, sa[cc][i]); }
                mr = fmaxf(mr, __shfl_xor(mr, 32));
                const float mx = fmaxf(mr * SC2, sink2);
                float sum4[4] = {0.f, 0.f, 0.f, 0.f};
#pragma unroll
                for (int cc = 0; cc < 5; ++cc)
#pragma unroll
                    for (int i = 0; i < 16; ++i) { const float pe = __builtin_amdgcn_exp2f(fmaf(sa[cc][i], SC2, -mx)); sa[cc][i] = pe; sum4[i & 3] += pe; }
                float sum = (sum4[0] + sum4[1]) + (sum4[2] + sum4[3]);
                sum += __shfl_xor(sum, 32);
                const float inv = 1.f / (sum + __builtin_amdgcn_exp2f(sink2 - mx));
                f32x16 o[2];
#pragma unroll
                for (int i = 0; i < 16; ++i) { o[0][i] = 0.f; o[1][i] = 0.f; }
#pragma unroll
                for (int cc = 0; cc < 5; ++cc)
#pragma unroll
                    for (int s2 = 0; s2 < 2; ++s2) {
                        u32x4 pw; pw.x = cvt_pk_bf16(sa[cc][8 * s2 + 0], sa[cc][8 * s2 + 1]); pw.y = cvt_pk_bf16(sa[cc][8 * s2 + 2], sa[cc][8 * s2 + 3]);
                        pw.z = cvt_pk_bf16(sa[cc][8 * s2 + 4], sa[cc][8 * s2 + 5]); pw.w = cvt_pk_bf16(sa[cc][8 * s2 + 6], sa[cc][8 * s2 + 7]);
                        const bf16x8 pf = __builtin_bit_cast(bf16x8, pw);
                        const LAS unsigned char* vp = Vl + (32 * (qb + cc) + 16 * s2) * 128 + vlane;
#pragma unroll
                        for (int db = 0; db < 2; ++db) { const int vh = db ? vh1 : vh0; const s16x4 a0 = vtr(vp + vh), a1 = vtr(vp + 8 * 128 + vh);
                            const bf16x8 vf = (bf16x8){a0[0], a0[1], a0[2], a0[3], a1[0], a1[1], a1[2], a1[3]};
                            o[db] = MFMA32(vf, pf, o[db]); }
                    }
                float ss4[4] = {0.f, 0.f, 0.f, 0.f};
#pragma unroll
                for (int db = 0; db < 2; ++db)
#pragma unroll
                    for (int i = 0; i < 16; ++i) { o[db][i] *= inv; ss4[i & 3] += o[db][i] * o[db][i]; }
                float ss = (ss4[0] + ss4[1]) + (ss4[2] + ss4[3]);
                ss += __shfl_xor(ss, 32);
                if (hh == 0) ssqm[(size_t)(t0 + q) * 16 + w] = ss;
                bf16_t* orow = mixed + (size_t)(t0 + q) * DM + 64 * w + 4 * hh;
#pragma unroll
                for (int db = 0; db < 2; ++db)
#pragma unroll
                    for (int rg = 0; rg < 4; ++rg) { u32x2 ow; ow.x = cvt_pk_bf16(o[db][4 * rg], o[db][4 * rg + 1]); ow.y = cvt_pk_bf16(o[db][4 * rg + 2], o[db][4 * rg + 3]);
                        *(u32x2*)(orow + 32 * db + 8 * rg) = ow; }
            }
        }
        if (!(skip & 2)) {
            u32x4 raw[16];
#pragma unroll
            for (int i = 0; i < 16; ++i) raw[i] = __builtin_nontemporal_load((const u32x4*)(proj + (size_t)(t0 + 16 * w + i) * NPROJ + C_GV + 8 * lane));
            const f32x4 lg0 = *(const f32x4*)(F.in[6] + 8 * lane), lg1 = *(const f32x4*)(F.in[6] + 8 * lane + 4), lb0 = *(const f32x4*)(F.in[7] + 8 * lane), lb1 = *(const f32x4*)(F.in[7] + 8 * lane + 4);
            LAS f32x2* stat = (LAS f32x2*)(lds + P2_EXG_OFF);
            if (tid < 128) { const f32x4* sp = (const f32x4*)((const float*)(F.ws + WS_SSQ) + (size_t)(t0 + tid) * 16); const f32x4 a = sp[0], b = sp[1], c = sp[2], d = sp[3];
                const float s1 = (a[0] + a[2]) + (b[0] + b[2]) + (c[0] + c[2]) + (d[0] + d[2]), s2 = (a[1] + a[3]) + (b[1] + b[3]) + (c[1] + c[3]) + (d[1] + d[3]);
                const float mu = s1 * (1.f / 512), var = fmaxf(s2 * (1.f / 512) - mu * mu, 0.f); stat[tid] = (f32x2){mu, rsqrtf(var + LN_EPS)}; }
            __syncthreads();
#pragma unroll
            for (int i = 0; i < 16; ++i) { const int tok = 16 * w + i; const f32x2 st = stat[tok]; const float mu = st.x, rstd = st.y;
                float v[8];
                v[0] = __uint_as_float(raw[i].x << 16); v[1] = __uint_as_float(raw[i].x & 0xffff0000u); v[2] = __uint_as_float(raw[i].y << 16); v[3] = __uint_as_float(raw[i].y & 0xffff0000u);
                v[4] = __uint_as_float(raw[i].z << 16); v[5] = __uint_as_float(raw[i].z & 0xffff0000u); v[6] = __uint_as_float(raw[i].w << 16); v[7] = __uint_as_float(raw[i].w & 0xffff0000u);
#pragma unroll
                for (int j = 0; j < 8; ++j) v[j] = (v[j] - mu) * rstd;
                u32x4 ow; ow.x = cvt_pk_bf16(v[0] * lg0[0] + lb0[0], v[1] * lg0[1] + lb0[1]); ow.y = cvt_pk_bf16(v[2] * lg0[2] + lb0[2], v[3] * lg0[3] + lb0[3]);
                ow.z = cvt_pk_bf16(v[4] * lg1[0] + lb1[0], v[5] * lg1[1] + lb1[1]); ow.w = cvt_pk_bf16(v[6] * lg1[2] + lb1[2], v[7] * lg1[3] + lb1[3]);
                *(LAS u32x4*)(lds + P2_VN_OFF + tok * P2_VNROW + lane * 16) = ow; }
        }
        if (!(skip & 4)) {
            const LAS unsigned char* vnl = lds + P2_VN_OFF + (8 * hh + q4) * P2_VNROW + (64 * w + 16 * (g4 & 1) + 4 * p4) * 2;
            const bf16_t* wh = wsp + (size_t)w * 128 * 128 + (size_t)r * 128 + 8 * hh;
            const bf16_t* ub = proj + (size_t)(t0 + r) * NPROJ + C_GU + 64 * w + 4 * hh;
            bf16x8 wf[8]; u32x2 uu[8];
#pragma unroll
            for (int s = 0; s < 2; ++s) wf[s] = *(const bf16x8*)(wh + 16 * s);
#pragma unroll
            for (int j = 0; j < 8; ++j) uu[j] = *(const u32x2*)(ub + 32 * (j >> 2) + 8 * (j & 3));
            __syncthreads();
#pragma unroll
            for (int tb = 0; tb < 4; ++tb) {
                f32x16 acc[2];
#pragma unroll
                for (int i = 0; i < 16; ++i) { acc[0][i] = 0.f; acc[1][i] = 0.f; }
#pragma unroll
                for (int s = 0; s < 2 * tb + 2; ++s) {
#pragma unroll
                    for (int db = 0; db < 2; ++db) { const LAS unsigned char* vp = vnl + (16 * s) * P2_VNROW + db * 64;
                        const s16x4 a0 = vtr(vp), a1 = vtr(vp + 4 * P2_VNROW);
                        const bf16x8 af = (bf16x8){a0[0], a0[1], a0[2], a0[3], a1[0], a1[1], a1[2], a1[3]};
                        acc[db] = MFMA32(af, wf[s], acc[db]); }
                }
                const int t = 32 * tb + r; const float bs = F.in[5][w * 128 + t];
                float ss = 0.f;
#pragma unroll
                for (int db = 0; db < 2; ++db)
#pragma unroll
                    for (int rg = 0; rg < 4; ++rg) { const u32x2 u2 = uu[4 * db + rg];
                        const float u0 = __uint_as_float(u2.x << 16), u1 = __uint_as_float(u2.x & 0xffff0000u), u2f = __uint_as_float(u2.y << 16), u3 = __uint_as_float(u2.y & 0xffff0000u);
                        float a = u0 * (acc[db][4 * rg] + bs), b = u1 * (acc[db][4 * rg + 1] + bs), c = u2f * (acc[db][4 * rg + 2] + bs), d = u3 * (acc[db][4 * rg + 3] + bs);
                        acc[db][4 * rg] = a; acc[db][4 * rg + 1] = b; acc[db][4 * rg + 2] = c; acc[db][4 * rg + 3] = d; ss += (a * a + b * b) + (c * c + d * d); }
                if (tb < 3) {
#pragma unroll
                    for (int s = 0; s < 2 * tb + 4; ++s) wf[s] = *(const bf16x8*)(wh + (size_t)(32 * (tb + 1)) * 128 + 16 * s);
#pragma unroll
                    for (int j = 0; j < 8; ++j) uu[j] = *(const u32x2*)(ub + (size_t)(32 * (tb + 1)) * NPROJ + 32 * (j >> 2) + 8 * (j & 3));
                }
                ss += __shfl_xor(ss, 32);
                if (hh == 0) ssqm[(size_t)(t0 + t) * 16 + 8 + w] = ss;
                bf16_t* orow = mixed + (size_t)(t0 + t) * DM + 512 + 64 * w + 4 * hh;
#pragma unroll
                for (int db = 0; db < 2; ++db)
#pragma unroll
                    for (int rg = 0; rg < 4; ++rg) { u32x2 ow; ow.x = cvt_pk_bf16(acc[db][4 * rg], acc[db][4 * rg + 1]); ow.y = cvt_pk_bf16(acc[db][4 * rg + 2], acc[db][4 * rg + 3]);
                        *(u32x2*)(orow + 32 * db + 8 * rg) = ow; }
            }
        }
        __syncthreads();
    }
}

constexpr int P4_WROW = 2064;
constexpr int P4_W_OFF = 0, P4_LG_OFF = 48 * P4_WROW, P4_CNT_OFF = P4_LG_OFF + 8 * 16 * 48 * 4, P4_BASE_OFF = P4_CNT_OFF + 128;
static_assert(P4_BASE_OFF + 128 <= MISC_OFF, "P4 LDS map");
__device__ __forceinline__ void p4_router(Frame& F) {
    const int lane = F.lane, w = F.wave, tid = F.tid;
    const bf16_t* hb = (const bf16_t*)(F.ws + WS_HB);
    const bf16_t* wr_t = (const bf16_t*)(F.ws + WS_WR_T);
    const float* ssq = (const float*)(F.ws + WS_SSQ);
    int* cntg = (int*)(F.ws + WS_CTL) + CW_CNT;
    int* tl = (int*)(F.ws + WS_TOKLIST); float* rl = (float*)(F.ws + WS_RSLIST);
    LAS unsigned char* lds = F.lds;
    LAS float* lg = (LAS float*)(lds + P4_LG_OFF) + w * 16 * 48;
    LAS int* cl = (LAS int*)(lds + P4_CNT_OFF); LAS int* bl = (LAS int*)(lds + P4_BASE_OFF);
    bool wimg = false;
    for (int blk = F.vcu; blk < NTOK / 128; blk += F.G) {
        const int tok0 = blk * 128 + 16 * w;
        if (tid < 32) cl[tid] = 0;
        const bf16_t* ap = hb + (size_t)(tok0 + (lane & 15)) * DM + 8 * (lane >> 4);
        bf16x8 af[32];
#pragma unroll
        for (int s = 0; s < 32; ++s) af[s] = *(const bf16x8*)(ap + 32 * s);
        const f32x4 sq0 = *(const f32x4*)(ssq + (size_t)(tok0 + (lane & 15)) * 16), sq1 = *(const f32x4*)(ssq + (size_t)(tok0 + (lane & 15)) * 16 + 4),
                    sq2 = *(const f32x4*)(ssq + (size_t)(tok0 + (lane & 15)) * 16 + 8), sq3 = *(const f32x4*)(ssq + (size_t)(tok0 + (lane & 15)) * 16 + 12);
        if (!wimg) { wimg = true;
#pragma unroll
            for (int i = 0; i < 12; ++i) { const int pc = tid + 512 * i, row = pc >> 7, ch = pc & 127; *(LAS u32x4*)(lds + P4_W_OFF + row * P4_WROW + ch * 16) = *(const u32x4*)(wr_t + (size_t)row * DM + ch * 8); } }
        __syncthreads();
        f32x4 acc[3];
#pragma unroll
        for (int c = 0; c < 3; ++c) acc[c] = (f32x4){0.f, 0.f, 0.f, 0.f};
        const LAS unsigned char* bp = lds + P4_W_OFF + (lane & 15) * P4_WROW + 16 * (lane >> 4);
#pragma unroll
        for (int s = 0; s < 32; ++s) {
#pragma unroll
            for (int c = 0; c < 3; ++c) { const bf16x8 b = *(const LAS bf16x8*)(bp + c * 16 * P4_WROW + 64 * s); acc[c] = MFMA16(af[s], b, acc[c]); }
        }
#pragma unroll
        for (int c = 0; c < 3; ++c)
#pragma unroll
            for (int i = 0; i < 4; ++i) lg[(4 * (lane >> 4) + i) * 48 + 16 * c + (lane & 15)] = acc[c][i];
        LDS_WAIT();
        int e1 = 0, e2 = 0, l1 = 0, l2 = 0; float w1 = 0.f, w2 = 0.f, rstd = 0.f;
        if (lane < 16) {
            float s = 0.f;
#pragma unroll
            for (int i = 0; i < 4; ++i) s += sq0[i];
#pragma unroll
            for (int i = 0; i < 4; ++i) s += sq1[i];
#pragma unroll
            for (int i = 0; i < 4; ++i) s += sq2[i];
#pragma unroll
            for (int i = 0; i < 4; ++i) s += sq3[i];
            rstd = rsqrtf(s * (1.f / DM) + RMS_EPS);
            const LAS float* L = lg + lane * 48;
            float gl[4]; int gi = 0;
#pragma unroll
            for (int j = 0; j < 4; ++j) gl[j] = L[j] * rstd + F.in[13][j];
            float gm = gl[0];
#pragma unroll
            for (int j = 1; j < 4; ++j) if (gl[j] > gm) { gm = gl[j]; gi = j; }
            float den = 0.f;
#pragma unroll
            for (int j = 0; j < 4; ++j) den += __expf(gl[j] - gm);
            const float gw = 1.f / den;
            float el[8];
#pragma unroll
            for (int j = 0; j < 8; ++j) el[j] = L[4 + gi * 8 + j] * rstd + F.in[15][gi * 8 + j];
            int i1 = 0; float v1 = el[0];
#pragma unroll
            for (int j = 1; j < 8; ++j) if (el[j] > v1) { v1 = el[j]; i1 = j; }
            int i2 = 0; float v2 = -INFINITY;
#pragma unroll
            for (int j = 0; j < 8; ++j) if (j != i1 && el[j] > v2) { v2 = el[j]; i2 = j; }
            const float a1 = 1.f / (1.f + __expf(v2 - v1));
            w1 = gw * a1; w2 = gw * (1.f - a1); e1 = gi * 8 + i1; e2 = gi * 8 + i2;
            l1 = atomicAdd((int*)(cl + e1), 1); l2 = atomicAdd((int*)(cl + e2), 1);
        }
        __syncthreads();
        if (tid < 32) bl[tid] = atomicAdd(cntg + tid, (int)cl[tid]);
        __syncthreads();
        if (lane < 16) {
            const int tok = tok0 + lane; const int p1 = bl[e1] + l1, p2 = bl[e2] + l2;
            tl[(size_t)e1 * NTOK + p1] = tok; rl[(size_t)e1 * NTOK + p1] = rstd;
            tl[(size_t)e2 * NTOK + p2] = tok; rl[(size_t)e2 * NTOK + p2] = rstd;
            ((int4*)(F.ws + WS_TOKREC))[tok] = make_int4(e1, p1, e2, p2);
            ((float2*)(F.ws + WS_TOKW))[tok] = make_float2(w1, w2);
        }
        __syncthreads();
    }
}

__device__ __forceinline__ int moe_offsets(Frame& F) {
    const int* cnt = (const int*)(F.ws + WS_CTL) + CW_CNT;
    if (F.tid == 0) { int o = 0; for (int e = 0; e < NEXP; ++e) { const int n = __hip_atomic_load(cnt + e, __ATOMIC_RELAXED, __HIP_MEMORY_SCOPE_AGENT); F.MISC[16 + e] = (unsigned)o; F.MISC[16 + 64 + e] = (unsigned)n; o += (n + 255) >> 8; } F.MISC[16 + NEXP] = (unsigned)o; }
    __syncthreads();
    return __builtin_amdgcn_readfirstlane((int)F.MISC[16 + NEXP]);
}

__device__ __forceinline__ void p7_final(Frame& F) {
    const int lane = F.lane; const int gw = F.vcu * NWAVES + F.wave, NGW = F.G * NWAVES;
    const volatile LAS int* toff = (const volatile LAS int*)(F.MISC + 16);
    const float* gf = F.in[19];
    const f32x4 g0a = *(const f32x4*)(gf + 8 * lane), g0b = *(const f32x4*)(gf + 8 * lane + 4), g1a = *(const f32x4*)(gf + 512 + 8 * lane), g1b = *(const f32x4*)(gf + 512 + 8 * lane + 4);
    const bf16_t* HBp = (const bf16_t*)(F.ws + WS_HB); const bf16_t* Yp = (const bf16_t*)(F.ws + WS_Y);
    for (int tok0 = gw * 4; tok0 < NTOK; tok0 += NGW * 4) {
        int4 rec[4]; float2 wt[4];
#pragma unroll
        for (int t = 0; t < 4; ++t) { rec[t] = ((const int4*)(F.ws + WS_TOKREC))[tok0 + t]; wt[t] = ((const float2*)(F.ws + WS_TOKW))[tok0 + t]; }
        u32x4 ra[4][2], rb[4][2], rc[4][2];
#pragma unroll
        for (int t = 0; t < 4; ++t) {
            const int s1 = toff[rec[t].x] * 256 + rec[t].y, s2 = toff[rec[t].z] * 256 + rec[t].w;
            const bf16_t* hb = HBp + (size_t)(tok0 + t) * DM + 8 * lane; const bf16_t* y1 = Yp + (size_t)s1 * DM + 8 * lane; const bf16_t* y2 = Yp + (size_t)s2 * DM + 8 * lane;
#pragma unroll
            for (int j = 0; j < 2; ++j) { ra[t][j] = __builtin_nontemporal_load((const u32x4*)(hb + 512 * j)); rb[t][j] = __builtin_nontemporal_load((const u32x4*)(y1 + 512 * j)); rc[t][j] = __builtin_nontemporal_load((const u32x4*)(y2 + 512 * j)); }
        }
#pragma unroll
        for (int t = 0; t < 4; ++t) {
            float z[16]; float ss = 0.f;
#pragma unroll
            for (int j = 0; j < 2; ++j)
#pragma unroll
                for (int q = 0; q < 4; ++q) {
                    const float lo = __uint_as_float(ra[t][j][q] << 16) + wt[t].x * __uint_as_float(rb[t][j][q] << 16) + wt[t].y * __uint_as_float(rc[t][j][q] << 16);
                    const float hi = __uint_as_float(ra[t][j][q] & 0xffff0000u) + wt[t].x * __uint_as_float(rb[t][j][q] & 0xffff0000u) + wt[t].y * __uint_as_float(rc[t][j][q] & 0xffff0000u);
                    z[8 * j + 2 * q] = lo; z[8 * j + 2 * q + 1] = hi; ss += lo * lo + hi * hi; }
            const float rstd = rsqrtf(wave_sum(ss) * (1.f / DM) + RMS_EPS);
            float* o = F.out + (size_t)(tok0 + t) * DM;
            __builtin_nontemporal_store((f32x4){z[0] * rstd * g0a[0], z[1] * rstd * g0a[1], z[2] * rstd * g0a[2], z[3] * rstd * g0a[3]}, (f32x4*)(o + 8 * lane));
            __builtin_nontemporal_store((f32x4){z[4] * rstd * g0b[0], z[5] * rstd * g0b[1], z[6] * rstd * g0b[2], z[7] * rstd * g0b[3]}, (f32x4*)(o + 8 * lane + 4));
            __builtin_nontemporal_store((f32x4){z[8] * rstd * g1a[0], z[9] * rstd * g1a[1], z[10] * rstd * g1a[2], z[11] * rstd * g1a[3]}, (f32x4*)(o + 512 + 8 * lane));
            __builtin_nontemporal_store((f32x4){z[12] * rstd * g1b[0], z[13] * rstd * g1b[1], z[14] * rstd * g1b[2], z[15] * rstd * g1b[3]}, (f32x4*)(o + 512 + 8 * lane + 4));
        }
    }
}

struct Args { const float* in[20]; float* out; unsigned char* ws; int ph_lo, ph_hi, li, pad; };
constexpr int N_PHASES = 8;
__global__ void __launch_bounds__(NWAVES * 64, 2) mk_fwd(Args args) {
    extern __shared__ __attribute__((aligned(16))) unsigned char lds_raw[];
    Frame F;
    F.lds = (LAS unsigned char*)lds_raw;
    F.MISC = (volatile LAS unsigned*)(F.lds + MISC_OFF);
    F.tid = threadIdx.x; F.lane = F.tid & 63; F.wave = __builtin_amdgcn_readfirstlane(F.tid >> 6);
    F.G = gridDim.x; { const int bx = blockIdx.x; F.vcu = (F.G % 8 == 0) ? (bx % 8) * (F.G / 8) + bx / 8 : bx; }
    F.in = args.in; F.out = args.out; F.ws = args.ws;
    unsigned char* ws = args.ws;
    for (int u = F.tid; u < 256; u += NWAVES * 64) F.MISC[u] = 0u;
    __syncthreads();
    const int lo = args.ph_lo, hi = args.ph_hi;
    XcdBarrier bar; bar.bar = (unsigned*)(ws + WS_CTL) + CW_BAR + args.li * XCD_BAR_WORDS; bar.x = 0; bar.st = nullptr;
    if (hi - lo > 1) bar = xcd_barrier_post((unsigned*)(ws + WS_CTL) + CW_BAR + args.li * XCD_BAR_WORDS, F.MISC + 8);
#define IN(k) (lo <= (k) && (k) < hi)
#define SEAM(k) do { if (IN(k) && IN((k) + 1)) xcd_barrier(bar, &F, (k) < 3 ? (k) : -1); } while (0)
    if (IN(0)) { p0_prologue(F); SEAM(0); }
    if (IN(1)) {
        pg8::Gemm g{(const bf16_t*)(ws + WS_XN), (const bf16_t*)(ws + WS_WIN_T), DM, 0}; pg8::StaticOrder S; S.init(NTOK, NPROJ, DM, F.G, (int)blockIdx.x);
        pg8::EpiBf16G E{(bf16_t*)(ws + WS_PROJ), NPROJ, 3, (f32x2*)(ws + WS_SSQ), 5, 0, (const float*)(ws + WS_RSX)};
        pg8::gemm_phase<pg8::EpiBf16G, pg8::StaticOrder>(F.lds, g, S, E);
        {
            const int nu = (NTOK / 256) * (NPROJ / 256), full = nu % F.G;
            if (full == 0) convert_rest<1>(F, (int)blockIdx.x * NWAVES + F.wave, F.G * NWAVES, 0, 1 << 30);
            else if ((int)blockIdx.x >= full) convert_rest<1>(F, ((int)blockIdx.x - full) * NWAVES + F.wave, (F.G - full) * NWAVES, 0, 1 << 30);
        }
        SEAM(1);
    }
    if (IN(2)) { p2_mix(F, args.pad); SEAM(2); }
    if (IN(3)) {
        pg8::Gemm g{(const bf16_t*)(ws + WS_MIXED), (const bf16_t*)(ws + WS_WO_T), DM, 0}; pg8::StaticOrder S; S.init(NTOK, DM, DM, F.G, (int)blockIdx.x);
        pg8::EpiH E{(const bf16_t*)(ws + WS_XN), (bf16_t*)(ws + WS_HB), (float*)(ws + WS_SSQ), (const LAS f32x2*)(F.lds + RING_BYTES), {-1, -1, -1, -1}};
        {
            LAS f32x2* tab = (LAS f32x2*)(F.lds + RING_BYTES); pg8::Unit uu;
            for (int i = 0; i < 4 && S.next(i, uu); ++i) { E.pms[i] = uu.pm;
                if (F.tid < 256) { const f32x4* sp = (const f32x4*)((const float*)(ws + WS_SSQM) + (size_t)(uu.pm * 256 + F.tid) * 16); const f32x4 a = sp[0], b = sp[1], c = sp[2], d = sp[3];
                    const float sa = ((a[0] + a[1]) + (a[2] + a[3])) + ((b[0] + b[1]) + (b[2] + b[3])), sg = ((c[0] + c[1]) + (c[2] + c[3])) + ((d[0] + d[1]) + (d[2] + d[3]));
                    const float ra = rsqrtf(sa * (1.f / 512) + RMS_EPS), rg = rsqrtf(sg * (1.f / 512) + RMS_EPS); tab[i * 256 + F.tid] = (f32x2){ra / rg, rg}; } }
            __syncthreads();
        }
        pg8::gemm_phase<pg8::EpiH, pg8::StaticOrder>(F.lds, g, S, E);
        SEAM(3);
    }
    if (IN(4)) { p4_router(F); SEAM(4); }
    if (IN(5) || IN(6) || IN(7)) {
        const int ntiles = moe_offsets(F);
        const volatile LAS int* toff = (const volatile LAS int*)(F.MISC + 16);
        const int* cnt = (const int*)(ws + WS_CTL) + CW_CNT;
        if (IN(5)) {
            pg8::Gemm g{(const bf16_t*)(ws + WS_HB), (const bf16_t*)(ws + WS_WGU_T), DM, 0};
            MoeOrder<true> S{toff, cnt, (const int*)(ws + WS_TOKLIST), 2, ntiles * 2, F.G, (int)blockIdx.x, DM, 512};
            EpiSwiglu E{(bf16_t*)(ws + WS_HID), (const float*)(ws + WS_RSLIST)};
            pg8::gemm_phase<EpiSwiglu, MoeOrder<true>>(F.lds, g, S, E);
            {
                const int nu = ntiles * 2, full = nu % F.G;
                if (full == 0) convert_rest<2>(F, (int)blockIdx.x * NWAVES + F.wave, F.G * NWAVES, 0, 1 << 30);
                else if ((int)blockIdx.x >= full) convert_rest<2>(F, ((int)blockIdx.x - full) * NWAVES + F.wave, (F.G - full) * NWAVES, 0, 1 << 30);
            }
            SEAM(5);
        }
        if (IN(6)) {
            pg8::Gemm g{(const bf16_t*)(ws + WS_HID), (const bf16_t*)(ws + WS_WD_T), DEXP, 0};
            MoeOrder<false> S{toff, cnt, (const int*)(ws + WS_TOKLIST), 4, ntiles * 4, F.G, (int)blockIdx.x, DEXP, DM};
            pg8::EpiBf16G E{(bf16_t*)(ws + WS_Y), DM, 1000, nullptr, 1000, 0, nullptr};
            pg8::gemm_phase<pg8::EpiBf16G, MoeOrder<false>>(F.lds, g, S, E);
            SEAM(6);
        }
        if (IN(7)) p7_final(F);
    }
#undef IN
#undef SEAM
}
extern "C" void kernel_launch(void* const* d_in, const int* in_sizes, int n_in, void* d_out, int out_size, void* d_ws, size_t ws_size, hipStream_t stream) {
    static int grid = 0;
    if (grid == 0) {
        if (n_in != 20 || in_sizes[0] != NTOK * DM || out_size != NTOK * DM || ws_size < WS_END) {
            fprintf(stderr, "kernel_launch: unexpected shapes (n_in %d, in0 %d, out %d, ws %zu)\n", n_in, n_in > 0 ? in_sizes[0] : -1, out_size, ws_size); grid = -1; return; }
        int dev = 0, cus = 0, per_cu = 0;
        if (hipGetDevice(&dev) != hipSuccess || hipDeviceGetAttribute(&cus, hipDeviceAttributeMultiprocessorCount, dev) != hipSuccess) { fprintf(stderr, "kernel_launch: device query failed\n"); grid = -1; return; }
        if (hipFuncSetAttribute((const void*)mk_fwd, hipFuncAttributeMaxDynamicSharedMemorySize, LDS_BYTES) != hipSuccess) { fprintf(stderr, "kernel_launch: hipFuncSetAttribute(%d B LDS) failed\n", LDS_BYTES); grid = -1; return; }
        if (hipOccupancyMaxActiveBlocksPerMultiprocessor(&per_cu, (const void*)mk_fwd, NWAVES * 64, LDS_BYTES) != hipSuccess || per_cu < 1)
            fprintf(stderr, "kernel_launch: note: occupancy query reports %d workgroups per CU\n", per_cu);
        (void)hipGetLastError();
        grid = cus;
    }
    if (grid < 0) return;
    Params p{};
    for (int i = 0; i < 20; ++i) p.in[i] = (const float*)d_in[i];
    p.out = (float*)d_out; p.ws = (unsigned char*)d_ws;
    unsigned char* ws = p.ws;
    (void)hipMemsetAsync(ws + WS_CTL, 0, CTL_ZERO_BYTES, stream);
    const int* cnt = (const int*)(ws + WS_CTL) + CW_CNT;
    Args a{};
    for (int i = 0; i < 20; ++i) a.in[i] = (const float*)d_in[i];
    a.out = (float*)d_out; a.ws = ws;
#ifndef REP_PH
#define REP_PH -1
#endif
    constexpr int rp = REP_PH;
    int li = 0;
#ifdef CUM_PH
    { a.ph_lo = 0; a.ph_hi = CUM_PH; a.li = li++; hipLaunchKernelGGL(mk_fwd, dim3(grid), dim3(NWAVES * 64), LDS_BYTES, stream, a);
      (void)hipMemsetAsync(ws + WS_CTL + CW_CNT * 4, 0, NEXP * 4, stream); }
#endif
    if (rp < 0) { a.ph_lo = 0; a.ph_hi = N_PHASES; a.li = li++; hipLaunchKernelGGL(mk_fwd, dim3(grid), dim3(NWAVES * 64), LDS_BYTES, stream, a); }
    else {
        a.ph_lo = 0; a.ph_hi = rp + 1; a.li = li++; hipLaunchKernelGGL(mk_fwd, dim3(grid), dim3(NWAVES * 64), LDS_BYTES, stream, a);
        if (rp == 4) (void)hipMemsetAsync(ws + WS_CTL + CW_CNT * 4, 0, NEXP * 4, stream);
#ifdef REP_P2
        a.pad = REP_P2;
#endif
#ifdef REP_GRID
        a.ph_lo = rp; a.ph_hi = rp + 1; a.li = li++; hipLaunchKernelGGL(mk_fwd, dim3(REP_GRID), dim3(NWAVES * 64), LDS_BYTES, stream, a);
#else
        a.ph_lo = rp; a.ph_hi = rp + 1; a.li = li++; hipLaunchKernelGGL(mk_fwd, dim3(grid), dim3(NWAVES * 64), LDS_BYTES, stream, a);
#endif
        a.pad = 0;
        if (rp + 1 < N_PHASES) { a.ph_lo = rp + 1; a.ph_hi = N_PHASES; a.li = li++; hipLaunchKernelGGL(mk_fwd, dim3(grid), dim3(NWAVES * 64), LDS_BYTES, stream, a); }
    }
    (void)p; (void)cnt;
}
```
